# Optimizing an MI355X kernel written in HIP

```python
import math
import jax, jax.numpy as jnp
from jax import lax
import numpy as np

D_MODEL = 1024
BATCH = 2
SEQ = 8192
DEPTH = 4

HEAD_DIM = 64
MIX_WIDTH = D_MODEL
A_WIDTH = MIX_WIDTH // 4
A_HEADS = A_WIDTH // HEAD_DIM
CHUNK = 128
B_WIDTH = MIX_WIDTH // 2
B_Q_HEADS = B_WIDTH // HEAD_DIM
B_KV_HEADS = 2
B_GROUP = B_Q_HEADS // B_KV_HEADS
WINDOW = 128
ROPE_THETA = 10000.0
C_WIDTH = MIX_WIDTH // 4
C_GROUP = 16
C_GROUPS = C_WIDTH // C_GROUP
C_STATE = 64
DT_MIN = 0.001
DT_MAX = 0.1
IN_A = 2 * A_WIDTH
IN_Q = B_WIDTH
IN_KV = B_KV_HEADS * HEAD_DIM
IN_C = C_WIDTH
IN_COLS = IN_A + IN_Q + 2 * IN_KV + IN_C
D_FF = 4 * D_MODEL
PLE_DIM = 256
EPS = 1e-6

kernel_name = "hybrid_gmlp_swa_s5_trunk"


def rmsnorm(x, g):
    xf = x.astype(jnp.float32)
    y = xf * lax.rsqrt(jnp.mean(xf * xf, axis=-1, keepdims=True) + EPS)
    return (y * g.astype(jnp.float32)).astype(x.dtype)


def layernorm(x, g, b):
    xf = x.astype(jnp.float32)
    mu = jnp.mean(xf, axis=-1, keepdims=True)
    xc = xf - mu
    y = xc * lax.rsqrt(jnp.mean(xc * xc, axis=-1, keepdims=True) + EPS)
    return (y * g.astype(jnp.float32) + b.astype(jnp.float32)).astype(x.dtype)


def rope_tables(positions):
    inv = 1.0 / (ROPE_THETA ** (jnp.arange(0, HEAD_DIM, 2, dtype=jnp.float32) / HEAD_DIM))
    ang = positions.astype(jnp.float32)[..., None] * inv
    return jnp.cos(ang), jnp.sin(ang)


def apply_rope(x, cos, sin):
    xf = x.astype(jnp.float32)
    x1, x2 = jnp.split(xf, 2, axis=-1)
    c = cos[:, :, None, :]
    s = sin[:, :, None, :]
    return jnp.concatenate([x1 * c - x2 * s, x2 * c + x1 * s], axis=-1).astype(x.dtype)


def chunk_gmlp(z, ln_g, ln_b, w_s, b_s):
    bsz, L, _ = z.shape
    z = jax.nn.gelu(z).reshape(bsz, L // CHUNK, CHUNK, A_HEADS, 2 * HEAD_DIM)
    u, v = jnp.split(z, 2, axis=-1)
    v = layernorm(v, ln_g, ln_b)
    causal = jnp.tril(jnp.ones((CHUNK, CHUNK), dtype=bool))
    w = jnp.where(causal, w_s, 0.0).astype(v.dtype)
    sv = jnp.einsum('hts,bnshd->bnthd', w, v) + b_s.T[None, None, :, :, None].astype(v.dtype)
    return (u * sv).reshape(bsz, L, A_WIDTH)


def swa_sink_attention(q, k, v, sinks):
    bsz, L = q.shape[:2]
    nb = L // WINDOW
    qb = q.reshape(bsz, nb, WINDOW, B_KV_HEADS, B_GROUP, HEAD_DIM)

    def band(t):
        t = t.reshape(bsz, nb, WINDOW, B_KV_HEADS, HEAD_DIM)
        prev = jnp.pad(t[:, :-1], ((0, 0), (1, 0), (0, 0), (0, 0), (0, 0)))
        return jnp.concatenate([prev, t], axis=2)

    kb, vb = band(k), band(v)
    s = jnp.einsum('bnqhgd,bnkhd->bnhgqk', qb, kb,
                   preferred_element_type=jnp.float32) * (HEAD_DIM ** -0.5)
    qi = jnp.arange(WINDOW)[:, None] + WINDOW
    kj = jnp.arange(2 * WINDOW)[None, :]
    diff = qi - kj
    band_ok = (diff >= 0) & (diff < WINDOW)
    not_first = jnp.arange(nb)[:, None, None] > 0
    mask = band_ok[None] & (not_first | (kj >= WINDOW)[None])
    s = jnp.where(mask[None, :, None, None], s, -jnp.inf)
    sink = sinks.astype(jnp.float32).reshape(B_KV_HEADS, B_GROUP)[None, None, :, :, None, None]
    m = jnp.maximum(jnp.max(s, axis=-1, keepdims=True), sink)
    pr = jnp.exp(s - m)
    denom = jnp.sum(pr, axis=-1, keepdims=True) + jnp.exp(sink - m)
    o = jnp.einsum('bnhgqk,bnkhd->bnqhgd', (pr / denom).astype(v.dtype), vb)
    return o.reshape(bsz, L, B_WIDTH)


def s5_ssm(u, a_re, a_im, log_dt, b_re, b_im, c_re, c_im, d_skip, glu_w1, glu_w2):
    bsz, L, _ = u.shape
    uf = u.astype(jnp.float32).reshape(bsz, L, C_GROUPS, C_GROUP)
    lam = lax.complex(a_re.astype(jnp.float32), a_im.astype(jnp.float32))
    dt = jnp.exp(log_dt.astype(jnp.float32))[:, None]
    lam_bar = jnp.exp(lam * dt)
    bmat = lax.complex(b_re.astype(jnp.float32), b_im.astype(jnp.float32))
    b_bar = ((lam_bar - 1.0) / lam)[..., None] * bmat
    bu = jnp.einsum('gph,blgh->blgp', b_bar, uf.astype(jnp.complex64))
    a_seq = jnp.broadcast_to(lam_bar, bu.shape)

    def combine(e1, e2):
        a1, x1 = e1
        a2, x2 = e2
        return a1 * a2, a2 * x1 + x2

    _, states = lax.associative_scan(combine, (a_seq, bu), axis=1)
    cmat = lax.complex(c_re.astype(jnp.float32), c_im.astype(jnp.float32))
    y = jnp.real(jnp.einsum('ghp,blgp->blgh', cmat, states)) + d_skip.astype(jnp.float32) * uf
    y = jax.nn.gelu(y.reshape(bsz, L, C_WIDTH)).astype(u.dtype)
    return (y @ glu_w1) * jax.nn.sigmoid(y @ glu_w2)


def hybrid_layer(h, p_i, cos, sin, attn_norm_g, w_in, gmlp_ln_g, gmlp_ln_b, gmlp_ws, gmlp_bs,
                 q_norm_g, k_norm_g, sinks, ssm_a_re, ssm_a_im, ssm_log_dt, ssm_b_re, ssm_b_im,
                 ssm_c_re, ssm_c_im, ssm_d, glu_w1, glu_w2, mix_out_g, w_out,
                 mlp_norm_g, w_ff1, w_ff2, ple_norm_g, w_ple_gate, w_ple_proj):
    bsz, L, _ = h.shape
    xn = rmsnorm(h, attn_norm_g)
    z = xn @ w_in
    za, zq, zk, zv, zc = jnp.split(
        z, [IN_A, IN_A + IN_Q, IN_A + IN_Q + IN_KV, IN_A + IN_Q + 2 * IN_KV], axis=-1)
    ya = chunk_gmlp(za, gmlp_ln_g, gmlp_ln_b, gmlp_ws, gmlp_bs)
    q = zq.reshape(bsz, L, B_Q_HEADS, HEAD_DIM)
    k = zk.reshape(bsz, L, B_KV_HEADS, HEAD_DIM)
    v = zv.reshape(bsz, L, B_KV_HEADS, HEAD_DIM)
    q = apply_rope(rmsnorm(q, q_norm_g), cos, sin)
    k = apply_rope(rmsnorm(k, k_norm_g), cos, sin)
    yb = swa_sink_attention(q, k, v, sinks)
    yc = s5_ssm(zc, ssm_a_re, ssm_a_im, ssm_log_dt, ssm_b_re, ssm_b_im,
                ssm_c_re, ssm_c_im, ssm_d, glu_w1, glu_w2)
    y = jnp.concatenate([
        rmsnorm(ya, mix_out_g[:A_WIDTH]),
        rmsnorm(yb, mix_out_g[A_WIDTH:A_WIDTH + B_WIDTH]),
        rmsnorm(yc, mix_out_g[A_WIDTH + B_WIDTH:]),
    ], axis=-1)
    h = h + y @ w_out
    hn = rmsnorm(h, mlp_norm_g)
    h = h + jnp.square(jax.nn.relu(hn @ w_ff1)) @ w_ff2
    gate = jax.nn.sigmoid(rmsnorm(h, ple_norm_g) @ w_ple_gate)
    return h + gate * (p_i @ w_ple_proj)


def setup_inputs(seed: int = 0) -> dict:
    key = jax.random.key(seed)
    ks = iter(jax.random.split(key, 40))
    f32 = jnp.float32

    def nrm(shape, scale):
        return jax.random.normal(next(ks), shape, f32) * scale

    def gain(shape):
        return 1.0 + nrm(shape, 0.02)

    x = nrm((BATCH, SEQ, D_MODEL), 1.0)
    p = nrm((DEPTH, BATCH, SEQ, PLE_DIM), 1.0)
    offsets = jax.random.randint(next(ks), (BATCH, 1), 0, 1024, dtype=jnp.int32)
    positions = offsets + jnp.arange(SEQ, dtype=jnp.int32)[None, :]

    n_idx = jnp.arange(C_STATE, dtype=f32)
    ssm_a_re = -0.5 + nrm((DEPTH, C_GROUPS, C_STATE), 0.01)
    ssm_a_im = math.pi * n_idx[None, None, :] + nrm((DEPTH, C_GROUPS, C_STATE), 0.01)
    ssm_log_dt = jax.random.uniform(next(ks), (DEPTH, C_GROUPS), f32,
                                    math.log(DT_MIN), math.log(DT_MAX))
    b_scale = (2.0 * C_GROUP) ** -0.5
    c_scale = (2.0 * C_STATE) ** -0.5

    return {
        "x": x,
        "p": p,
        "positions": positions,
        "attn_norm_g": gain((DEPTH, D_MODEL)),
        "w_in": nrm((DEPTH, D_MODEL, IN_COLS), D_MODEL ** -0.5),
        "gmlp_ln_g": gain((DEPTH, A_HEADS, HEAD_DIM)),
        "gmlp_ln_b": nrm((DEPTH, A_HEADS, HEAD_DIM), 0.02),
        "gmlp_ws": nrm((DEPTH, A_HEADS, CHUNK, CHUNK), 0.5 * CHUNK ** -0.5),
        "gmlp_bs": gain((DEPTH, A_HEADS, CHUNK)),
        "q_norm_g": gain((DEPTH, HEAD_DIM)),
        "k_norm_g": gain((DEPTH, HEAD_DIM)),
        "sinks": nrm((DEPTH, B_Q_HEADS), 0.5),
        "ssm_a_re": ssm_a_re,
        "ssm_a_im": ssm_a_im,
        "ssm_log_dt": ssm_log_dt,
        "ssm_b_re": nrm((DEPTH, C_GROUPS, C_STATE, C_GROUP), b_scale),
        "ssm_b_im": nrm((DEPTH, C_GROUPS, C_STATE, C_GROUP), b_scale),
        "ssm_c_re": nrm((DEPTH, C_GROUPS, C_GROUP, C_STATE), c_scale),
        "ssm_c_im": nrm((DEPTH, C_GROUPS, C_GROUP, C_STATE), c_scale),
        "ssm_d": nrm((DEPTH, C_GROUPS, C_GROUP), 0.5),
        "glu_w1": nrm((DEPTH, C_WIDTH, C_WIDTH), C_WIDTH ** -0.5),
        "glu_w2": nrm((DEPTH, C_WIDTH, C_WIDTH), C_WIDTH ** -0.5),
        "mix_out_g": gain((DEPTH, MIX_WIDTH)),
        "w_out": nrm((DEPTH, MIX_WIDTH, D_MODEL), MIX_WIDTH ** -0.5),
        "mlp_norm_g": gain((DEPTH, D_MODEL)),
        "w_ff1": nrm((DEPTH, D_MODEL, D_FF), D_MODEL ** -0.5),
        "w_ff2": nrm((DEPTH, D_FF, D_MODEL), D_FF ** -0.5),
        "ple_norm_g": gain((DEPTH, D_MODEL)),
        "w_ple_gate": nrm((DEPTH, D_MODEL, D_MODEL), D_MODEL ** -0.5),
        "w_ple_proj": nrm((DEPTH, PLE_DIM, D_MODEL), 0.5 * PLE_DIM ** -0.5),
    }


def reference(x, p, positions, attn_norm_g, w_in, gmlp_ln_g, gmlp_ln_b, gmlp_ws, gmlp_bs,
              q_norm_g, k_norm_g, sinks, ssm_a_re, ssm_a_im, ssm_log_dt, ssm_b_re, ssm_b_im,
              ssm_c_re, ssm_c_im, ssm_d, glu_w1, glu_w2, mix_out_g, w_out,
              mlp_norm_g, w_ff1, w_ff2, ple_norm_g, w_ple_gate, w_ple_proj):
    cos, sin = rope_tables(positions)
    h = x
    for i in range(DEPTH):
        h = hybrid_layer(h, p[i], cos, sin, attn_norm_g[i], w_in[i], gmlp_ln_g[i], gmlp_ln_b[i],
                         gmlp_ws[i], gmlp_bs[i], q_norm_g[i], k_norm_g[i], sinks[i],
                         ssm_a_re[i], ssm_a_im[i], ssm_log_dt[i], ssm_b_re[i], ssm_b_im[i],
                         ssm_c_re[i], ssm_c_im[i], ssm_d[i], glu_w1[i], glu_w2[i],
                         mix_out_g[i], w_out[i], mlp_norm_g[i], w_ff1[i], w_ff2[i],
                         ple_norm_g[i], w_ple_gate[i], w_ple_proj[i])
    return h
```

```cpp
#include <hip/hip_runtime.h>
#include <math.h>

#define NTOK 16384
#define SEQL 8192
#define DM 1024
#define NIN 1536
#define DFF 4096

__device__ __forceinline__ float wave_sum(float v) {
#pragma unroll
    for (int o = 1; o < 64; o <<= 1) v += __shfl_xor(v, o);
    return v;
}
__device__ __forceinline__ float gelu_tanh(float x) {
    const float k0 = 0.7978845608028654f, k1 = 0.044715f;
    float u = k0 * (x + k1 * x * x * x);
    return 0.5f * x * (1.0f + tanhf(u));
}

__global__ void k_rmsnorm(const float* in, int ldi, const float* g, float* out, int ldo, int ncols, int nrows) {
    int row = blockIdx.x * 4 + (threadIdx.x >> 6), lane = threadIdx.x & 63;
    if (row >= nrows) return;
    const float* x = in + (size_t)row * ldi;
    float s = 0.f;
    for (int c = lane; c < ncols; c += 64) { float v = x[c]; s += v * v; }
    s = wave_sum(s);
    float r = rsqrtf(s / (float)ncols + 1e-6f);
    float* o = out + (size_t)row * ldo;
    for (int c = lane; c < ncols; c += 64) o[c] = x[c] * r * g[c];
}

template <int MODE>
__global__ __launch_bounds__(256) void k_gemm(const float* A, int lda, const float* B, int ldb, float* C, int ldc, int K) {
    __shared__ float As[16][68];
    __shared__ float Bs[16][64];
    const int tx = threadIdx.x & 15, ty = threadIdx.x >> 4;
    const int m0 = blockIdx.y * 64, n0 = blockIdx.x * 64;
    float acc[4][4];
#pragma unroll
    for (int i = 0; i < 4; ++i)
#pragma unroll
        for (int j = 0; j < 4; ++j) acc[i][j] = 0.f;
    for (int k0 = 0; k0 < K; k0 += 16) {
#pragma unroll
        for (int i = 0; i < 4; ++i) { int idx = threadIdx.x + i * 256; int r = idx >> 4, c = idx & 15; As[c][r] = A[(size_t)(m0 + r) * lda + k0 + c]; }
#pragma unroll
        for (int i = 0; i < 4; ++i) { int idx = threadIdx.x + i * 256; int r = idx >> 6, c = idx & 63; Bs[r][c] = B[(size_t)(k0 + r) * ldb + n0 + c]; }
        __syncthreads();
#pragma unroll
        for (int k = 0; k < 16; ++k) {
            float a[4], b[4];
#pragma unroll
            for (int i = 0; i < 4; ++i) { a[i] = As[k][ty * 4 + i]; b[i] = Bs[k][tx * 4 + i]; }
#pragma unroll
            for (int i = 0; i < 4; ++i)
#pragma unroll
                for (int j = 0; j < 4; ++j) acc[i][j] += a[i] * b[j];
        }
        __syncthreads();
    }
#pragma unroll
    for (int i = 0; i < 4; ++i)
#pragma unroll
        for (int j = 0; j < 4; ++j) {
            float* p = C + (size_t)(m0 + ty * 4 + i) * ldc + n0 + tx * 4 + j;
            float v = acc[i][j];
            if (MODE == 1) v += *p;
            if (MODE == 2) { v = v > 0.f ? v : 0.f; v = v * v; }
            *p = v;
        }
}

__global__ void k_gmlp_pre(float* z, const float* ln_g, const float* ln_b) {
    int idx = blockIdx.x * 4 + (threadIdx.x >> 6), lane = threadIdx.x & 63;
    int tok = idx >> 2, h = idx & 3;
    float* p = z + (size_t)tok * NIN + h * 128;
    float u = gelu_tanh(p[lane]);
    float v = gelu_tanh(p[64 + lane]);
    float mu = wave_sum(v) * (1.f / 64.f);
    float vc = v - mu;
    float var = wave_sum(vc * vc) * (1.f / 64.f);
    float y = vc * rsqrtf(var + 1e-6f) * ln_g[h * 64 + lane] + ln_b[h * 64 + lane];
    p[lane] = u; p[64 + lane] = y;
}
__global__ void k_gmlp_mix(const float* z, const float* ws, const float* bs, float* ycat) {
    int idx = blockIdx.x * 4 + (threadIdx.x >> 6), d = threadIdx.x & 63;
    int tok = idx >> 2, h = idx & 3;
    int t = tok & 127, base = tok - t;
    const float* w = ws + ((size_t)h * 128 + t) * 128;
    float acc = 0.f;
    for (int s = 0; s <= t; ++s) acc += w[s] * z[(size_t)(base + s) * NIN + h * 128 + 64 + d];
    acc += bs[h * 128 + t];
    float u = z[(size_t)tok * NIN + h * 128 + d];
    ycat[(size_t)tok * DM + h * 64 + d] = u * acc;
}
__global__ void k_qk_prep(float* z, const float* qg, const float* kg, const int* pos) {
    int idx = blockIdx.x * 4 + (threadIdx.x >> 6), lane = threadIdx.x & 63;
    int tok = idx / 10, h = idx % 10;
    float* p = z + (size_t)tok * NIN + 512 + h * 64;
    const float* g = (h < 8) ? qg : kg;
    float x = p[lane];
    float ss = wave_sum(x * x) * (1.f / 64.f);
    float y = x * rsqrtf(ss + 1e-6f) * g[lane];
    float other = __shfl_xor(y, 32);
    int i = lane & 31;
    double inv = pow(10000.0, -(double)i / 32.0);
    double ang = (double)pos[tok] * inv;
    float c = (float)cos(ang), s = (float)sin(ang);
    float o = (lane < 32) ? (y * c - other * s) : (y * c + other * s);
    p[lane] = o;
}
__global__ void k_attn(const float* z, const float* sinks, float* ycat) {
    __shared__ float qs[64];
    __shared__ float ps[128];
    int idx = blockIdx.x, lane = threadIdx.x;
    int tok = idx >> 3, hq = idx & 7, hkv = hq >> 2;
    int t = tok & (SEQL - 1), b0 = tok - t;
    qs[lane] = z[(size_t)tok * NIN + 512 + hq * 64 + lane];
    __syncthreads();
    int nk = t + 1 < 128 ? t + 1 : 128;
    int j0 = t - nk + 1;
    float sc[2];
#pragma unroll
    for (int r = 0; r < 2; ++r) {
        int jj = lane + 64 * r;
        float s = -INFINITY;
        if (jj < nk) {
            const float* kp = z + (size_t)(b0 + j0 + jj) * NIN + 1024 + hkv * 64;
            float a = 0.f;
            for (int d = 0; d < 64; ++d) a += qs[d] * kp[d];
            s = a * 0.125f;
        }
        sc[r] = s;
    }
    float sink = sinks[hq];
    float m = fmaxf(sc[0], sc[1]);
#pragma unroll
    for (int o = 1; o < 64; o <<= 1) m = fmaxf(m, __shfl_xor(m, o));
    m = fmaxf(m, sink);
    float p0 = (lane < nk) ? expf(sc[0] - m) : 0.f;
    float p1 = (lane + 64 < nk) ? expf(sc[1] - m) : 0.f;
    float den = wave_sum(p0 + p1) + expf(sink - m);
    ps[lane] = p0 / den; ps[lane + 64] = p1 / den;
    __syncthreads();
    float o = 0.f;
    for (int jj = 0; jj < nk; ++jj) o += ps[jj] * z[(size_t)(b0 + j0 + jj) * NIN + 1152 + hkv * 64 + lane];
    ycat[(size_t)tok * DM + 256 + hq * 64 + lane] = o;
}
__global__ void k_ssm(const float* z, const float* a_re, const float* a_im, const float* log_dt, const float* b_re, const float* b_im,
                      const float* c_re, const float* c_im, const float* dsk, float* yssm) {
    int b = blockIdx.x >> 4, g = blockIdx.x & 15, p = threadIdx.x;
    double lre = a_re[g * 64 + p], lim = a_im[g * 64 + p], dt = exp((double)log_dt[g]);
    double er = exp(lre * dt), lbr = er * cos(lim * dt), lbi = er * sin(lim * dt);
    double nr = lbr - 1.0, ni = lbi, den = lre * lre + lim * lim;
    double fr = (nr * lre + ni * lim) / den, fi = (ni * lre - nr * lim) / den;
    float bbr[16], bbi[16], cr[16], ci[16], dd[16];
#pragma unroll
    for (int h = 0; h < 16; ++h) {
        double br = b_re[(g * 64 + p) * 16 + h], bi = b_im[(g * 64 + p) * 16 + h];
        bbr[h] = (float)(fr * br - fi * bi); bbi[h] = (float)(fr * bi + fi * br);
        cr[h] = c_re[(g * 16 + h) * 64 + p]; ci[h] = c_im[(g * 16 + h) * 64 + p];
        dd[h] = dsk[g * 16 + h];
    }
    float lr = (float)lbr, li = (float)lbi;
    float xr = 0.f, xi = 0.f;
    for (int t = 0; t < SEQL; ++t) {
        const float* up = z + (size_t)(b * SEQL + t) * NIN + 1280 + g * 16;
        float u[16];
#pragma unroll
        for (int h = 0; h < 16; ++h) u[h] = up[h];
        float sr = 0.f, si = 0.f;
#pragma unroll
        for (int h = 0; h < 16; ++h) { sr += bbr[h] * u[h]; si += bbi[h] * u[h]; }
        float nxr = lr * xr - li * xi + sr, nxi = lr * xi + li * xr + si;
        xr = nxr; xi = nxi;
        float mine = 0.f;
#pragma unroll
        for (int h = 0; h < 16; ++h) {
            float v = wave_sum(cr[h] * xr - ci[h] * xi);
            if (p == h) mine = v + dd[h] * u[h];
        }
        if (p < 16) yssm[(size_t)(b * SEQL + t) * 256 + g * 16 + p] = gelu_tanh(mine);
    }
}
__global__ void k_glu(const float* t1, const float* t2, float* ycat) {
    int i = blockIdx.x * 256 + threadIdx.x;
    int tok = i >> 8, c = i & 255;
    float a = t1[i], b = t2[i];
    ycat[(size_t)tok * DM + 768 + c] = a / (1.f + expf(-b));
}
__global__ void k_ple(float* h, const float* gate, const float* pp) {
    int i = blockIdx.x * 256 + threadIdx.x;
    h[i] = h[i] + pp[i] / (1.f + expf(-gate[i]));
}

extern "C" void kernel_launch(void* const* d_in, const int* in_sizes, int n_in, void* d_out, int out_size, void* d_ws, size_t ws_size, hipStream_t stream) {
    const float* x = (const float*)d_in[0];
    const float* pin = (const float*)d_in[1];
    const int* pos = (const int*)d_in[2];
    const float* F[30];
    for (int i = 0; i < 30; ++i) F[i] = (const float*)d_in[i];
    float* h = (float*)d_out;
    char* ws = (char*)d_ws;
    const size_t MiB = 1u << 20;
    float* xn = (float*)(ws + 0 * MiB);
    float* z = (float*)(ws + 64 * MiB);
    float* hid = z;
    float* ycat = (float*)(ws + 160 * MiB);
    float* pproj = ycat;
    float* gate = (float*)(ws + 224 * MiB);
    float* yssm = (float*)(ws + 224 * MiB);
    float* t1 = (float*)(ws + 240 * MiB);
    float* t2 = (float*)(ws + 256 * MiB);
    hipMemcpyAsync(h, x, (size_t)NTOK * DM * 4, hipMemcpyDeviceToDevice, stream);
    for (int L = 0; L < 4; ++L) {
        k_rmsnorm<<<NTOK / 4, 256, 0, stream>>>(h, DM, F[3] + L * DM, xn, DM, DM, NTOK);
        k_gemm<0><<<dim3(NIN / 64, NTOK / 64), 256, 0, stream>>>(xn, DM, F[4] + (size_t)L * DM * NIN, NIN, z, NIN, DM);
        k_gmlp_pre<<<NTOK * 4 / 4, 256, 0, stream>>>(z, F[5] + L * 256, F[6] + L * 256);
        k_gmlp_mix<<<NTOK * 4 / 4, 256, 0, stream>>>(z, F[7] + (size_t)L * 4 * 128 * 128, F[8] + L * 512, ycat);
        k_qk_prep<<<NTOK * 10 / 4, 256, 0, stream>>>(z, F[9] + L * 64, F[10] + L * 64, pos);
        k_attn<<<NTOK * 8, 64, 0, stream>>>(z, F[11] + L * 8, ycat);
        k_ssm<<<32, 64, 0, stream>>>(z, F[12] + L * 1024, F[13] + L * 1024, F[14] + L * 16, F[15] + L * 16384, F[16] + L * 16384,
                                     F[17] + L * 16384, F[18] + L * 16384, F[19] + L * 256, yssm);
        k_gemm<0><<<dim3(256 / 64, NTOK / 64), 256, 0, stream>>>(yssm, 256, F[20] + (size_t)L * 65536, 256, t1, 256, 256);
        k_gemm<0><<<dim3(256 / 64, NTOK / 64), 256, 0, stream>>>(yssm, 256, F[21] + (size_t)L * 65536, 256, t2, 256, 256);
        k_glu<<<NTOK * 256 / 256, 256, 0, stream>>>(t1, t2, ycat);
        k_rmsnorm<<<NTOK / 4, 256, 0, stream>>>(ycat, DM, F[22] + L * DM, ycat, DM, 256, NTOK);
        k_rmsnorm<<<NTOK / 4, 256, 0, stream>>>(ycat + 256, DM, F[22] + L * DM + 256, ycat + 256, DM, 512, NTOK);
        k_rmsnorm<<<NTOK / 4, 256, 0, stream>>>(ycat + 768, DM, F[22] + L * DM + 768, ycat + 768, DM, 256, NTOK);
        k_gemm<1><<<dim3(DM / 64, NTOK / 64), 256, 0, stream>>>(ycat, DM, F[23] + (size_t)L * DM * DM, DM, h, DM, DM);
        k_rmsnorm<<<NTOK / 4, 256, 0, stream>>>(h, DM, F[24] + L * DM, xn, DM, DM, NTOK);
        for (int c = 0; c < 4; ++c) {
            k_gemm<2><<<dim3(1024 / 64, NTOK / 64), 256, 0, stream>>>(xn, DM, F[25] + (size_t)L * DM * DFF + c * 1024, DFF, hid, 1024, DM);
            k_gemm<1><<<dim3(DM / 64, NTOK / 64), 256, 0, stream>>>(hid, 1024, F[26] + (size_t)L * DFF * DM + (size_t)c * 1024 * DM, DM, h, DM, 1024);
        }
        k_rmsnorm<<<NTOK / 4, 256, 0, stream>>>(h, DM, F[27] + L * DM, xn, DM, DM, NTOK);
        k_gemm<0><<<dim3(DM / 64, NTOK / 64), 256, 0, stream>>>(xn, DM, F[28] + (size_t)L * DM * DM, DM, gate, DM, DM);
        k_gemm<0><<<dim3(DM / 64, NTOK / 64), 256, 0, stream>>>(pin + (size_t)L * NTOK * 256, 256, F[29] + (size_t)L * 256 * DM, DM, pproj, DM, 256);
        k_ple<<<NTOK * DM / 256, 256, 0, stream>>>(h, gate, pproj);
    }
}
```

```cpp
#include <hip/hip_runtime.h>
#include <cstdio>
#include <cstdint>
#include <math.h>

#define NTOK 16384
#define SEQL 8192
#define DM 1024
#define NIN 1536
#define DFF 4096
#define NLAYER 4
constexpr float QSCALE = 0.125f * 1.4426950408889634f;
constexpr float LOG2E = 1.4426950408889634f;

constexpr size_t MiB = 1u << 20;
constexpr size_t WS_CTL = 0, CTL_ZERO_BYTES = 1 * MiB;
constexpr size_t WS_W = 2 * MiB;
constexpr size_t LW_IN = 0, LW_OUT = 3 * MiB, LW_FF1 = 5 * MiB, LW_FF2 = 13 * MiB, LW_GATE = 21 * MiB, LW_PROJ = 23 * MiB, LW_GLU = 23 * MiB + 512 * 1024, LW_STRIDE = 24 * MiB;
constexpr size_t WS_TAB = 98 * MiB;
constexpr size_t TAB_COS = WS_TAB, TAB_SIN = WS_TAB + 2 * MiB, TAB_SSQ0 = WS_TAB + 4 * MiB, TAB_SSQ1 = TAB_SSQ0 + 256 * 1024, TAB_GW = TAB_SSQ1 + 256 * 1024, TAB_SMALL = TAB_GW + 512 * 1024, TAB_END = TAB_SMALL + 64 * 1024;
constexpr int SM_LNG = 0, SM_LNB = 256, SM_QG = 512, SM_KG = 576, SM_SINK = 640, SM_GBS = 1024  , SM_STRIDE = 2048;
constexpr size_t WS_HB = 104 * MiB;
constexpr size_t WS_U = 138 * MiB, WS_VLN = 146 * MiB, WS_Q = 154 * MiB, WS_K = 170 * MiB, WS_V = 174 * MiB, WS_ZC = 178 * MiB;
constexpr size_t WS_YCAT = 186 * MiB;
constexpr size_t WS_HID = 138 * MiB;
constexpr size_t WS_PPROJ = 266 * MiB;
constexpr size_t WS_YF = 218 * MiB;
constexpr size_t WS_YSSM = 282 * MiB;
constexpr size_t WS_PB = 298 * MiB;
constexpr size_t WS_SSM = 306 * MiB;
constexpr size_t SSM_PW = WS_SSM;
constexpr size_t SSM_KT = SSM_PW + 2304 * 1024;
constexpr size_t SSM_BBT = SSM_KT + 2 * MiB;
constexpr size_t SSM_CCT = SSM_BBT + 256 * 1024;
constexpr size_t SSM_BBC = SSM_CCT + 256 * 1024;
constexpr size_t SSM_S = SSM_BBC + 512 * 1024;
constexpr size_t SSM_W1 = SSM_S + 2 * MiB;
constexpr size_t WS_END = SSM_W1 + 2 * MiB;
static_assert(WS_END <= 316 * MiB, "ssm region");
static_assert(TAB_END <= WS_HB && WS_HB + 32 * MiB <= WS_U && WS_HID + 128 * MiB <= WS_PPROJ && WS_YF + 64 * MiB <= WS_YSSM && WS_YSSM + 16 * MiB <= WS_PB, "ws map");
static_assert(WS_W + NLAYER * LW_STRIDE <= WS_TAB, "weights");

typedef float f32x2_t __attribute__((ext_vector_type(2)));
typedef __bf16 bf16x2_t __attribute__((ext_vector_type(2)));
__device__ __forceinline__ unsigned pk2(float lo, float hi) { f32x2_t v = {lo, hi}; bf16x2_t b = __builtin_convertvector(v, bf16x2_t); return __builtin_bit_cast(unsigned, b); }
__device__ __forceinline__ float bf_lo(unsigned w) { return __uint_as_float(w << 16); }
__device__ __forceinline__ float bf_hi(unsigned w) { return __uint_as_float(w & 0xffff0000u); }
__device__ __forceinline__ float bf2f(unsigned short b) { return __uint_as_float(((unsigned)b) << 16); }
template <int X> __device__ __forceinline__ float xor_lane(float v) { return __int_as_float(__builtin_amdgcn_ds_swizzle(__float_as_int(v), (X << 10) | 0x1f)); }
__device__ __forceinline__ float add_xor16(float v) { return v + xor_lane<16>(v); }
__device__ __forceinline__ float add_xor32(float v) { auto r = __builtin_amdgcn_permlane32_swap(__float_as_uint(v), __float_as_uint(v), false, false); return __uint_as_float(r[0]) + __uint_as_float(r[1]); }
__device__ __forceinline__ float wave_sum(float v) {
    v += xor_lane<1>(v); v += xor_lane<2>(v); v += xor_lane<4>(v); v += xor_lane<8>(v); v = add_xor16(v); return add_xor32(v);
}
__device__ __forceinline__ float wave_sum_shfl(float v) {
#pragma unroll
    for (int o = 1; o < 64; o <<= 1) v += __shfl_xor(v, o);
    return v;
}
__device__ __forceinline__ int fresh_lane() { int l; asm volatile("v_mbcnt_lo_u32_b32 %0, -1, 0\n\tv_mbcnt_hi_u32_b32 %0, -1, %0" : "=v"(l)); return l; }
__device__ __forceinline__ float gelu_fast(float x) {
    const float u = x * (1.0f + 0.044715f * x * x);
    const float t = __builtin_amdgcn_exp2f(u * 2.3022082f);
    return x - x * __builtin_amdgcn_rcpf(1.0f + t);
}
__device__ __forceinline__ float sigmoid_fast(float x) { return __builtin_amdgcn_rcpf(1.0f + __builtin_amdgcn_exp2f(-x * LOG2E)); }
__device__ __forceinline__ float gelu_tanh(float x) { const float k0 = 0.7978845608028654f, k1 = 0.044715f; float u = k0 * (x + k1 * x * x * x); return 0.5f * x * (1.0f + tanhf(u)); }
__device__ const double ROPE_INV_REV[32] = {0.15915494309189535, 0.11934937021124886, 0.08949940160889101, 0.06711508300522726, 0.050329212104487035, 0.03774158471741977, 0.0283021958306234, 0.02122365276477766, 0.015915494309189534, 0.011934937021124886, 0.008949940160889102, 0.006711508300522725, 0.005032921210448704, 0.003774158471741977, 0.00283021958306234, 0.0021223652764777662, 0.0015915494309189536, 0.0011934937021124885, 0.0008949940160889102, 0.0006711508300522726, 0.0005032921210448703, 0.00037741584717419774, 0.00028302195830623395, 0.0002122365276477766, 0.00015915494309189535, 0.00011934937021124886, 8.949940160889102e-05, 6.711508300522725e-05, 5.0329212104487035e-05, 3.774158471741978e-05, 2.8302195830623396e-05, 2.122365276477766e-05};
namespace pg8 {
#define PG8_LAS __attribute__((address_space(3)))
typedef unsigned short bf16_t;
typedef short bf16x8 __attribute__((ext_vector_type(8)));
typedef float f32x4 __attribute__((ext_vector_type(4)));
typedef unsigned u32x4 __attribute__((ext_vector_type(4)));
constexpr int BM = 256, BK = 64, HALF = 128, HTB = HALF * BK * 2  , STAGE_BYTES = 8 * HTB, NXCD = 8, WGM = 8;

__host__ __device__ __forceinline__ int lds_byte(int r, int c) { const int st = (r >> 4) * 2 + (c >> 5), rr = r & 15, cc = c & 31, ob = rr * 64 + cc * 2; return st * 1024 + (ob ^ (((ob >> 9) & 1) << 5)); }
__host__ __device__ __forceinline__ void stage_rc(int b, int& R, int& C) { const int st = b / 1024, sb = b % 1024, swz = sb ^ (((sb >> 9) & 1) << 5); R = (st >> 1) * 16 + swz / 64; C = (st & 1) * 32 + (swz % 64) / 2; }
__host__ __device__ __forceinline__ int perm32(int rho) { const int n = rho >> 4, i = rho & 15; return 8 * (i >> 2) + 4 * n + (i & 3); }

struct Unit { int pm, pn; };
struct Gemm { const bf16_t* A; const bf16_t* Bt; int M, N, K; };

struct StaticOrder {
    int nM, nN, nwg, G, c;
    __host__ __device__ void init(int M, int N, int G_, int c_) { nM = M / BM; nN = N / BM; nwg = nM * nN; G = G_; c = c_; }
    __host__ __device__ bool next(int i, Unit& u) const {
        const long L = (long)i * G + c; if (L >= nwg) return false;
        int wgid = (int)L; { const int q = nwg / NXCD, r = nwg % NXCD, xcd = wgid % NXCD, off = wgid / NXCD; wgid = (xcd < r ? xcd * (q + 1) : r * (q + 1) + (xcd - r) * q) + off; }
        const int nig = WGM * nN, gid = wgid / nig, fm = gid * WGM, gsz = (nM - fm) < WGM ? (nM - fm) : WGM;
        u.pm = fm + ((wgid % nig) % gsz); u.pn = (wgid % nig) / gsz; return true;
    }
    __device__ __forceinline__ void a_ready(const Unit&) const {}
    __device__ __forceinline__ void done(const Unit&) const {}
};

template <class Epi, class Sched, bool ALIGN_EPI = false, bool SP2 = false>
__device__ __forceinline__ void gemm_phase(PG8_LAS unsigned char* lds, const Gemm g, const Sched& S, const Epi& E, const int tid) {
    const int wid = __builtin_amdgcn_readfirstlane(tid >> 6), lane = tid & 63, wr = wid >> 2, wc = wid & 3, fr = lane & 15, fq = lane >> 4;
    const int K = g.K, nt = K / BK;
    unsigned voffA[2], voffB[2];
#pragma unroll
    for (int i = 0; i < 2; ++i) { int R, C; stage_rc(tid * 16 + i * 8192, R, C); const int Rb = Epi::PERM ? ((R & ~31) + perm32(R & 31)) : R;
        voffA[i] = (unsigned)(R * K + C) * 2u; voffB[i] = (unsigned)(Rb * K + C) * 2u; }
    const size_t kstep = (size_t)(BK * 2);
    const size_t hstep = (size_t)HALF * K * 2;
    const size_t tstep = 2 * hstep;
    const unsigned ldsw = (unsigned)wid * 1024u;
    const int aoff = lds_byte(wr * 64 + fr, fq * 8), boff = lds_byte(wc * 32 + fr, fq * 8);
#define PG8_SA(b, h) (((b) * 2 + (h)) * HTB)
#define PG8_SB(b, h) ((4 + (b) * 2 + (h)) * HTB)
#define PG8_STAGE(bufoff, gbase, voff) do { _Pragma("unroll") for (int _i = 0; _i < 2; ++_i) \
        __builtin_amdgcn_global_load_lds((const unsigned*)((const char*)(gbase) + (voff)[_i]), (PG8_LAS unsigned*)(lds + (bufoff) + ldsw + _i * 8192), 16, 0, 0); } while (0)
#define PG8_LDA(dst, b, h) do { _Pragma("unroll") for (int m = 0; m < 4; ++m) _Pragma("unroll") for (int k = 0; k < 2; ++k) dst[m][k] = *(const PG8_LAS bf16x8*)(lds + PG8_SA(b, h) + aoff + m * 2048 + k * 1024); } while (0)
#define PG8_LDB(dst, b, h) do { _Pragma("unroll") for (int n = 0; n < 2; ++n) _Pragma("unroll") for (int k = 0; k < 2; ++k) dst[n][k] = *(const PG8_LAS bf16x8*)(lds + PG8_SB(b, h) + boff + n * 2048 + k * 1024); } while (0)
#define PG8_MMA(ai, bj, At, Bt) do { __builtin_amdgcn_s_setprio(1); _Pragma("unroll") for (int m = 0; m < 4; ++m) _Pragma("unroll") for (int n = 0; n < 2; ++n) _Pragma("unroll") for (int k = 0; k < 2; ++k) \
        acc[ai][bj][m][n] = __builtin_amdgcn_mfma_f32_16x16x32_bf16(Bt[n][k], At[m][k], acc[ai][bj][m][n], 0, 0, 0); __builtin_amdgcn_s_setprio(0); } while (0)
#define PG8_WAIT_V(n) asm volatile("s_waitcnt vmcnt(" #n ")" ::: "memory")
#define PG8_WAIT_L(n) asm volatile("s_waitcnt lgkmcnt(" #n ")" ::: "memory")
#define PG8_BAR __builtin_amdgcn_s_barrier()
#define PG8_SCHED __builtin_amdgcn_sched_barrier(0)
    Unit cur, nxt; int ui = 0;
    if (!S.next(0, cur)) return;
    f32x4 acc[2][2][4][2];
#pragma unroll
    for (int a = 0; a < 2; ++a)
#pragma unroll
        for (int b = 0; b < 2; ++b)
#pragma unroll
            for (int m = 0; m < 4; ++m)
#pragma unroll
                for (int n = 0; n < 2; ++n) acc[a][b][m][n] = (f32x4){0.f, 0.f, 0.f, 0.f};
    bf16x8 At[4][2], B0[2][2], B1[2][2];
    const char* cA = (const char*)g.A + (size_t)cur.pm * tstep; const char* cB = (const char*)g.Bt + (size_t)cur.pn * tstep;
    S.a_ready(cur);
    if constexpr (SP2) {
        PG8_STAGE(PG8_SB(0, 0), cB, voffB); PG8_STAGE(PG8_SB(0, 1), cB + hstep, voffB); PG8_STAGE(PG8_SA(0, 0), cA, voffA); PG8_STAGE(PG8_SA(0, 1), cA + hstep, voffA);
        if (wr == 1) PG8_BAR;
        PG8_WAIT_V(2); PG8_BAR;
        PG8_STAGE(PG8_SB(1, 0), cB + kstep, voffB); PG8_STAGE(PG8_SA(1, 0), cA + kstep, voffA); PG8_STAGE(PG8_SB(1, 1), cB + hstep + kstep, voffB);
        PG8_WAIT_V(6); PG8_BAR;
    } else {
        PG8_STAGE(PG8_SB(0, 0), cB, voffB); PG8_STAGE(PG8_SA(0, 0), cA, voffA); PG8_STAGE(PG8_SB(0, 1), cB + hstep, voffB); PG8_STAGE(PG8_SA(0, 1), cA + hstep, voffA);
        if (wr == 1) PG8_BAR;
        PG8_WAIT_V(4); PG8_BAR;
        PG8_STAGE(PG8_SB(1, 0), cB + kstep, voffB); PG8_STAGE(PG8_SA(1, 0), cA + kstep, voffA); PG8_STAGE(PG8_SB(1, 1), cB + hstep + kstep, voffB);
        PG8_WAIT_V(6); PG8_BAR;
    }
    for (;;) {
        const bool has_next = S.next(ui + 1, nxt);
        const char* nA = has_next ? (const char*)g.A + (size_t)nxt.pm * tstep : cA; const char* nB = has_next ? (const char*)g.Bt + (size_t)nxt.pn * tstep : cB;
        for (int t = 0; t < nt; t += 2) {
            const bool last = (t == nt - 2);
            const char* a1 = cA + (size_t)(t + 1) * kstep;
            const char* a2 = last ? nA : cA + (size_t)(t + 2) * kstep; const char* b2 = last ? nB : cB + (size_t)(t + 2) * kstep;
            const char* a3 = a2 + kstep; const char* b3 = b2 + kstep;
            if (last && has_next) S.a_ready(nxt);
            if constexpr (SP2) {
            PG8_LDB(B0, 0, 0); PG8_LDB(B1, 0, 1); PG8_SCHED; PG8_LDA(At, 0, 0); PG8_STAGE(PG8_SA(1, 1), a1 + hstep, voffA);
            PG8_WAIT_V(8); PG8_WAIT_L(0); PG8_BAR; PG8_MMA(0, 0, At, B0); PG8_MMA(0, 1, At, B1); PG8_BAR; PG8_SCHED;
            PG8_LDA(At, 0, 1); PG8_STAGE(PG8_SB(0, 0), b2, voffB); PG8_STAGE(PG8_SB(0, 1), b2 + hstep, voffB); PG8_STAGE(PG8_SA(0, 0), a2, voffA);
            PG8_WAIT_V(8); PG8_WAIT_L(0); PG8_BAR; PG8_MMA(1, 0, At, B0); PG8_MMA(1, 1, At, B1); PG8_BAR; PG8_SCHED;
            PG8_LDB(B0, 1, 0); PG8_LDB(B1, 1, 1); PG8_SCHED; PG8_LDA(At, 1, 0); PG8_STAGE(PG8_SA(0, 1), a2 + hstep, voffA);
            PG8_WAIT_V(8); PG8_WAIT_L(0); PG8_BAR; PG8_MMA(0, 0, At, B0); PG8_MMA(0, 1, At, B1); PG8_BAR; PG8_SCHED;
            PG8_LDA(At, 1, 1); PG8_STAGE(PG8_SB(1, 0), b3, voffB); PG8_STAGE(PG8_SB(1, 1), b3 + hstep, voffB); PG8_STAGE(PG8_SA(1, 0), a3, voffA);
            PG8_WAIT_V(8); PG8_WAIT_L(0); PG8_BAR; PG8_MMA(1, 0, At, B0); PG8_MMA(1, 1, At, B1); PG8_BAR; PG8_SCHED;
            } else {
            PG8_LDB(B0, 0, 0); PG8_SCHED; PG8_LDA(At, 0, 0); PG8_STAGE(PG8_SA(1, 1), a1 + hstep, voffA);
            PG8_WAIT_L(8); PG8_BAR; PG8_WAIT_L(0); PG8_MMA(0, 0, At, B0); PG8_BAR; PG8_SCHED;
            PG8_LDB(B1, 0, 1); PG8_STAGE(PG8_SB(0, 0), b2, voffB);
            PG8_BAR; PG8_WAIT_L(0); PG8_MMA(0, 1, At, B1); PG8_BAR;
            PG8_LDA(At, 0, 1); PG8_STAGE(PG8_SA(0, 0), a2, voffA);
            PG8_BAR; PG8_WAIT_L(0); PG8_MMA(1, 0, At, B0); PG8_BAR; PG8_SCHED;
            PG8_STAGE(PG8_SB(0, 1), b2 + hstep, voffB);
            PG8_WAIT_V(6); PG8_BAR; PG8_MMA(1, 1, At, B1); PG8_BAR;
            PG8_LDB(B0, 1, 0); PG8_SCHED; PG8_LDA(At, 1, 0); PG8_STAGE(PG8_SA(0, 1), a2 + hstep, voffA);
            PG8_WAIT_L(8); PG8_BAR; PG8_WAIT_L(0); PG8_MMA(0, 0, At, B0); PG8_BAR; PG8_SCHED;
            PG8_LDB(B1, 1, 1); PG8_STAGE(PG8_SB(1, 0), b3, voffB);
            PG8_BAR; PG8_WAIT_L(0); PG8_MMA(0, 1, At, B1); PG8_BAR;
            PG8_LDA(At, 1, 1); PG8_STAGE(PG8_SA(1, 0), a3, voffA);
            PG8_BAR; PG8_WAIT_L(0); PG8_MMA(1, 0, At, B0); PG8_BAR; PG8_SCHED;
            PG8_STAGE(PG8_SB(1, 1), b3 + hstep, voffB);
            PG8_WAIT_V(6); PG8_BAR; PG8_MMA(1, 1, At, B1); PG8_BAR;
            }
        }
        if constexpr (ALIGN_EPI) { if (wr == 0) PG8_BAR; }
        if constexpr (!Epi::AFTER_DRAIN) { const int l2 = fresh_lane();
            E(acc, cur, wr, wc, l2 & 15, l2 >> 4); S.done(cur); }
        if (!has_next) break;
#pragma unroll
        for (int a = 0; a < 2; ++a)
#pragma unroll
            for (int b = 0; b < 2; ++b)
#pragma unroll
                for (int m = 0; m < 4; ++m)
#pragma unroll
                    for (int n = 0; n < 2; ++n) acc[a][b][m][n] = (f32x4){0.f, 0.f, 0.f, 0.f};
        cur = nxt; cA = nA; cB = nB; ++ui;
        if constexpr (ALIGN_EPI) { if (wr == 1) PG8_BAR; }
    }
    PG8_WAIT_V(0);
    if constexpr (!ALIGN_EPI) { if (wr == 0) PG8_BAR; }
    PG8_BAR;
    if constexpr (Epi::AFTER_DRAIN) { const int l2 = fresh_lane();
        E.fused(acc, cur, wr, wc, l2 & 15, l2 >> 4, lds, wid, l2); S.done(cur); }
#undef PG8_SA
#undef PG8_SB
#undef PG8_STAGE
#undef PG8_LDA
#undef PG8_LDB
#undef PG8_MMA
#undef PG8_WAIT_V
#undef PG8_WAIT_L
#undef PG8_BAR
#undef PG8_SCHED
}
}
namespace pg8 {
__device__ __forceinline__ float rstd_row(const float* ssq, int row) {
    const float s = (ssq[row] + ssq[NTOK + row]) + (ssq[2 * NTOK + row] + ssq[3 * NTOK + row]);
    return __builtin_amdgcn_rsqf(s * (1.0f / 1024.0f) + 1e-6f);
}
__device__ __forceinline__ void store8(bf16_t* p, const float (&v)[8]) {
    u32x4 w; w.x = pk2(v[0], v[1]); w.y = pk2(v[2], v[3]); w.z = pk2(v[4], v[5]); w.w = pk2(v[6], v[7]); *(u32x4*)p = w;
}
struct EpiIn {
    static constexpr bool PERM = false, AFTER_DRAIN = false;
    unsigned char* ws; int par, L;
    __device__ __forceinline__ void operator()(const f32x4 (&acc)[2][2][4][2], const Unit& u, int wr, int wc, int fr, int fq) const {
        const int pn = u.pn;
        const float* ssq = (const float*)(ws + (par ? TAB_SSQ1 : TAB_SSQ0)); const float* cosT = (const float*)(ws + TAB_COS); const float* sinT = (const float*)(ws + TAB_SIN);
        const float* sm = (const float*)(ws + TAB_SMALL) + L * SM_STRIDE; const float* lng = sm + SM_LNG; const float* lnb = sm + SM_LNB; const float* qg = sm + SM_QG; const float* kg = sm + SM_KG;
        bf16_t* U = (bf16_t*)(ws + WS_U); bf16_t* VLN = (bf16_t*)(ws + WS_VLN); bf16_t* Q = (bf16_t*)(ws + WS_Q); bf16_t* K = (bf16_t*)(ws + WS_K); bf16_t* V = (bf16_t*)(ws + WS_V); bf16_t* ZC = (bf16_t*)(ws + WS_ZC);
        int mode, ld, cb; bf16_t* dst; const float* gp = nullptr; const float* bp = nullptr;
        if (pn < 2) { const int head = 2 * pn + (wc >> 1); ld = 256; cb = head * 64; if (wc & 1) { mode = 1; dst = VLN; gp = lng + head * 64; bp = lnb + head * 64; } else { mode = 0; dst = U; } }
        else if (pn < 4) { mode = 2; dst = Q; ld = 512; cb = (4 * (pn - 2) + wc) * 64; gp = qg; }
        else if (pn == 4) { ld = 128; if (wc < 2) { mode = 3; dst = K; cb = wc * 64; gp = kg; } else { mode = 4; dst = V; cb = (wc - 2) * 64; } }
        else { mode = 4; dst = ZC; ld = 256; cb = wc * 64; }
        float g[16], bb[16];
#pragma unroll
        for (int i = 0; i < 16; ++i) { g[i] = 1.f; bb[i] = 0.f; }
        if (gp) {
#pragma unroll
            for (int bj = 0; bj < 2; ++bj)
#pragma unroll
                for (int n = 0; n < 2; ++n) { const f32x4 t = *(const f32x4*)(gp + 32 * bj + 8 * fq + 4 * n); g[bj * 8 + n * 4 + 0] = t[0]; g[bj * 8 + n * 4 + 1] = t[1]; g[bj * 8 + n * 4 + 2] = t[2]; g[bj * 8 + n * 4 + 3] = t[3]; }
        }
        if (bp) {
#pragma unroll
            for (int bj = 0; bj < 2; ++bj)
#pragma unroll
                for (int n = 0; n < 2; ++n) { const f32x4 t = *(const f32x4*)(bp + 32 * bj + 8 * fq + 4 * n); bb[bj * 8 + n * 4 + 0] = t[0]; bb[bj * 8 + n * 4 + 1] = t[1]; bb[bj * 8 + n * 4 + 2] = t[2]; bb[bj * 8 + n * 4 + 3] = t[3]; }
        }
#pragma unroll
        for (int ai = 0; ai < 2; ++ai)
#pragma unroll
            for (int m = 0; m < 4; ++m) {
                const int row = u.pm * BM + ai * HALF + wr * 64 + m * 16 + fr;
                const float rs = rstd_row(ssq, row);
                float v[16];
#pragma unroll
                for (int bj = 0; bj < 2; ++bj)
#pragma unroll
                    for (int n = 0; n < 2; ++n)
#pragma unroll
                        for (int j = 0; j < 4; ++j) v[bj * 8 + n * 4 + j] = acc[ai][bj][m][n][j] * rs;
                if (mode <= 1) {
#pragma unroll
                    for (int i = 0; i < 16; ++i) v[i] = gelu_fast(v[i]);
                    if (mode == 1) {
                        float s = 0.f;
#pragma unroll
                        for (int i = 0; i < 16; ++i) s += v[i];
                        s = add_xor16(s); s = add_xor32(s);
                        const float mu = s * (1.0f / 64.0f); float q = 0.f;
#pragma unroll
                        for (int i = 0; i < 16; ++i) { v[i] -= mu; q += v[i] * v[i]; }
                        q = add_xor16(q); q = add_xor32(q);
                        const float r = __builtin_amdgcn_rsqf(q * (1.0f / 64.0f) + 1e-6f);
#pragma unroll
                        for (int i = 0; i < 16; ++i) v[i] = v[i] * r * g[i] + bb[i];
                    }
                } else if (mode <= 3) {
                    float q = 0.f;
#pragma unroll
                    for (int i = 0; i < 16; ++i) q += v[i] * v[i];
                    q = add_xor16(q); q = add_xor32(q);
                    const float r = __builtin_amdgcn_rsqf(q * (1.0f / 64.0f) + 1e-6f) * (mode == 2 ? QSCALE : 1.0f);
#pragma unroll
                    for (int i = 0; i < 16; ++i) v[i] = v[i] * r * g[i];
                    const float* cp = cosT + (size_t)row * 32 + 8 * fq; const float* sp = sinT + (size_t)row * 32 + 8 * fq;
#pragma unroll
                    for (int n = 0; n < 2; ++n) { const f32x4 c4 = *(const f32x4*)(cp + 4 * n), s4 = *(const f32x4*)(sp + 4 * n);
#pragma unroll
                        for (int j = 0; j < 4; ++j) { const float x1 = v[n * 4 + j], x2 = v[8 + n * 4 + j]; v[n * 4 + j] = x1 * c4[j] - x2 * s4[j]; v[8 + n * 4 + j] = x2 * c4[j] + x1 * s4[j]; } }
                }
                bf16_t* rp = dst + (size_t)row * ld + cb + 8 * fq;
                { float t[8];
#pragma unroll
                  for (int i = 0; i < 8; ++i) t[i] = v[i];
                  store8(rp, t);
#pragma unroll
                  for (int i = 0; i < 8; ++i) t[i] = v[8 + i];
                  store8(rp + 32, t); }
            }
    }
};
struct EpiFF1 {
    static constexpr bool PERM = false, AFTER_DRAIN = false;
    unsigned char* ws; int par;
    __device__ __forceinline__ void operator()(const f32x4 (&acc)[2][2][4][2], const Unit& u, int wr, int wc, int fr, int fq) const {
        const float* ssq = (const float*)(ws + (par ? TAB_SSQ1 : TAB_SSQ0)); bf16_t* HID = (bf16_t*)(ws + WS_HID);
#pragma unroll
        for (int ai = 0; ai < 2; ++ai)
#pragma unroll
            for (int m = 0; m < 4; ++m) {
                const int row = u.pm * BM + ai * HALF + wr * 64 + m * 16 + fr;
                const float rs = rstd_row(ssq, row);
                bf16_t* rp = HID + (size_t)row * DFF + u.pn * BM + wc * 64 + 8 * fq;
#pragma unroll
                for (int bj = 0; bj < 2; ++bj) { float t[8];
#pragma unroll
                    for (int n = 0; n < 2; ++n)
#pragma unroll
                        for (int j = 0; j < 4; ++j) { float x = acc[ai][bj][m][n][j] * rs; x = x > 0.f ? x : 0.f; t[n * 4 + j] = x * x; }
                    store8(rp + 32 * bj, t); }
            }
    }
};
struct EpiProj {
    static constexpr bool PERM = false, AFTER_DRAIN = false;
    unsigned char* ws;
    __device__ __forceinline__ void operator()(const f32x4 (&acc)[2][2][4][2], const Unit& u, int wr, int wc, int fr, int fq) const {
        bf16_t* O = (bf16_t*)(ws + WS_PPROJ);
#pragma unroll
        for (int ai = 0; ai < 2; ++ai)
#pragma unroll
            for (int m = 0; m < 4; ++m) {
                const int row = u.pm * BM + ai * HALF + wr * 64 + m * 16 + fr;
                bf16_t* rp = O + (size_t)row * DM + u.pn * BM + wc * 64 + 8 * fq;
#pragma unroll
                for (int bj = 0; bj < 2; ++bj) { float t[8];
#pragma unroll
                    for (int n = 0; n < 2; ++n)
#pragma unroll
                        for (int j = 0; j < 4; ++j) t[n * 4 + j] = acc[ai][bj][m][n][j];
                    store8(rp + 32 * bj, t); }
            }
    }
};
template <bool GATED> struct EpiRes {
    static constexpr bool PERM = false, AFTER_DRAIN = true;
    float* h; unsigned char* ws; int par_out;
    __device__ __forceinline__ void fused(f32x4 (&acc)[2][2][4][2], const Unit& u, int wr, int wc, int fr, int fq, PG8_LAS unsigned char* lds, int wid, int lane) const {
        bf16_t* HBo = (bf16_t*)(ws + (GATED ? WS_YCAT : WS_HB)); float* ssq_out = (float*)(ws + (par_out ? TAB_SSQ1 : TAB_SSQ0));
        const float* ssq_in = (const float*)(ws + (par_out ? TAB_SSQ0 : TAB_SSQ1)); const bf16_t* PP = (const bf16_t*)(ws + WS_PPROJ);
        PG8_LAS float* P = (PG8_LAS float*)lds;
        const int cb = u.pn * BM + wc * 64 + 8 * fq;
#pragma unroll
        for (int ai = 0; ai < 2; ++ai)
#pragma unroll
            for (int m = 0; m < 4; ++m) {
                const int rl = ai * HALF + wr * 64 + m * 16 + fr, row = u.pm * BM + rl;
                float* hp = h + (size_t)row * DM + cb;
                float rs = 1.f; if (GATED) rs = rstd_row(ssq_in, row);
                float ss = 0.f;
#pragma unroll
                for (int bj = 0; bj < 2; ++bj) {
                    f32x4 o0 = *(const f32x4*)(hp + 32 * bj), o1 = *(const f32x4*)(hp + 32 * bj + 4);
                    f32x4 a0 = acc[ai][bj][m][0], a1 = acc[ai][bj][m][1];
                    if (GATED) {
                        const u32x4 pw = *(const u32x4*)(PP + (size_t)row * DM + cb + 32 * bj);
                        a0[0] = sigmoid_fast(a0[0] * rs) * bf_lo(pw.x); a0[1] = sigmoid_fast(a0[1] * rs) * bf_hi(pw.x);
                        a0[2] = sigmoid_fast(a0[2] * rs) * bf_lo(pw.y); a0[3] = sigmoid_fast(a0[3] * rs) * bf_hi(pw.y);
                        a1[0] = sigmoid_fast(a1[0] * rs) * bf_lo(pw.z); a1[1] = sigmoid_fast(a1[1] * rs) * bf_hi(pw.z);
                        a1[2] = sigmoid_fast(a1[2] * rs) * bf_lo(pw.w); a1[3] = sigmoid_fast(a1[3] * rs) * bf_hi(pw.w);
                    }
                    o0 += a0; o1 += a1;
                    *(f32x4*)(hp + 32 * bj) = o0; *(f32x4*)(hp + 32 * bj + 4) = o1;
                    ss += (o0[0] * o0[0] + o0[1] * o0[1]) + (o0[2] * o0[2] + o0[3] * o0[3]) + (o1[0] * o1[0] + o1[1] * o1[1]) + (o1[2] * o1[2] + o1[3] * o1[3]);
                    float t[8] = {o0[0], o0[1], o0[2], o0[3], o1[0], o1[1], o1[2], o1[3]};
                    store8(HBo + (size_t)row * DM + cb + 32 * bj, t);
                }
                ss = add_xor16(ss); ss = add_xor32(ss);
                if (fq == 0) P[rl * 4 + wc] = ss;
                asm volatile("" ::: "memory");
            }
        asm volatile("s_waitcnt lgkmcnt(0)" ::: "memory"); __builtin_amdgcn_s_barrier(); asm volatile("" ::: "memory");
        const int tid = wid * 64 + lane;
        if (tid < 256) ssq_out[u.pn * NTOK + u.pm * BM + tid] = (P[tid * 4] + P[tid * 4 + 1]) + (P[tid * 4 + 2] + P[tid * 4 + 3]);
        asm volatile("s_waitcnt lgkmcnt(0)" ::: "memory"); __builtin_amdgcn_s_barrier(); asm volatile("" ::: "memory");
    }
};
}
typedef unsigned short bf16;
#define LAS __attribute__((address_space(3)))
typedef unsigned v4u __attribute__((ext_vector_type(4)));
typedef unsigned v2u __attribute__((ext_vector_type(2)));
typedef float f32x4 __attribute__((ext_vector_type(4)));
typedef short bf16x8 __attribute__((ext_vector_type(8)));
typedef short s16x4 __attribute__((ext_vector_type(4)));
constexpr int NWAVES = 8;
__device__ __forceinline__ float max_xor16(float v) { return fmaxf(v, xor_lane<16>(v)); }
__device__ __forceinline__ float max_xor32(float v) { auto r = __builtin_amdgcn_permlane32_swap(__float_as_uint(v), __float_as_uint(v), false, false); return fmaxf(__uint_as_float(r[0]), __uint_as_float(r[1])); }
__device__ __forceinline__ bf16x8 tr_frag(LAS const unsigned char* p, LAS const unsigned char* p2) {
    const s16x4 lo = __builtin_bit_cast(s16x4, __builtin_amdgcn_ds_read_tr16_b64_v4i16((LAS s16x4*)p));
    const s16x4 hi = __builtin_bit_cast(s16x4, __builtin_amdgcn_ds_read_tr16_b64_v4i16((LAS s16x4*)p2));
    return (bf16x8){lo[0], lo[1], lo[2], lo[3], hi[0], hi[1], hi[2], hi[3]};
}
#define WG_BARRIER() do { asm volatile("s_waitcnt vmcnt(0) lgkmcnt(0)" ::: "memory"); __builtin_amdgcn_s_barrier(); asm volatile("" ::: "memory"); } while (0)

constexpr int GM_ROWB = 528;
constexpr int GM_SS = 128 * GM_ROWB;
__device__ __forceinline__ void gmlp_item(unsigned char* ws, int L, LAS unsigned char* lds, int item, int wv, int lane_unused) {
    const int lane = fresh_lane();
    const int tok0 = item * 128, tid = wv * 64 + lane;
    const bf16* VLN = (const bf16*)(ws + WS_VLN); const bf16* U = (const bf16*)(ws + WS_U); bf16* YC = (bf16*)(ws + WS_YCAT);
    const bf16* GW = (const bf16*)(ws + TAB_GW) + (size_t)L * 4 * 128 * 128;
    const float* bsv = (const float*)(ws + TAB_SMALL) + L * SM_STRIDE + SM_GBS;
    for (int q = tid; q < 128 * 32; q += NWAVES * 64) { const int s = q >> 5, c = q & 31;
        const v4u x = *(const v4u*)(VLN + (size_t)(tok0 + s) * 256 + c * 8); *(LAS v4u*)(lds + s * GM_ROWB + c * 16) = x; }
    WG_BARRIER();
    const int h = wv >> 1, th = wv & 1, fr = lane & 15, g4 = lane >> 4;
    f32x4 acc[4][4];
#pragma unroll
    for (int m = 0; m < 4; ++m)
#pragma unroll
        for (int n = 0; n < 4; ++n) acc[m][n] = (f32x4){0.f, 0.f, 0.f, 0.f};
#pragma unroll
    for (int m = 0; m < 4; ++m) {
        const int t0 = 64 * th + 16 * m, nks = (t0 >> 5) + 1;
        for (int ks = 0; ks < nks; ++ks) {
            const int s0 = 32 * ks;
            const bf16x8 wf = *(const bf16x8*)(GW + ((size_t)h * 128 + t0 + fr) * 128 + s0 + 8 * g4);
#pragma unroll
            for (int n = 0; n < 4; ++n) {
                LAS const unsigned char* p = lds + (s0 + 8 * g4 + (fr >> 2)) * GM_ROWB + (h * 64 + 16 * n + 4 * (fr & 3)) * 2;
                const bf16x8 vf = tr_frag(p, p + 4 * GM_ROWB);
                acc[m][n] = __builtin_amdgcn_mfma_f32_16x16x32_bf16(vf, wf, acc[m][n], 0, 0, 0);
            }
        }
    }
    LAS float* SS = (LAS float*)(lds + GM_SS);
#pragma unroll
    for (int m = 0; m < 4; ++m) {
        const int t = 64 * th + 16 * m + fr; const float bb = bsv[h * 128 + t]; float ss = 0.f;
#pragma unroll
        for (int n = 0; n < 4; ++n) {
            const v2u uw = *(const v2u*)(U + (size_t)(tok0 + t) * 256 + h * 64 + 16 * n + 4 * g4);
            f32x4 y; y[0] = bf_lo(uw.x) * (acc[m][n][0] + bb); y[1] = bf_hi(uw.x) * (acc[m][n][1] + bb); y[2] = bf_lo(uw.y) * (acc[m][n][2] + bb); y[3] = bf_hi(uw.y) * (acc[m][n][3] + bb);
            acc[m][n] = y; ss += (y[0] * y[0] + y[1] * y[1]) + (y[2] * y[2] + y[3] * y[3]);
        }
        ss = add_xor16(ss); ss = add_xor32(ss);
        if (g4 == 0) SS[h * 128 + t] = ss;
    }
    WG_BARRIER();
#pragma unroll
    for (int m = 0; m < 4; ++m) {
        const int t = 64 * th + 16 * m + fr;
        const float tot = (SS[t] + SS[128 + t]) + (SS[256 + t] + SS[384 + t]);
        const float r = __builtin_amdgcn_rsqf(tot * (1.0f / 256.0f) + 1e-6f);
#pragma unroll
        for (int n = 0; n < 4; ++n) { v2u o; o.x = pk2(acc[m][n][0] * r, acc[m][n][1] * r); o.y = pk2(acc[m][n][2] * r, acc[m][n][3] * r);
            *(v2u*)(YC + (size_t)(tok0 + t) * DM + h * 64 + 16 * n + 4 * g4) = o; }
    }
    WG_BARRIER();
}

constexpr int AT_ROWB = 272;
constexpr int AT_V = 192 * AT_ROWB, AT_SS = 2 * 192 * AT_ROWB;
__device__ __forceinline__ void attn_item(unsigned char* ws, int L, LAS unsigned char* lds, int item, int wv, int lane_unused) {
    const int lane = fresh_lane();
    const int b = item >> 7, q0 = (item & 127) * 64, tokb = b * SEQL, tid = wv * 64 + lane;
    const bf16* Q = (const bf16*)(ws + WS_Q); const bf16* K = (const bf16*)(ws + WS_K); const bf16* V = (const bf16*)(ws + WS_V); bf16* YC = (bf16*)(ws + WS_YCAT);
    for (int q = tid; q < 192 * 16; q += NWAVES * 64) { const int r = q >> 4, c = q & 15, j = q0 - 128 + r;
        v4u kx = (v4u){0u, 0u, 0u, 0u}, vx = kx;
        if (j >= 0) { kx = *(const v4u*)(K + (size_t)(tokb + j) * 128 + c * 8); vx = *(const v4u*)(V + (size_t)(tokb + j) * 128 + c * 8); }
        *(LAS v4u*)(lds + r * AT_ROWB + c * 16) = kx; *(LAS v4u*)(lds + AT_V + r * AT_ROWB + c * 16) = vx; }
    WG_BARRIER();
    const int hq = wv, hkv = wv >> 2, fr = lane & 15, g4 = lane >> 4;
    const float sink2 = ((const float*)(ws + TAB_SMALL))[L * SM_STRIDE + SM_SINK + hq] * LOG2E;
    LAS float* SS = (LAS float*)(lds + AT_SS);
    for (int qt = 0; qt < 4; ++qt) {
        const size_t tq = (size_t)(tokb + q0 + 16 * qt + fr);
        bf16x8 qf[2];
#pragma unroll
        for (int ks = 0; ks < 2; ++ks) qf[ks] = *(const bf16x8*)(Q + tq * 512 + hq * 64 + 32 * ks + 8 * g4);
        f32x4 s[12];
#pragma unroll
        for (int kt = 0; kt < 12; ++kt) { s[kt] = (f32x4){0.f, 0.f, 0.f, 0.f};
#pragma unroll
            for (int ks = 0; ks < 2; ++ks) { const bf16x8 kf = *(LAS const bf16x8*)(lds + (16 * kt + fr) * AT_ROWB + (hkv * 64 + 32 * ks + 8 * g4) * 2);
                s[kt] = __builtin_amdgcn_mfma_f32_16x16x32_bf16(kf, qf[ks], s[kt], 0, 0, 0); } }
        const int diff0 = 128 + 16 * qt + fr - 4 * g4, j0 = q0 - 128 + 4 * g4;
        float mx = -INFINITY;
#pragma unroll
        for (int kt = 0; kt < 12; ++kt)
#pragma unroll
            for (int r = 0; r < 4; ++r) { const int diff = diff0 - 16 * kt - r; const bool ok = (diff >= 0) && (diff < 128) && (j0 + 16 * kt + r >= 0);
                s[kt][r] = ok ? s[kt][r] : -INFINITY; mx = fmaxf(mx, s[kt][r]); }
        mx = max_xor16(mx); mx = max_xor32(mx); mx = fmaxf(mx, sink2);
        float sum = 0.f;
#pragma unroll
        for (int kt = 0; kt < 12; ++kt)
#pragma unroll
            for (int r = 0; r < 4; ++r) { s[kt][r] = __builtin_amdgcn_exp2f(s[kt][r] - mx); sum += s[kt][r]; }
        sum = add_xor16(sum); sum = add_xor32(sum); sum += __builtin_amdgcn_exp2f(sink2 - mx);
        const float inv_l = __builtin_amdgcn_rcpf(sum);
        f32x4 o[4];
#pragma unroll
        for (int dt = 0; dt < 4; ++dt) o[dt] = (f32x4){0.f, 0.f, 0.f, 0.f};
#pragma unroll
        for (int kk = 0; kk < 6; ++kk) {
            v4u pw; pw.x = pk2(s[2 * kk][0], s[2 * kk][1]); pw.y = pk2(s[2 * kk][2], s[2 * kk][3]); pw.z = pk2(s[2 * kk + 1][0], s[2 * kk + 1][1]); pw.w = pk2(s[2 * kk + 1][2], s[2 * kk + 1][3]);
            const bf16x8 pf = __builtin_bit_cast(bf16x8, pw);
#pragma unroll
            for (int dt = 0; dt < 4; ++dt) {
                LAS const unsigned char* p = lds + AT_V + (32 * kk + 4 * g4 + (fr >> 2)) * AT_ROWB + (hkv * 64 + 16 * dt + 4 * (fr & 3)) * 2;
                const bf16x8 vf = tr_frag(p, p + 16 * AT_ROWB);
                o[dt] = __builtin_amdgcn_mfma_f32_16x16x32_bf16(vf, pf, o[dt], 0, 0, 0);
            }
        }
        float ss = 0.f;
#pragma unroll
        for (int dt = 0; dt < 4; ++dt) { o[dt] = o[dt] * inv_l; ss += (o[dt][0] * o[dt][0] + o[dt][1] * o[dt][1]) + (o[dt][2] * o[dt][2] + o[dt][3] * o[dt][3]); }
        ss = add_xor16(ss); ss = add_xor32(ss);
        if (g4 == 0) SS[hq * 64 + 16 * qt + fr] = ss;
        WG_BARRIER();
        float tot = 0.f;
#pragma unroll
        for (int hh = 0; hh < 8; ++hh) tot += SS[hh * 64 + 16 * qt + fr];
        const float r = __builtin_amdgcn_rsqf(tot * (1.0f / 512.0f) + 1e-6f);
#pragma unroll
        for (int dt = 0; dt < 4; ++dt) { v2u ow; ow.x = pk2(o[dt][0] * r, o[dt][1] * r); ow.y = pk2(o[dt][2] * r, o[dt][3] * r);
            *(v2u*)(YC + tq * DM + 256 + hq * 64 + 16 * dt + 4 * g4) = ow; }
    }
    WG_BARRIER();
}
__device__ __forceinline__ double d_exp(double x) {
    const double k = __builtin_rint(x * 1.4426950408889634), r = x - k * 0.6931471805599453;
    double e = 1.0, term = 1.0;
    for (int n = 1; n <= 20; ++n) { term *= r / (double)n; e += term; }
    const long long bits = (long long)(1023 + (int)k) << 52;
    return e * __builtin_bit_cast(double, bits);
}
__device__ __forceinline__ void d_sincos(double th, double& sn, double& cs) {
    const double q = __builtin_rint(th * 0.15915494309189535), r = th - q * 6.283185307179586, r2 = -r * r;
    double s = r, c = 1.0, ts = r, tc = 1.0;
    for (int n = 1; n <= 14; ++n) { tc *= r2 / (double)((2 * n - 1) * (2 * n)); c += tc; ts *= r2 / (double)((2 * n) * (2 * n + 1)); s += ts; }
    sn = s; cs = c;
}
__device__ __forceinline__ void ssm_tables(const float* const* in, unsigned char* ws, int gtid, int nthreads) {
    for (int i = gtid; i < NLAYER * 16 * 64; i += nthreads) {
        const int p = i & 63, lg = i >> 6;
        const double lre = in[12][i], lim = in[13][i], dt = d_exp((double)in[14][lg]);
        const double er = d_exp(lre * dt); double sn, cs; d_sincos(lim * dt, sn, cs);
        const double lbr = er * cs, lbi = er * sn;
        const double nr = lbr - 1.0, ni = lbi, den = lre * lre + lim * lim;
        const double fr_ = (nr * lre + ni * lim) / den, fi_ = (ni * lre - nr * lim) / den;
        float* bbc = (float*)(ws + SSM_BBC) + (size_t)i * 32; bf16* bbt = (bf16*)(ws + SSM_BBT) + (size_t)lg * 128 * 16;
        for (int h = 0; h < 16; ++h) { const double br = in[15][i * 16 + h], bi = in[16][i * 16 + h]; const float re = (float)(fr_ * br - fi_ * bi), im = (float)(fr_ * bi + fi_ * br);
            bbc[2 * h] = re; bbc[2 * h + 1] = im; bbt[p * 16 + h] = (bf16)(pk2(re, 0.f) & 0xffffu); bbt[(64 + p) * 16 + h] = (bf16)(pk2(im, 0.f) & 0xffffu); }
        bf16* cct = (bf16*)(ws + SSM_CCT) + (size_t)lg * 16 * 128;
        for (int hp = 0; hp < 16; ++hp) { const float cre = in[17][(lg * 16 + hp) * 64 + p], cim = in[18][(lg * 16 + hp) * 64 + p]; *(unsigned*)(cct + hp * 128 + 2 * p) = pk2(cre, -cim); }
        float* pw = (float*)(ws + SSM_PW) + (size_t)lg * 65 * 128;
        double xr = 1.0, xi = 0.0;
        float* w1 = (float*)(ws + SSM_W1) + (size_t)lg * 8192;
        for (int n = 0; n <= 64; ++n) { pw[(n * 64 + p) * 2] = (float)xr; pw[(n * 64 + p) * 2 + 1] = (float)xi;
            if (n < 64) { const int t = 63 - n, ln = ((t >> 2) & 3) * 16 + (p & 15), o = ((ln * 16 + (t >> 4) * 4 + (t & 3)) * 4 + (p >> 4)) * 2; w1[o] = (float)xr; w1[o + 1] = (float)xi; }
            const double t = xr * lbr - xi * lbi; xi = xr * lbi + xi * lbr; xr = t; }
    }
}
__device__ __forceinline__ void ssm_ktable(const float* const* in, unsigned char* ws, int gtid, int nthreads) {
    bf16* KT = (bf16*)(ws + SSM_KT);
    for (int i = gtid; i < NLAYER * 16 * 64 * 256; i += nthreads) {
        const int h = i & 15, hp = (i >> 4) & 15, tau = (i >> 8) & 63, lg = i >> 14;
        const float* pw = (const float*)(ws + SSM_PW) + ((size_t)lg * 65 + tau) * 128; const float* bbc = (const float*)(ws + SSM_BBC) + (size_t)lg * 64 * 32 + 2 * h;
        const float* cre = in[17] + (size_t)(lg * 16 + hp) * 64; const float* cim = in[18] + (size_t)(lg * 16 + hp) * 64;
        float acc = 0.f;
        for (int p = 0; p < 64; ++p) { const float zr = pw[2 * p], zi = pw[2 * p + 1], br = bbc[p * 32], bi = bbc[p * 32 + 1];
            acc += cre[p] * (zr * br - zi * bi) - cim[p] * (zr * bi + zi * br); }
        if (tau == 0 && h == hp) acc += in[19][lg * 16 + hp];
        KT[i] = (bf16)(pk2(acc, 0.f) & 0xffffu);
    }
}
__device__ __forceinline__ void ssm1_item(unsigned char* ws, int L, int item, int wv, int lane_unused) {
    const int tok0 = item * 64;
    const bf16* ZC = (const bf16*)(ws + WS_ZC); float* S = (float*)(ws + SSM_S);
    const bf16x8 zero8 = (bf16x8){0, 0, 0, 0, 0, 0, 0, 0};
    for (int gi = 0; gi < 2; ++gi) {
        const int g = 2 * wv + gi, lg = L * 16 + g;
        const int lane = fresh_lane(), fr = lane & 15, g4 = lane >> 4;
        const bf16* bbt = (const bf16*)(ws + SSM_BBT) + (size_t)lg * 128 * 16; const float* w1 = (const float*)(ws + SSM_W1) + (size_t)lg * 8192 + lane * 128;
        bf16x8 bfr[8];
#pragma unroll
        for (int n = 0; n < 8; ++n) bfr[n] = (g4 < 2) ? *(const bf16x8*)(bbt + (16 * n + fr) * 16 + 8 * g4) : zero8;
        float sre[4] = {0.f, 0.f, 0.f, 0.f}, sim[4] = {0.f, 0.f, 0.f, 0.f};
#pragma unroll
        for (int m = 0; m < 4; ++m) {
            const bf16x8 uf = (g4 < 2) ? *(const bf16x8*)(ZC + (size_t)(tok0 + 16 * m + fr) * 256 + g * 16 + 8 * g4) : zero8;
            f32x4 d[8];
#pragma unroll
            for (int n = 0; n < 8; ++n) d[n] = __builtin_amdgcn_mfma_f32_16x16x32_bf16(uf, bfr[n], (f32x4){0.f, 0.f, 0.f, 0.f}, 0, 0, 0);
#pragma unroll
            for (int r = 0; r < 4; ++r) { const f32x4 wa = *(const f32x4*)(w1 + (m * 4 + r) * 8), wb = *(const f32x4*)(w1 + (m * 4 + r) * 8 + 4);
                const float wre[4] = {wa[0], wa[2], wb[0], wb[2]}, wim[4] = {wa[1], wa[3], wb[1], wb[3]};
#pragma unroll
                for (int q = 0; q < 4; ++q) { const float br = d[q][r], bi = d[q + 4][r];
                    sre[q] += wre[q] * br - wim[q] * bi; sim[q] += wre[q] * bi + wim[q] * br; } }
        }
#pragma unroll
        for (int q = 0; q < 4; ++q) { sre[q] = add_xor16(sre[q]); sre[q] = add_xor32(sre[q]); sim[q] = add_xor16(sim[q]); sim[q] = add_xor32(sim[q]);
            if (g4 == 0) *(f32x2_t*)(S + ((size_t)(item * 16 + g) * 64 + 16 * q + fr) * 2) = (f32x2_t){sre[q], sim[q]}; }
    }
}
constexpr int S2_ROWB = 528, S2_XIN = 80 * S2_ROWB, S2_YT = S2_XIN + 8192, S2_SS = S2_YT + 64 * S2_ROWB;
__device__ __forceinline__ void ssm2_item(unsigned char* ws, int L, LAS unsigned char* lds, int item, int wv, int lane_unused) {
    const int lane = fresh_lane();
    const int tok0 = item * 64, b = item >> 7, c = item & 127, tid = wv * 64 + lane, fr = lane & 15, g4 = lane >> 4;
    const bf16* ZC = (const bf16*)(ws + WS_ZC); const float* S = (const float*)(ws + SSM_S);
    for (int q = tid; q < 80 * 32; q += NWAVES * 64) { const int r = q >> 5, cc = q & 31; v4u x = (v4u){0u, 0u, 0u, 0u};
        if (r >= 16) x = *(const v4u*)(ZC + (size_t)(tok0 + r - 16) * 256 + cc * 8);
        *(LAS v4u*)(lds + r * S2_ROWB + cc * 16) = x; }
#pragma unroll
    for (int k = 0; k < 2; ++k) { const int ch = tid + 512 * k, g = ch >> 6, p = ch & 63;
        const f32x2_t lam = *(const f32x2_t*)((const float*)(ws + SSM_PW) + ((size_t)(L * 16 + g) * 65 + 64) * 128 + 2 * p);
        float xr = 0.f, xi = 0.f; const float* sp = S + ((size_t)(b * 128) * 1024 + ch) * 2;
#pragma unroll 16
        for (int cp = 0; cp < c; ++cp) { const f32x2_t s = *(const f32x2_t*)(sp + (size_t)cp * 2048); const float t = lam[0] * xr - lam[1] * xi + s[0]; xi = lam[0] * xi + lam[1] * xr + s[1]; xr = t; }
        *(LAS f32x2_t*)(lds + S2_XIN + ch * 8) = (f32x2_t){xr, xi}; }
    WG_BARRIER();
    float* yssm = (float*)(ws + WS_YSSM);
    for (int gi = 0; gi < 2; ++gi) {
        const int g = 2 * wv + gi, lg = L * 16 + g;
        int fr, g4; { const int l2 = fresh_lane(); fr = l2 & 15; g4 = l2 >> 4; }
        const bf16* kt = (const bf16*)(ws + SSM_KT) + (size_t)lg * 64 * 256 + fr * 16 + 8 * (g4 & 1);
        LAS const unsigned char* ub = lds + (16 + fr - (g4 >> 1)) * S2_ROWB + (g * 16 + 8 * (g4 & 1)) * 2;
        f32x4 acc[4];
#pragma unroll
        for (int m = 0; m < 4; ++m) acc[m] = (f32x4){0.f, 0.f, 0.f, 0.f};
#pragma unroll
        for (int seg = 0; seg < 4; ++seg)
            for (int lp = 8 * seg; lp < 8 * seg + 8; ++lp) {
                const bf16x8 kf = *(const bf16x8*)(kt + (2 * lp + (g4 >> 1)) * 256);
#pragma unroll
                for (int m = seg; m < 4; ++m) { const bf16x8 uf = *(LAS const bf16x8*)(ub + (16 * m - 2 * lp) * S2_ROWB); acc[m] = __builtin_amdgcn_mfma_f32_16x16x32_bf16(uf, kf, acc[m], 0, 0, 0); }
            }
        { const int l2 = fresh_lane(); fr = l2 & 15; g4 = l2 >> 4; }
        const bf16* cct = (const bf16*)(ws + SSM_CCT) + (size_t)lg * 16 * 128 + fr * 128 + 8 * g4;
        const float* pwg = (const float*)(ws + SSM_PW) + (size_t)lg * 65 * 128;
#pragma unroll
        for (int ks = 0; ks < 4; ++ks) {
            const bf16x8 cf = *(const bf16x8*)(cct + 32 * ks);
            const int p4 = 16 * ks + 4 * g4;
            const f32x4 x01 = *(LAS const f32x4*)(lds + S2_XIN + (g * 64 + p4) * 8), x23 = *(LAS const f32x4*)(lds + S2_XIN + (g * 64 + p4) * 8 + 16);
#pragma unroll
            for (int m = 0; m < 4; ++m) {
                const float* w = pwg + ((size_t)(16 * m + fr + 1) * 64 + p4) * 2;
                const f32x4 w01 = *(const f32x4*)w, w23 = *(const f32x4*)(w + 4);
                v4u zw; zw.x = pk2(w01[0] * x01[0] - w01[1] * x01[1], w01[0] * x01[1] + w01[1] * x01[0]); zw.y = pk2(w01[2] * x01[2] - w01[3] * x01[3], w01[2] * x01[3] + w01[3] * x01[2]);
                zw.z = pk2(w23[0] * x23[0] - w23[1] * x23[1], w23[0] * x23[1] + w23[1] * x23[0]); zw.w = pk2(w23[2] * x23[2] - w23[3] * x23[3], w23[2] * x23[3] + w23[3] * x23[2]);
                acc[m] = __builtin_amdgcn_mfma_f32_16x16x32_bf16(__builtin_bit_cast(bf16x8, zw), cf, acc[m], 0, 0, 0);
            }
        }
#pragma unroll
        for (int m = 0; m < 4; ++m)
#pragma unroll
            for (int r = 0; r < 4; ++r) yssm[(size_t)(tok0 + 16 * m + 4 * g4 + r) * 256 + g * 16 + fr] = gelu_fast(acc[m][r]);
    }
    WG_BARRIER();
}
constexpr int LDS_BYTES = 147456;

__device__ __forceinline__ void prep_transpose_item(const float* W, int K, int N, const float* g, bf16* WT, LAS float* scr, int item, int lane) {
    const int nblk = N / 32, kb = item / nblk, nb = item % nblk, k0 = 64 * kb, p0 = 32 * nb;
    const int c0 = p0 & 255, lbase = (p0 & ~255) + 64 * ((c0 >> 5) & 3) + 32 * (c0 >> 7);
#pragma unroll 8
    for (int i = 0; i < 32; ++i) { const int kk = 2 * i + (lane >> 5); float w = W[(size_t)(k0 + kk) * N + lbase + (lane & 31)]; if (g) w *= g[k0 + kk]; scr[kk * 33 + (lane & 31)] = w; }
    asm volatile("s_waitcnt lgkmcnt(0)" ::: "memory");
    const int c = lane & 7;
#pragma unroll
    for (int j = 0; j < 4; ++j) { const int x = (lane >> 3) + 8 * j; const int px = 8 * ((x >> 2) & 3) + 4 * (x >> 4) + (x & 3); const LAS float* s = scr + (8 * c) * 33 + px;
        v4u o; o.x = pk2(s[0 * 33], s[1 * 33]); o.y = pk2(s[2 * 33], s[3 * 33]); o.z = pk2(s[4 * 33], s[5 * 33]); o.w = pk2(s[6 * 33], s[7 * 33]);
        *(v4u*)(WT + (size_t)(p0 + x) * K + k0 + 8 * c) = o; }
    asm volatile("s_waitcnt lgkmcnt(0)" ::: "memory");
}
struct Args { const float* in[30]; float* out; unsigned char* ws; int s_lo, s_hi; };

__device__ __forceinline__ void prologue_phase(const Args& a, unsigned char* ws, float* outp, LAS unsigned char* lds, int gw, int NGW, int wave, int lane) {
    LAS float* scr = (LAS float*)(lds + wave * 16384);
    constexpr int I_IN = 16 * 48, I_OUT = 16 * 32, I_FF1 = 16 * 128, I_FF2 = 64 * 32, I_GATE = 16 * 32, I_PROJ = 4 * 32, I_L = I_IN + I_OUT + I_FF1 + I_FF2 + I_GATE + I_PROJ;
    for (int it = gw; it < NLAYER * I_L; it += NGW) {
        const int L = it / I_L; int r = it % I_L; unsigned char* wl = ws + WS_W + (size_t)L * LW_STRIDE;
        const float* W; const float* gg; bf16* WT; int K, N;
        if (r < I_IN) { W = a.in[4] + (size_t)L * DM * NIN; K = DM; N = NIN; gg = a.in[3] + L * DM; WT = (bf16*)(wl + LW_IN); }
        else if ((r -= I_IN) < I_OUT) { W = a.in[23] + (size_t)L * DM * DM; K = DM; N = DM; gg = a.in[22] + L * DM; WT = (bf16*)(wl + LW_OUT); }
        else if ((r -= I_OUT) < I_FF1) { W = a.in[25] + (size_t)L * DM * DFF; K = DM; N = DFF; gg = a.in[24] + L * DM; WT = (bf16*)(wl + LW_FF1); }
        else if ((r -= I_FF1) < I_FF2) { W = a.in[26] + (size_t)L * DFF * DM; K = DFF; N = DM; gg = nullptr; WT = (bf16*)(wl + LW_FF2); }
        else if ((r -= I_FF2) < I_GATE) { W = a.in[28] + (size_t)L * DM * DM; K = DM; N = DM; gg = a.in[27] + L * DM; WT = (bf16*)(wl + LW_GATE); }
        else { r -= I_GATE; W = a.in[29] + (size_t)L * 256 * DM; K = 256; N = DM; gg = nullptr; WT = (bf16*)(wl + LW_PROJ); }
        prep_transpose_item(W, K, N, gg, WT, scr, r, lane);
    }
    {
        const float* x = a.in[0]; float* h = outp; bf16* hb = (bf16*)(ws + WS_YCAT); float* ssq = (float*)(ws + TAB_SSQ0);
        for (int m = gw; m < NTOK; m += NGW) {
            const f32x4* xr = (const f32x4*)(x + (size_t)m * DM) + lane; f32x4* hr = (f32x4*)(h + (size_t)m * DM) + lane;
            unsigned long long* o8 = (unsigned long long*)(hb + (size_t)m * DM) + lane; float s = 0.f;
#pragma unroll
            for (int j = 0; j < 4; ++j) { const f32x4 v = xr[64 * j]; hr[64 * j] = v; s += (v[0] * v[0] + v[1] * v[1]) + (v[2] * v[2] + v[3] * v[3]);
                o8[64 * j] = (unsigned long long)pk2(v[0], v[1]) | ((unsigned long long)pk2(v[2], v[3]) << 32); }
            s = wave_sum(s);
            if (lane < 4) ssq[lane * NTOK + m] = (lane == 0) ? s : 0.f;
        }
    }
    {
        const int* pos = (const int*)a.in[2]; float* cosT = (float*)(ws + TAB_COS); float* sinT = (float*)(ws + TAB_SIN);
        for (int i = gw * 64 + lane; i < NTOK * 32; i += NGW * 64) { const int tok = i >> 5, k = i & 31;
            const double rev = (double)pos[tok] * ROPE_INV_REV[k]; const float r = (float)(rev - __builtin_rint(rev));
            cosT[i] = __builtin_amdgcn_cosf(r); sinT[i] = __builtin_amdgcn_sinf(r); }
    }
    {
        bf16* gwt = (bf16*)(ws + TAB_GW);
        for (int i = gw * 64 + lane; i < NLAYER * 4 * 128 * 128; i += NGW * 64) { const int s_ = i & 127, t_ = (i >> 7) & 127; gwt[i] = (bf16)(pk2(s_ <= t_ ? a.in[7][i] : 0.f, 0.f) & 0xffffu); }
    }
    ssm_tables(a.in, ws, gw * 64 + lane, NGW * 64);
    {
        float* sm = (float*)(ws + TAB_SMALL);
        for (int i = gw * 64 + lane; i < NLAYER * SM_STRIDE; i += NGW * 64) { const int L = i / SM_STRIDE, o = i % SM_STRIDE; float v = 0.f;
            if (o < SM_LNB) v = a.in[5][L * 256 + o]; else if (o < SM_QG) v = a.in[6][L * 256 + o - SM_LNB]; else if (o < SM_KG) v = a.in[9][L * 64 + o - SM_QG];
            else if (o < SM_SINK) v = a.in[10][L * 64 + o - SM_KG]; else if (o < SM_SINK + 8) v = a.in[11][L * 8 + o - SM_SINK];
            else if (o >= SM_GBS && o < SM_GBS + 512) v = a.in[8][L * 512 + o - SM_GBS];
            sm[i] = v; }
    }
}

enum { ST_IN = 0, ST_MIX, ST_CARRY, ST_SSM2, ST_OUT, ST_FF1, ST_FF2, ST_PLE, NSTEP };
#ifndef PG8_SP2
#define PG8_SP2 true
#endif
#ifndef PG8_ALIGN
#define PG8_ALIGN true
#endif
__global__ void __launch_bounds__(NWAVES * 64, 2) mk_fwd(Args args) {
    extern __shared__ __attribute__((aligned(16))) unsigned char lds_raw[];
    LAS unsigned char* lds = (LAS unsigned char*)lds_raw;
    const int G = gridDim.x;
    const int wave0 = __builtin_amdgcn_readfirstlane(threadIdx.x >> 6);
    for (int s = args.s_lo; s < args.s_hi; ++s) {
        unsigned long long z0 = 0ull; int bx = blockIdx.x; int wv = wave0;
        asm volatile("" : "+s"(z0), "+s"(bx), "+s"(wv));
        unsigned char* ws = args.ws + z0; float* outp = args.out + z0;
        const int vcu = (G % 8 == 0) ? (bx % 8) * (G / 8) + bx / 8 : bx;
#define FRESH_TID(name) int name = fresh_lane(); name += wv * 64
        if (s == 0) { FRESH_TID(t0); prologue_phase(args, ws, outp, lds, vcu * NWAVES + wv, G * NWAVES, wv, t0 & 63); asm volatile("s_waitcnt vmcnt(0) lgkmcnt(0)" ::: "memory"); __syncthreads(); continue; }
        const int L = (s - 1) / NSTEP, st = (s - 1) % NSTEP, par = L & 1;
        unsigned char* wl = ws + WS_W + (size_t)L * LW_STRIDE;
        if (st == ST_IN) {
            {
                FRESH_TID(t1); const int lane = t1 & 63;
                if (L == 0) ssm_ktable(args.in, ws, (vcu * NWAVES + wv) * 64 + lane, G * NWAVES * 64);
                const float* pl = args.in[1] + (size_t)L * NTOK * 256; bf16* pb = (bf16*)(ws + WS_PB);
                for (int m = vcu * NWAVES + wv; m < NTOK; m += G * NWAVES) { const f32x4 v = ((const f32x4*)(pl + (size_t)m * 256))[lane];
                    ((unsigned long long*)(pb + (size_t)m * 256))[lane] = (unsigned long long)pk2(v[0], v[1]) | ((unsigned long long)pk2(v[2], v[3]) << 32); }
                asm volatile("s_waitcnt vmcnt(0)" ::: "memory");
            }
            pg8::Gemm g{(const bf16*)(ws + WS_YCAT), (const bf16*)(wl + LW_IN), NTOK, NIN, DM}; pg8::StaticOrder S; S.init(NTOK, NIN, G, bx);
            pg8::EpiIn E{ws, par, L};
            { FRESH_TID(tl); pg8::gemm_phase<pg8::EpiIn, pg8::StaticOrder, PG8_ALIGN, PG8_SP2>(lds, g, S, E, tl); }
        } else if (st == ST_MIX) {
            FRESH_TID(tm); const int lane = tm & 63;
            for (int it = vcu; it < 256 + 128 + 256; it += G) { if (it < 256) attn_item(ws, L, lds, it, wv, lane); else if (it < 384) gmlp_item(ws, L, lds, it - 256, wv, lane); else ssm1_item(ws, L, it - 384, wv, lane); }
        } else if (st == ST_SSM2) {
            FRESH_TID(tm); const int lane = tm & 63;
            for (int it = vcu; it < 256; it += G) ssm2_item(ws, L, lds, it, wv, lane);
        } else if (st == ST_CARRY) {
            pg8::Gemm g{(const bf16*)(ws + WS_PB), (const bf16*)(wl + LW_PROJ), NTOK, DM, 256}; pg8::StaticOrder S; S.init(NTOK, DM, G, bx);
            pg8::EpiProj E{ws};
            { FRESH_TID(tl); pg8::gemm_phase<pg8::EpiProj, pg8::StaticOrder, PG8_ALIGN, PG8_SP2>(lds, g, S, E, tl); }
        } else if (st == ST_OUT || st == ST_FF2) {
            const bool o = (st == ST_OUT);
            pg8::Gemm g{(const bf16*)(ws + (o ? WS_YCAT : WS_HID)), (const bf16*)(wl + (o ? LW_OUT : LW_FF2)), NTOK, DM, o ? DM : DFF}; pg8::StaticOrder S; S.init(NTOK, DM, G, bx);
            pg8::EpiRes<false> E{outp, ws, o ? (par ^ 1) : par};
            { FRESH_TID(tl); pg8::gemm_phase<pg8::EpiRes<false>, pg8::StaticOrder, false, PG8_SP2>(lds, g, S, E, tl); }
        } else if (st == ST_FF1) {
            pg8::Gemm g{(const bf16*)(ws + WS_HB), (const bf16*)(wl + LW_FF1), NTOK, DFF, DM}; pg8::StaticOrder S; S.init(NTOK, DFF, G, bx);
            pg8::EpiFF1 E{ws, par ^ 1};
            { FRESH_TID(tl); pg8::gemm_phase<pg8::EpiFF1, pg8::StaticOrder, PG8_ALIGN, PG8_SP2>(lds, g, S, E, tl); }
        } else if (st == ST_PLE) {
            pg8::Gemm g{(const bf16*)(ws + WS_HB), (const bf16*)(wl + LW_GATE), NTOK, DM, DM}; pg8::StaticOrder S; S.init(NTOK, DM, G, bx);
            pg8::EpiRes<true> E{outp, ws, par ^ 1};
            { FRESH_TID(tl); pg8::gemm_phase<pg8::EpiRes<true>, pg8::StaticOrder, false, PG8_SP2>(lds, g, S, E, tl); }
        }
    }
}
__global__ void nk_gmlp_mix(const bf16* U, const bf16* VLN, const float* ws_, const float* bs, float* yf) {
    int idx = blockIdx.x * 4 + (threadIdx.x >> 6), d = threadIdx.x & 63;
    int tok = idx >> 2, h = idx & 3;
    int t = tok & 127, base = tok - t;
    const float* w = ws_ + ((size_t)h * 128 + t) * 128;
    float acc = 0.f;
    for (int s = 0; s <= t; ++s) acc += w[s] * bf2f(VLN[(size_t)(base + s) * 256 + h * 64 + d]);
    acc += bs[h * 128 + t];
    yf[(size_t)tok * DM + h * 64 + d] = bf2f(U[(size_t)tok * 256 + h * 64 + d]) * acc;
}
__global__ void nk_attn(const bf16* Q, const bf16* K, const bf16* V, const float* sinks, float* yf) {
    __shared__ float qs[64];
    __shared__ float ps[128];
    int idx = blockIdx.x, lane = threadIdx.x;
    int tok = idx >> 3, hq = idx & 7, hkv = hq >> 2;
    int t = tok & (SEQL - 1), b0 = tok - t;
    qs[lane] = bf2f(Q[(size_t)tok * 512 + hq * 64 + lane]);
    __syncthreads();
    int nk = t + 1 < 128 ? t + 1 : 128;
    int j0 = t - nk + 1;
    float sc[2];
#pragma unroll
    for (int r = 0; r < 2; ++r) {
        int jj = lane + 64 * r;
        float s = -INFINITY;
        if (jj < nk) {
            const bf16* kp = K + (size_t)(b0 + j0 + jj) * 128 + hkv * 64;
            float a = 0.f;
            for (int d = 0; d < 64; ++d) a += qs[d] * bf2f(kp[d]);
            s = a;
        }
        sc[r] = s;
    }
    float sink = sinks[hq] * LOG2E;
    float m = fmaxf(sc[0], sc[1]);
#pragma unroll
    for (int o = 1; o < 64; o <<= 1) m = fmaxf(m, __shfl_xor(m, o));
    m = fmaxf(m, sink);
    float p0 = (lane < nk) ? exp2f(sc[0] - m) : 0.f;
    float p1 = (lane + 64 < nk) ? exp2f(sc[1] - m) : 0.f;
    float den = wave_sum_shfl(p0 + p1) + exp2f(sink - m);
    ps[lane] = p0 / den; ps[lane + 64] = p1 / den;
    __syncthreads();
    float o = 0.f;
    for (int jj = 0; jj < nk; ++jj) o += ps[jj] * bf2f(V[(size_t)(b0 + j0 + jj) * 128 + hkv * 64 + lane]);
    yf[(size_t)tok * DM + 256 + hq * 64 + lane] = o;
}
__global__ void nk_ssm(const bf16* ZC, const float* a_re, const float* a_im, const float* log_dt, const float* b_re, const float* b_im,
                       const float* c_re, const float* c_im, const float* dsk, float* yssm) {
    int b = blockIdx.x >> 4, g = blockIdx.x & 15, p = threadIdx.x;
    double lre = a_re[g * 64 + p], lim = a_im[g * 64 + p], dt = exp((double)log_dt[g]);
    double er = exp(lre * dt), lbr = er * cos(lim * dt), lbi = er * sin(lim * dt);
    double nr = lbr - 1.0, ni = lbi, den = lre * lre + lim * lim;
    double fr = (nr * lre + ni * lim) / den, fi = (ni * lre - nr * lim) / den;
    float bbr[16], bbi[16], cr[16], ci[16], dd[16];
#pragma unroll
    for (int h = 0; h < 16; ++h) {
        double br = b_re[(g * 64 + p) * 16 + h], bi = b_im[(g * 64 + p) * 16 + h];
        bbr[h] = (float)(fr * br - fi * bi); bbi[h] = (float)(fr * bi + fi * br);
        cr[h] = c_re[(g * 16 + h) * 64 + p]; ci[h] = c_im[(g * 16 + h) * 64 + p];
        dd[h] = dsk[g * 16 + h];
    }
    float lr = (float)lbr, li = (float)lbi;
    float xr = 0.f, xi = 0.f;
    for (int t = 0; t < SEQL; ++t) {
        const bf16* up = ZC + (size_t)(b * SEQL + t) * 256 + g * 16;
        float u[16];
#pragma unroll
        for (int h = 0; h < 16; ++h) u[h] = bf2f(up[h]);
        float sr = 0.f, si = 0.f;
#pragma unroll
        for (int h = 0; h < 16; ++h) { sr += bbr[h] * u[h]; si += bbi[h] * u[h]; }
        float nxr = lr * xr - li * xi + sr, nxi = lr * xi + li * xr + si;
        xr = nxr; xi = nxi;
        float mine = 0.f;
#pragma unroll
        for (int h = 0; h < 16; ++h) {
            float v = wave_sum_shfl(cr[h] * xr - ci[h] * xi);
            if (p == h) mine = v + dd[h] * u[h];
        }
        if (p < 16) yssm[(size_t)(b * SEQL + t) * 256 + g * 16 + p] = gelu_tanh(mine);
    }
}
__global__ void nk_glu(const float* yssm, const float* w1, const float* w2, float* yf) {
    __shared__ float ys[256];
    int tok = blockIdx.x, c = threadIdx.x;
    ys[c] = yssm[(size_t)tok * 256 + c];
    __syncthreads();
    float a = 0.f, b = 0.f;
    for (int k = 0; k < 256; ++k) { a += ys[k] * w1[k * 256 + c]; b += ys[k] * w2[k * 256 + c]; }
    yf[(size_t)tok * DM + 768 + c] = a / (1.f + expf(-b));
}
__global__ void nk_norm3(const float* yf, bf16* ycat) {
    int row = blockIdx.x * 4 + (threadIdx.x >> 6), lane = threadIdx.x & 63;
    const float* x = yf + (size_t)row * DM; bf16* o = ycat + (size_t)row * DM;
    float v[16]; float sa = 0.f, sb = 0.f, sc = 0.f;
#pragma unroll
    for (int j = 0; j < 16; ++j) { v[j] = x[lane + 64 * j]; float q = v[j] * v[j]; if (j < 4) sa += q; else if (j < 12) sb += q; else sc += q; }
    sa = wave_sum_shfl(sa); sb = wave_sum_shfl(sb); sc = wave_sum_shfl(sc);
    const float ra = rsqrtf(sa / 256.f + 1e-6f), rb = rsqrtf(sb / 512.f + 1e-6f), rc = rsqrtf(sc / 256.f + 1e-6f);
#pragma unroll
    for (int j = 0; j < 16; ++j) { float r = j < 4 ? ra : (j < 12 ? rb : rc); o[lane + 64 * j] = (bf16)(pk2(v[j] * r, 0.f) & 0xffffu); }
}
__global__ void nk_norm_c(const float* yf, bf16* ycat) {
    int row = blockIdx.x * 4 + (threadIdx.x >> 6), lane = threadIdx.x & 63;
    const float* x = yf + (size_t)row * DM + 768; bf16* o = ycat + (size_t)row * DM + 768;
    float v[4]; float sc = 0.f;
#pragma unroll
    for (int j = 0; j < 4; ++j) { v[j] = x[lane + 64 * j]; sc += v[j] * v[j]; }
    sc = wave_sum_shfl(sc);
    const float rc = rsqrtf(sc / 256.f + 1e-6f);
#pragma unroll
    for (int j = 0; j < 4; ++j) o[lane + 64 * j] = (bf16)(pk2(v[j] * rc, 0.f) & 0xffffu);
}
extern "C" void kernel_launch(void* const* d_in, const int* in_sizes, int n_in, void* d_out, int out_size, void* d_ws, size_t ws_size, hipStream_t stream) {
    static int grid = 0;
    if (grid == 0) {
        if (n_in != 30 || out_size != NTOK * DM || ws_size < WS_END) { fprintf(stderr, "kernel_launch: unexpected shapes / workspace (n_in %d out %d ws %zu)\n", n_in, out_size, ws_size); grid = -1; return; }
        int dev = 0, cus = 0, per_cu = 0;
        (void)hipGetDevice(&dev); (void)hipDeviceGetAttribute(&cus, hipDeviceAttributeMultiprocessorCount, dev);
        (void)hipFuncSetAttribute((const void*)mk_fwd, hipFuncAttributeMaxDynamicSharedMemorySize, LDS_BYTES);
        (void)hipOccupancyMaxActiveBlocksPerMultiprocessor(&per_cu, (const void*)mk_fwd, NWAVES * 64, LDS_BYTES);
        (void)hipGetLastError();
        grid = (per_cu >= 1 && cus == 256) ? 256 : -1;
        if (grid < 0) { fprintf(stderr, "kernel_launch: needs 256 CUs with one resident workgroup each (cus %d per_cu %d)\n", cus, per_cu); return; }
    }
    if (grid < 0) return;
    (void)hipMemsetAsync((char*)d_ws + WS_CTL, 0, CTL_ZERO_BYTES, stream);
    Args a{};
    for (int i = 0; i < 30; ++i) a.in[i] = (const float*)d_in[i];
    a.out = (float*)d_out; a.ws = (unsigned char*)d_ws;
    unsigned char* ws = (unsigned char*)d_ws;
    const float* const* F = a.in;
#define LAUNCH_STEPS(lo, hi) do { a.s_lo = (lo); a.s_hi = (hi); hipLaunchKernelGGL(mk_fwd, dim3(grid), dim3(NWAVES * 64), LDS_BYTES, stream, a); } while (0)
    LAUNCH_STEPS(0, 1);
    for (int L = 0; L < NLAYER; ++L) {
        const int s0 = 1 + L * NSTEP;
        LAUNCH_STEPS(s0 + ST_IN, s0 + ST_IN + 1);
        float* yf = (float*)(ws + WS_YF); float* yssm = (float*)(ws + WS_YSSM);
        LAUNCH_STEPS(s0 + ST_MIX, s0 + ST_MIX + 1);
        LAUNCH_STEPS(s0 + ST_SSM2, s0 + ST_SSM2 + 1);
        nk_glu<<<NTOK, 256, 0, stream>>>(yssm, F[20] + (size_t)L * 65536, F[21] + (size_t)L * 65536, yf);
        nk_norm_c<<<NTOK / 4, 256, 0, stream>>>(yf, (bf16*)(ws + WS_YCAT));
        LAUNCH_STEPS(s0 + ST_CARRY, s0 + ST_CARRY + 1);
        LAUNCH_STEPS(s0 + ST_OUT, s0 + ST_OUT + 1);
        LAUNCH_STEPS(s0 + ST_FF1, s0 + ST_FF1 + 1);
        LAUNCH_STEPS(s0 + ST_FF2, s0 + ST_FF2 + 1);
        LAUNCH_STEPS(s0 + ST_PLE, s0 + ST_PLE + 1);
    }
}
```

```cpp
#include <hip/hip_runtime.h>
#include <cstdio>
#include <cstdint>
#include <math.h>

#define NTOK 16384
#define SEQL 8192
#define DM 1024
#define NIN 1536
#define DFF 4096
#define NLAYER 4
constexpr float QSCALE = 0.125f * 1.4426950408889634f;
constexpr float LOG2E = 1.4426950408889634f;

constexpr size_t MiB = 1u << 20;
constexpr size_t WS_CTL = 0, CTL_ZERO_BYTES = 1 * MiB;
constexpr size_t WS_W = 2 * MiB;
constexpr size_t LW_IN = 0, LW_OUT = 3 * MiB, LW_FF1 = 5 * MiB, LW_FF2 = 13 * MiB, LW_GATE = 21 * MiB, LW_PROJ = 23 * MiB, LW_GLU = 23 * MiB + 512 * 1024, LW_STRIDE = 24 * MiB;
constexpr size_t WS_TAB = 98 * MiB;
constexpr size_t TAB_COS = WS_TAB, TAB_SIN = WS_TAB + 2 * MiB, TAB_SSQ0 = WS_TAB + 4 * MiB, TAB_SSQ1 = TAB_SSQ0 + 256 * 1024, TAB_GW = TAB_SSQ1 + 256 * 1024, TAB_SMALL = TAB_GW + 512 * 1024, TAB_END = TAB_SMALL + 64 * 1024;
constexpr int SM_LNG = 0, SM_LNB = 256, SM_QG = 512, SM_KG = 576, SM_SINK = 640, SM_GBS = 1024  , SM_STRIDE = 2048;
constexpr size_t WS_HB = 104 * MiB;
constexpr size_t WS_U = 138 * MiB, WS_VLN = 146 * MiB, WS_Q = 154 * MiB, WS_K = 170 * MiB, WS_V = 174 * MiB, WS_ZC = 178 * MiB;
constexpr size_t WS_YCAT = 186 * MiB;
constexpr size_t WS_HID = 138 * MiB;
constexpr size_t WS_PPROJ = 266 * MiB;
constexpr size_t WS_YF = 218 * MiB;
constexpr size_t WS_YSSM = 282 * MiB;
constexpr size_t WS_PB = 298 * MiB;
constexpr size_t WS_SSM = 306 * MiB;
constexpr size_t SSM_PW = WS_SSM;
constexpr size_t SSM_KT = SSM_PW + 2304 * 1024;
constexpr size_t SSM_BBT = SSM_KT + 2 * MiB;
constexpr size_t SSM_CCT = SSM_BBT + 256 * 1024;
constexpr size_t SSM_BBC = SSM_CCT + 256 * 1024;
constexpr size_t SSM_S = SSM_BBC + 512 * 1024;
constexpr size_t SSM_W1 = SSM_S + 2 * MiB;
constexpr size_t WS_END = SSM_W1 + 2 * MiB;
static_assert(WS_END <= 316 * MiB, "ssm region");
static_assert(TAB_END <= WS_HB && WS_HB + 32 * MiB <= WS_U && WS_HID + 128 * MiB <= WS_PPROJ && WS_YF + 64 * MiB <= WS_YSSM && WS_YSSM + 16 * MiB <= WS_PB, "ws map");
static_assert(WS_W + NLAYER * LW_STRIDE <= WS_TAB, "weights");

typedef float f32x2_t __attribute__((ext_vector_type(2)));
typedef __bf16 bf16x2_t __attribute__((ext_vector_type(2)));
__device__ __forceinline__ unsigned pk2(float lo, float hi) { f32x2_t v = {lo, hi}; bf16x2_t b = __builtin_convertvector(v, bf16x2_t); return __builtin_bit_cast(unsigned, b); }
__device__ __forceinline__ float bf_lo(unsigned w) { return __uint_as_float(w << 16); }
__device__ __forceinline__ float bf_hi(unsigned w) { return __uint_as_float(w & 0xffff0000u); }
__device__ __forceinline__ float bf2f(unsigned short b) { return __uint_as_float(((unsigned)b) << 16); }
template <int X> __device__ __forceinline__ float xor_lane(float v) { return __int_as_float(__builtin_amdgcn_ds_swizzle(__float_as_int(v), (X << 10) | 0x1f)); }
__device__ __forceinline__ float add_xor16(float v) { return v + xor_lane<16>(v); }
__device__ __forceinline__ float add_xor32(float v) { auto r = __builtin_amdgcn_permlane32_swap(__float_as_uint(v), __float_as_uint(v), false, false); return __uint_as_float(r[0]) + __uint_as_float(r[1]); }
__device__ __forceinline__ float wave_sum(float v) {
    v += xor_lane<1>(v); v += xor_lane<2>(v); v += xor_lane<4>(v); v += xor_lane<8>(v); v = add_xor16(v); return add_xor32(v);
}
__device__ __forceinline__ float wave_sum_shfl(float v) {
#pragma unroll
    for (int o = 1; o < 64; o <<= 1) v += __shfl_xor(v, o);
    return v;
}
__device__ __forceinline__ int fresh_lane() { int l; asm volatile("v_mbcnt_lo_u32_b32 %0, -1, 0\n\tv_mbcnt_hi_u32_b32 %0, -1, %0" : "=v"(l)); return l; }
__device__ __forceinline__ float gelu_fast(float x) {
    const float u = x * (1.0f + 0.044715f * x * x);
    const float t = __builtin_amdgcn_exp2f(u * 2.3022082f);
    return x - x * __builtin_amdgcn_rcpf(1.0f + t);
}
__device__ __forceinline__ float sigmoid_fast(float x) { return __builtin_amdgcn_rcpf(1.0f + __builtin_amdgcn_exp2f(-x * LOG2E)); }
__device__ __forceinline__ float gelu_tanh(float x) { const float k0 = 0.7978845608028654f, k1 = 0.044715f; float u = k0 * (x + k1 * x * x * x); return 0.5f * x * (1.0f + tanhf(u)); }
__device__ const double ROPE_INV_REV[32] = {0.15915494309189535, 0.11934937021124886, 0.08949940160889101, 0.06711508300522726, 0.050329212104487035, 0.03774158471741977, 0.0283021958306234, 0.02122365276477766, 0.015915494309189534, 0.011934937021124886, 0.008949940160889102, 0.006711508300522725, 0.005032921210448704, 0.003774158471741977, 0.00283021958306234, 0.0021223652764777662, 0.0015915494309189536, 0.0011934937021124885, 0.0008949940160889102, 0.0006711508300522726, 0.0005032921210448703, 0.00037741584717419774, 0.00028302195830623395, 0.0002122365276477766, 0.00015915494309189535, 0.00011934937021124886, 8.949940160889102e-05, 6.711508300522725e-05, 5.0329212104487035e-05, 3.774158471741978e-05, 2.8302195830623396e-05, 2.122365276477766e-05};
namespace pg8 {
#define PG8_LAS __attribute__((address_space(3)))
typedef unsigned short bf16_t;
typedef short bf16x8 __attribute__((ext_vector_type(8)));
typedef float f32x4 __attribute__((ext_vector_type(4)));
typedef unsigned u32x4 __attribute__((ext_vector_type(4)));
constexpr int BM = 256, BK = 64, HALF = 128, HTB = HALF * BK * 2  , STAGE_BYTES = 8 * HTB, NXCD = 8, WGM = 8;

__host__ __device__ __forceinline__ int lds_byte(int r, int c) { const int st = (r >> 4) * 2 + (c >> 5), rr = r & 15, cc = c & 31, ob = rr * 64 + cc * 2; return st * 1024 + (ob ^ (((ob >> 9) & 1) << 5)); }
__host__ __device__ __forceinline__ void stage_rc(int b, int& R, int& C) { const int st = b / 1024, sb = b % 1024, swz = sb ^ (((sb >> 9) & 1) << 5); R = (st >> 1) * 16 + swz / 64; C = (st & 1) * 32 + (swz % 64) / 2; }
__host__ __device__ __forceinline__ int perm32(int rho) { const int n = rho >> 4, i = rho & 15; return 8 * (i >> 2) + 4 * n + (i & 3); }

struct Unit { int pm, pn; };
struct Gemm { const bf16_t* A; const bf16_t* Bt; int M, N, K; };

struct StaticOrder {
    int nM, nN, nwg, G, c;
    __host__ __device__ void init(int M, int N, int G_, int c_) { nM = M / BM; nN = N / BM; nwg = nM * nN; G = G_; c = c_; }
    __host__ __device__ bool next(int i, Unit& u) const {
        const long L = (long)i * G + c; if (L >= nwg) return false;
        int wgid = (int)L; { const int q = nwg / NXCD, r = nwg % NXCD, xcd = wgid % NXCD, off = wgid / NXCD; wgid = (xcd < r ? xcd * (q + 1) : r * (q + 1) + (xcd - r) * q) + off; }
        const int nig = WGM * nN, gid = wgid / nig, fm = gid * WGM, gsz = (nM - fm) < WGM ? (nM - fm) : WGM;
        u.pm = fm + ((wgid % nig) % gsz); u.pn = (wgid % nig) / gsz; return true;
    }
    __device__ __forceinline__ void a_ready(const Unit&) const {}
    __device__ __forceinline__ void done(const Unit&) const {}
};

template <class Epi, class Sched, bool ALIGN_EPI = false, bool SP2 = false>
__device__ __forceinline__ void gemm_phase(PG8_LAS unsigned char* lds, const Gemm g, const Sched& S, const Epi& E, const int tid) {
    const int wid = __builtin_amdgcn_readfirstlane(tid >> 6), lane = tid & 63, wr = wid >> 2, wc = wid & 3, fr = lane & 15, fq = lane >> 4;
    const int K = g.K, nt = K / BK;
    unsigned voffA[2], voffB[2];
#pragma unroll
    for (int i = 0; i < 2; ++i) { int R, C; stage_rc(tid * 16 + i * 8192, R, C); const int Rb = Epi::PERM ? ((R & ~31) + perm32(R & 31)) : R;
        voffA[i] = (unsigned)(R * K + C) * 2u; voffB[i] = (unsigned)(Rb * K + C) * 2u; }
    const size_t kstep = (size_t)(BK * 2);
    const size_t hstep = (size_t)HALF * K * 2;
    const size_t tstep = 2 * hstep;
    const unsigned ldsw = (unsigned)wid * 1024u;
    const int aoff = lds_byte(wr * 64 + fr, fq * 8), boff = lds_byte(wc * 32 + fr, fq * 8);
#define PG8_SA(b, h) (((b) * 2 + (h)) * HTB)
#define PG8_SB(b, h) ((4 + (b) * 2 + (h)) * HTB)
#define PG8_STAGE(bufoff, gbase, voff) do { _Pragma("unroll") for (int _i = 0; _i < 2; ++_i) \
        __builtin_amdgcn_global_load_lds((const unsigned*)((const char*)(gbase) + (voff)[_i]), (PG8_LAS unsigned*)(lds + (bufoff) + ldsw + _i * 8192), 16, 0, 0); } while (0)
#define PG8_LDA(dst, b, h) do { _Pragma("unroll") for (int m = 0; m < 4; ++m) _Pragma("unroll") for (int k = 0; k < 2; ++k) dst[m][k] = *(const PG8_LAS bf16x8*)(lds + PG8_SA(b, h) + aoff + m * 2048 + k * 1024); } while (0)
#define PG8_LDB(dst, b, h) do { _Pragma("unroll") for (int n = 0; n < 2; ++n) _Pragma("unroll") for (int k = 0; k < 2; ++k) dst[n][k] = *(const PG8_LAS bf16x8*)(lds + PG8_SB(b, h) + boff + n * 2048 + k * 1024); } while (0)
#define PG8_MMA(ai, bj, At, Bt) do { __builtin_amdgcn_s_setprio(1); _Pragma("unroll") for (int m = 0; m < 4; ++m) _Pragma("unroll") for (int n = 0; n < 2; ++n) _Pragma("unroll") for (int k = 0; k < 2; ++k) \
        acc[ai][bj][m][n] = __builtin_amdgcn_mfma_f32_16x16x32_bf16(Bt[n][k], At[m][k], acc[ai][bj][m][n], 0, 0, 0); __builtin_amdgcn_s_setprio(0); } while (0)
#define PG8_WAIT_V(n) asm volatile("s_waitcnt vmcnt(" #n ")" ::: "memory")
#define PG8_WAIT_L(n) asm volatile("s_waitcnt lgkmcnt(" #n ")" ::: "memory")
#define PG8_BAR __builtin_amdgcn_s_barrier()
#define PG8_SCHED __builtin_amdgcn_sched_barrier(0)
    Unit cur, nxt; int ui = 0;
    if (!S.next(0, cur)) return;
    f32x4 acc[2][2][4][2];
#pragma unroll
    for (int a = 0; a < 2; ++a)
#pragma unroll
        for (int b = 0; b < 2; ++b)
#pragma unroll
            for (int m = 0; m < 4; ++m)
#pragma unroll
                for (int n = 0; n < 2; ++n) acc[a][b][m][n] = (f32x4){0.f, 0.f, 0.f, 0.f};
    bf16x8 At[4][2], B0[2][2], B1[2][2];
    const char* cA = (const char*)g.A + (size_t)cur.pm * tstep; const char* cB = (const char*)g.Bt + (size_t)cur.pn * tstep;
    S.a_ready(cur);
    if constexpr (SP2) {
        PG8_STAGE(PG8_SB(0, 0), cB, voffB); PG8_STAGE(PG8_SB(0, 1), cB + hstep, voffB); PG8_STAGE(PG8_SA(0, 0), cA, voffA); PG8_STAGE(PG8_SA(0, 1), cA + hstep, voffA);
        if (wr == 1) PG8_BAR;
        PG8_WAIT_V(2); PG8_BAR;
        PG8_STAGE(PG8_SB(1, 0), cB + kstep, voffB); PG8_STAGE(PG8_SA(1, 0), cA + kstep, voffA); PG8_STAGE(PG8_SB(1, 1), cB + hstep + kstep, voffB);
        PG8_WAIT_V(6); PG8_BAR;
    } else {
        PG8_STAGE(PG8_SB(0, 0), cB, voffB); PG8_STAGE(PG8_SA(0, 0), cA, voffA); PG8_STAGE(PG8_SB(0, 1), cB + hstep, voffB); PG8_STAGE(PG8_SA(0, 1), cA + hstep, voffA);
        if (wr == 1) PG8_BAR;
        PG8_WAIT_V(4); PG8_BAR;
        PG8_STAGE(PG8_SB(1, 0), cB + kstep, voffB); PG8_STAGE(PG8_SA(1, 0), cA + kstep, voffA); PG8_STAGE(PG8_SB(1, 1), cB + hstep + kstep, voffB);
        PG8_WAIT_V(6); PG8_BAR;
    }
    for (;;) {
        const bool has_next = S.next(ui + 1, nxt);
        const char* nA = has_next ? (const char*)g.A + (size_t)nxt.pm * tstep : cA; const char* nB = has_next ? (const char*)g.Bt + (size_t)nxt.pn * tstep : cB;
        for (int t = 0; t < nt; t += 2) {
            const bool last = (t == nt - 2);
            const char* a1 = cA + (size_t)(t + 1) * kstep;
            const char* a2 = last ? nA : cA + (size_t)(t + 2) * kstep; const char* b2 = last ? nB : cB + (size_t)(t + 2) * kstep;
            const char* a3 = a2 + kstep; const char* b3 = b2 + kstep;
            if (last && has_next) S.a_ready(nxt);
            if constexpr (SP2) {
            PG8_LDB(B0, 0, 0); PG8_LDB(B1, 0, 1); PG8_SCHED; PG8_LDA(At, 0, 0); PG8_STAGE(PG8_SA(1, 1), a1 + hstep, voffA);
            PG8_WAIT_V(8); PG8_WAIT_L(0); PG8_BAR; PG8_MMA(0, 0, At, B0); PG8_MMA(0, 1, At, B1); PG8_BAR; PG8_SCHED;
            PG8_LDA(At, 0, 1); PG8_STAGE(PG8_SB(0, 0), b2, voffB); PG8_STAGE(PG8_SB(0, 1), b2 + hstep, voffB); PG8_STAGE(PG8_SA(0, 0), a2, voffA);
            PG8_WAIT_V(8); PG8_WAIT_L(0); PG8_BAR; PG8_MMA(1, 0, At, B0); PG8_MMA(1, 1, At, B1); PG8_BAR; PG8_SCHED;
            PG8_LDB(B0, 1, 0); PG8_LDB(B1, 1, 1); PG8_SCHED; PG8_LDA(At, 1, 0); PG8_STAGE(PG8_SA(0, 1), a2 + hstep, voffA);
            PG8_WAIT_V(8); PG8_WAIT_L(0); PG8_BAR; PG8_MMA(0, 0, At, B0); PG8_MMA(0, 1, At, B1); PG8_BAR; PG8_SCHED;
            PG8_LDA(At, 1, 1); PG8_STAGE(PG8_SB(1, 0), b3, voffB); PG8_STAGE(PG8_SB(1, 1), b3 + hstep, voffB); PG8_STAGE(PG8_SA(1, 0), a3, voffA);
            PG8_WAIT_V(8); PG8_WAIT_L(0); PG8_BAR; PG8_MMA(1, 0, At, B0); PG8_MMA(1, 1, At, B1); PG8_BAR; PG8_SCHED;
            } else {
            PG8_LDB(B0, 0, 0); PG8_SCHED; PG8_LDA(At, 0, 0); PG8_STAGE(PG8_SA(1, 1), a1 + hstep, voffA);
            PG8_WAIT_L(8); PG8_BAR; PG8_WAIT_L(0); PG8_MMA(0, 0, At, B0); PG8_BAR; PG8_SCHED;
            PG8_LDB(B1, 0, 1); PG8_STAGE(PG8_SB(0, 0), b2, voffB);
            PG8_BAR; PG8_WAIT_L(0); PG8_MMA(0, 1, At, B1); PG8_BAR;
            PG8_LDA(At, 0, 1); PG8_STAGE(PG8_SA(0, 0), a2, voffA);
            PG8_BAR; PG8_WAIT_L(0); PG8_MMA(1, 0, At, B0); PG8_BAR; PG8_SCHED;
            PG8_STAGE(PG8_SB(0, 1), b2 + hstep, voffB);
            PG8_WAIT_V(6); PG8_BAR; PG8_MMA(1, 1, At, B1); PG8_BAR;
            PG8_LDB(B0, 1, 0); PG8_SCHED; PG8_LDA(At, 1, 0); PG8_STAGE(PG8_SA(0, 1), a2 + hstep, voffA);
            PG8_WAIT_L(8); PG8_BAR; PG8_WAIT_L(0); PG8_MMA(0, 0, At, B0); PG8_BAR; PG8_SCHED;
            PG8_LDB(B1, 1, 1); PG8_STAGE(PG8_SB(1, 0), b3, voffB);
            PG8_BAR; PG8_WAIT_L(0); PG8_MMA(0, 1, At, B1); PG8_BAR;
            PG8_LDA(At, 1, 1); PG8_STAGE(PG8_SA(1, 0), a3, voffA);
            PG8_BAR; PG8_WAIT_L(0); PG8_MMA(1, 0, At, B0); PG8_BAR; PG8_SCHED;
            PG8_STAGE(PG8_SB(1, 1), b3 + hstep, voffB);
            PG8_WAIT_V(6); PG8_BAR; PG8_MMA(1, 1, At, B1); PG8_BAR;
            }
        }
        if constexpr (ALIGN_EPI) { if (wr == 0) PG8_BAR; }
        if constexpr (!Epi::AFTER_DRAIN) { const int l2 = fresh_lane();
            E(acc, cur, wr, wc, l2 & 15, l2 >> 4); S.done(cur); }
        if (!has_next) break;
#pragma unroll
        for (int a = 0; a < 2; ++a)
#pragma unroll
            for (int b = 0; b < 2; ++b)
#pragma unroll
                for (int m = 0; m < 4; ++m)
#pragma unroll
                    for (int n = 0; n < 2; ++n) acc[a][b][m][n] = (f32x4){0.f, 0.f, 0.f, 0.f};
        cur = nxt; cA = nA; cB = nB; ++ui;
        if constexpr (ALIGN_EPI) { if (wr == 1) PG8_BAR; }
    }
    PG8_WAIT_V(0);
    if constexpr (!ALIGN_EPI) { if (wr == 0) PG8_BAR; }
    PG8_BAR;
    if constexpr (Epi::AFTER_DRAIN) { const int l2 = fresh_lane();
        E.fused(acc, cur, wr, wc, l2 & 15, l2 >> 4, lds, wid, l2); S.done(cur); }
#undef PG8_SA
#undef PG8_SB
#undef PG8_STAGE
#undef PG8_LDA
#undef PG8_LDB
#undef PG8_MMA
#undef PG8_WAIT_V
#undef PG8_WAIT_L
#undef PG8_BAR
#undef PG8_SCHED
}
}
namespace pg8 {
__device__ __forceinline__ float rstd_row(const float* ssq, int row) {
    const float s = (ssq[row] + ssq[NTOK + row]) + (ssq[2 * NTOK + row] + ssq[3 * NTOK + row]);
    return __builtin_amdgcn_rsqf(s * (1.0f / 1024.0f) + 1e-6f);
}
__device__ __forceinline__ void store8(bf16_t* p, const float (&v)[8]) {
    u32x4 w; w.x = pk2(v[0], v[1]); w.y = pk2(v[2], v[3]); w.z = pk2(v[4], v[5]); w.w = pk2(v[6], v[7]); *(u32x4*)p = w;
}
struct EpiIn {
    static constexpr bool PERM = false, AFTER_DRAIN = false;
    unsigned char* ws; int par, L;
    __device__ __forceinline__ void operator()(const f32x4 (&acc)[2][2][4][2], const Unit& u, int wr, int wc, int fr, int fq) const {
        const int pn = u.pn;
        const float* ssq = (const float*)(ws + (par ? TAB_SSQ1 : TAB_SSQ0)); const float* cosT = (const float*)(ws + TAB_COS); const float* sinT = (const float*)(ws + TAB_SIN);
        const float* sm = (const float*)(ws + TAB_SMALL) + L * SM_STRIDE; const float* lng = sm + SM_LNG; const float* lnb = sm + SM_LNB; const float* qg = sm + SM_QG; const float* kg = sm + SM_KG;
        bf16_t* U = (bf16_t*)(ws + WS_U); bf16_t* VLN = (bf16_t*)(ws + WS_VLN); bf16_t* Q = (bf16_t*)(ws + WS_Q); bf16_t* K = (bf16_t*)(ws + WS_K); bf16_t* V = (bf16_t*)(ws + WS_V); bf16_t* ZC = (bf16_t*)(ws + WS_ZC);
        int mode, ld, cb; bf16_t* dst; const float* gp = nullptr; const float* bp = nullptr;
        if (pn < 2) { const int head = 2 * pn + (wc >> 1); ld = 256; cb = head * 64; if (wc & 1) { mode = 1; dst = VLN; gp = lng + head * 64; bp = lnb + head * 64; } else { mode = 0; dst = U; } }
        else if (pn < 4) { mode = 2; dst = Q; ld = 512; cb = (4 * (pn - 2) + wc) * 64; gp = qg; }
        else if (pn == 4) { ld = 128; if (wc < 2) { mode = 3; dst = K; cb = wc * 64; gp = kg; } else { mode = 4; dst = V; cb = (wc - 2) * 64; } }
        else { mode = 4; dst = ZC; ld = 256; cb = wc * 64; }
        float g[16], bb[16];
#pragma unroll
        for (int i = 0; i < 16; ++i) { g[i] = 1.f; bb[i] = 0.f; }
        if (gp) {
#pragma unroll
            for (int bj = 0; bj < 2; ++bj)
#pragma unroll
                for (int n = 0; n < 2; ++n) { const f32x4 t = *(const f32x4*)(gp + 32 * bj + 8 * fq + 4 * n); g[bj * 8 + n * 4 + 0] = t[0]; g[bj * 8 + n * 4 + 1] = t[1]; g[bj * 8 + n * 4 + 2] = t[2]; g[bj * 8 + n * 4 + 3] = t[3]; }
        }
        if (bp) {
#pragma unroll
            for (int bj = 0; bj < 2; ++bj)
#pragma unroll
                for (int n = 0; n < 2; ++n) { const f32x4 t = *(const f32x4*)(bp + 32 * bj + 8 * fq + 4 * n); bb[bj * 8 + n * 4 + 0] = t[0]; bb[bj * 8 + n * 4 + 1] = t[1]; bb[bj * 8 + n * 4 + 2] = t[2]; bb[bj * 8 + n * 4 + 3] = t[3]; }
        }
#pragma unroll
        for (int ai = 0; ai < 2; ++ai)
#pragma unroll
            for (int m = 0; m < 4; ++m) {
                const int row = u.pm * BM + ai * HALF + wr * 64 + m * 16 + fr;
                const float rs = rstd_row(ssq, row);
                float v[16];
#pragma unroll
                for (int bj = 0; bj < 2; ++bj)
#pragma unroll
                    for (int n = 0; n < 2; ++n)
#pragma unroll
                        for (int j = 0; j < 4; ++j) v[bj * 8 + n * 4 + j] = acc[ai][bj][m][n][j] * rs;
                if (mode <= 1) {
#pragma unroll
                    for (int i = 0; i < 16; ++i) v[i] = gelu_fast(v[i]);
                    if (mode == 1) {
                        float s = 0.f;
#pragma unroll
                        for (int i = 0; i < 16; ++i) s += v[i];
                        s = add_xor16(s); s = add_xor32(s);
                        const float mu = s * (1.0f / 64.0f); float q = 0.f;
#pragma unroll
                        for (int i = 0; i < 16; ++i) { v[i] -= mu; q += v[i] * v[i]; }
                        q = add_xor16(q); q = add_xor32(q);
                        const float r = __builtin_amdgcn_rsqf(q * (1.0f / 64.0f) + 1e-6f);
#pragma unroll
                        for (int i = 0; i < 16; ++i) v[i] = v[i] * r * g[i] + bb[i];
                    }
                } else if (mode <= 3) {
                    float q = 0.f;
#pragma unroll
                    for (int i = 0; i < 16; ++i) q += v[i] * v[i];
                    q = add_xor16(q); q = add_xor32(q);
                    const float r = __builtin_amdgcn_rsqf(q * (1.0f / 64.0f) + 1e-6f) * (mode == 2 ? QSCALE : 1.0f);
#pragma unroll
                    for (int i = 0; i < 16; ++i) v[i] = v[i] * r * g[i];
                    const float* cp = cosT + (size_t)row * 32 + 8 * fq; const float* sp = sinT + (size_t)row * 32 + 8 * fq;
#pragma unroll
                    for (int n = 0; n < 2; ++n) { const f32x4 c4 = *(const f32x4*)(cp + 4 * n), s4 = *(const f32x4*)(sp + 4 * n);
#pragma unroll
                        for (int j = 0; j < 4; ++j) { const float x1 = v[n * 4 + j], x2 = v[8 + n * 4 + j]; v[n * 4 + j] = x1 * c4[j] - x2 * s4[j]; v[8 + n * 4 + j] = x2 * c4[j] + x1 * s4[j]; } }
                }
                bf16_t* rp = dst + (size_t)row * ld + cb + 8 * fq;
                { float t[8];
#pragma unroll
                  for (int i = 0; i < 8; ++i) t[i] = v[i];
                  store8(rp, t);
#pragma unroll
                  for (int i = 0; i < 8; ++i) t[i] = v[8 + i];
                  store8(rp + 32, t); }
            }
    }
};
struct EpiFF1 {
    static constexpr bool PERM = false, AFTER_DRAIN = false;
    unsigned char* ws; int par;
    __device__ __forceinline__ void operator()(const f32x4 (&acc)[2][2][4][2], const Unit& u, int wr, int wc, int fr, int fq) const {
        const float* ssq = (const float*)(ws + (par ? TAB_SSQ1 : TAB_SSQ0)); bf16_t* HID = (bf16_t*)(ws + WS_HID);
#pragma unroll
        for (int ai = 0; ai < 2; ++ai)
#pragma unroll
            for (int m = 0; m < 4; ++m) {
                const int row = u.pm * BM + ai * HALF + wr * 64 + m * 16 + fr;
                const float rs = rstd_row(ssq, row);
                bf16_t* rp = HID + (size_t)row * DFF + u.pn * BM + wc * 64 + 8 * fq;
#pragma unroll
                for (int bj = 0; bj < 2; ++bj) { float t[8];
#pragma unroll
                    for (int n = 0; n < 2; ++n)
#pragma unroll
                        for (int j = 0; j < 4; ++j) { float x = acc[ai][bj][m][n][j] * rs; x = x > 0.f ? x : 0.f; t[n * 4 + j] = x * x; }
                    store8(rp + 32 * bj, t); }
            }
    }
};
struct EpiProj {
    static constexpr bool PERM = false, AFTER_DRAIN = false;
    unsigned char* ws;
    __device__ __forceinline__ void operator()(const f32x4 (&acc)[2][2][4][2], const Unit& u, int wr, int wc, int fr, int fq) const {
        bf16_t* O = (bf16_t*)(ws + WS_PPROJ);
#pragma unroll
        for (int ai = 0; ai < 2; ++ai)
#pragma unroll
            for (int m = 0; m < 4; ++m) {
                const int row = u.pm * BM + ai * HALF + wr * 64 + m * 16 + fr;
                bf16_t* rp = O + (size_t)row * DM + u.pn * BM + wc * 64 + 8 * fq;
#pragma unroll
                for (int bj = 0; bj < 2; ++bj) { float t[8];
#pragma unroll
                    for (int n = 0; n < 2; ++n)
#pragma unroll
                        for (int j = 0; j < 4; ++j) t[n * 4 + j] = acc[ai][bj][m][n][j];
                    store8(rp + 32 * bj, t); }
            }
    }
};
template <bool GATED> struct EpiRes {
    static constexpr bool PERM = false, AFTER_DRAIN = true;
    float* h; unsigned char* ws; int par_out;
    __device__ __forceinline__ void fused(f32x4 (&acc)[2][2][4][2], const Unit& u, int wr, int wc, int fr, int fq, PG8_LAS unsigned char* lds, int wid, int lane) const {
        bf16_t* HBo = (bf16_t*)(ws + (GATED ? WS_YCAT : WS_HB)); float* ssq_out = (float*)(ws + (par_out ? TAB_SSQ1 : TAB_SSQ0));
        const float* ssq_in = (const float*)(ws + (par_out ? TAB_SSQ0 : TAB_SSQ1)); const bf16_t* PP = (const bf16_t*)(ws + WS_PPROJ);
        PG8_LAS float* P = (PG8_LAS float*)lds;
        const int cb = u.pn * BM + wc * 64 + 8 * fq;
#pragma unroll
        for (int ai = 0; ai < 2; ++ai)
#pragma unroll
            for (int m = 0; m < 4; ++m) {
                const int rl = ai * HALF + wr * 64 + m * 16 + fr, row = u.pm * BM + rl;
                float* hp = h + (size_t)row * DM + cb;
                float rs = 1.f; if (GATED) rs = rstd_row(ssq_in, row);
                float ss = 0.f;
#pragma unroll
                for (int bj = 0; bj < 2; ++bj) {
                    f32x4 o0 = *(const f32x4*)(hp + 32 * bj), o1 = *(const f32x4*)(hp + 32 * bj + 4);
                    f32x4 a0 = acc[ai][bj][m][0], a1 = acc[ai][bj][m][1];
                    if (GATED) {
                        const u32x4 pw = *(const u32x4*)(PP + (size_t)row * DM + cb + 32 * bj);
                        a0[0] = sigmoid_fast(a0[0] * rs) * bf_lo(pw.x); a0[1] = sigmoid_fast(a0[1] * rs) * bf_hi(pw.x);
                        a0[2] = sigmoid_fast(a0[2] * rs) * bf_lo(pw.y); a0[3] = sigmoid_fast(a0[3] * rs) * bf_hi(pw.y);
                        a1[0] = sigmoid_fast(a1[0] * rs) * bf_lo(pw.z); a1[1] = sigmoid_fast(a1[1] * rs) * bf_hi(pw.z);
                        a1[2] = sigmoid_fast(a1[2] * rs) * bf_lo(pw.w); a1[3] = sigmoid_fast(a1[3] * rs) * bf_hi(pw.w);
                    }
                    o0 += a0; o1 += a1;
                    *(f32x4*)(hp + 32 * bj) = o0; *(f32x4*)(hp + 32 * bj + 4) = o1;
                    ss += (o0[0] * o0[0] + o0[1] * o0[1]) + (o0[2] * o0[2] + o0[3] * o0[3]) + (o1[0] * o1[0] + o1[1] * o1[1]) + (o1[2] * o1[2] + o1[3] * o1[3]);
                    float t[8] = {o0[0], o0[1], o0[2], o0[3], o1[0], o1[1], o1[2], o1[3]};
                    store8(HBo + (size_t)row * DM + cb + 32 * bj, t);
                }
                ss = add_xor16(ss); ss = add_xor32(ss);
                if (fq == 0) P[rl * 4 + wc] = ss;
                asm volatile("" ::: "memory");
            }
        asm volatile("s_waitcnt lgkmcnt(0)" ::: "memory"); __builtin_amdgcn_s_barrier(); asm volatile("" ::: "memory");
        const int tid = wid * 64 + lane;
        if (tid < 256) ssq_out[u.pn * NTOK + u.pm * BM + tid] = (P[tid * 4] + P[tid * 4 + 1]) + (P[tid * 4 + 2] + P[tid * 4 + 3]);
        asm volatile("s_waitcnt lgkmcnt(0)" ::: "memory"); __builtin_amdgcn_s_barrier(); asm volatile("" ::: "memory");
    }
};
}
typedef unsigned short bf16;
#define LAS __attribute__((address_space(3)))
typedef unsigned v4u __attribute__((ext_vector_type(4)));
typedef unsigned v2u __attribute__((ext_vector_type(2)));
typedef float f32x4 __attribute__((ext_vector_type(4)));
typedef short bf16x8 __attribute__((ext_vector_type(8)));
typedef short s16x4 __attribute__((ext_vector_type(4)));
constexpr int NWAVES = 8;
__device__ __forceinline__ float max_xor16(float v) { return fmaxf(v, xor_lane<16>(v)); }
__device__ __forceinline__ float max_xor32(float v) { auto r = __builtin_amdgcn_permlane32_swap(__float_as_uint(v), __float_as_uint(v), false, false); return fmaxf(__uint_as_float(r[0]), __uint_as_float(r[1])); }
__device__ __forceinline__ bf16x8 tr_frag(LAS const unsigned char* p, LAS const unsigned char* p2) {
    const s16x4 lo = __builtin_bit_cast(s16x4, __builtin_amdgcn_ds_read_tr16_b64_v4i16((LAS s16x4*)p));
    const s16x4 hi = __builtin_bit_cast(s16x4, __builtin_amdgcn_ds_read_tr16_b64_v4i16((LAS s16x4*)p2));
    return (bf16x8){lo[0], lo[1], lo[2], lo[3], hi[0], hi[1], hi[2], hi[3]};
}
#define WG_BARRIER() do { asm volatile("s_waitcnt vmcnt(0) lgkmcnt(0)" ::: "memory"); __builtin_amdgcn_s_barrier(); asm volatile("" ::: "memory"); } while (0)

constexpr int GM_ROWB = 528;
constexpr int GM_SS = 128 * GM_ROWB;
__device__ __forceinline__ void gmlp_item(unsigned char* ws, int L, LAS unsigned char* lds, int item, int wv, int lane_unused) {
    const int lane = fresh_lane();
    const int tok0 = item * 128, tid = wv * 64 + lane;
    const bf16* VLN = (const bf16*)(ws + WS_VLN); const bf16* U = (const bf16*)(ws + WS_U); bf16* YC = (bf16*)(ws + WS_YCAT);
    const bf16* GW = (const bf16*)(ws + TAB_GW) + (size_t)L * 4 * 128 * 128;
    const float* bsv = (const float*)(ws + TAB_SMALL) + L * SM_STRIDE + SM_GBS;
    for (int q = tid; q < 128 * 32; q += NWAVES * 64) { const int s = q >> 5, c = q & 31;
        const v4u x = *(const v4u*)(VLN + (size_t)(tok0 + s) * 256 + c * 8); *(LAS v4u*)(lds + s * GM_ROWB + c * 16) = x; }
    WG_BARRIER();
    const int h = wv >> 1, th = wv & 1, fr = lane & 15, g4 = lane >> 4;
    f32x4 acc[4][4];
#pragma unroll
    for (int m = 0; m < 4; ++m)
#pragma unroll
        for (int n = 0; n < 4; ++n) acc[m][n] = (f32x4){0.f, 0.f, 0.f, 0.f};
#pragma unroll
    for (int m = 0; m < 4; ++m) {
        const int t0 = 64 * th + 16 * m, nks = (t0 >> 5) + 1;
        for (int ks = 0; ks < nks; ++ks) {
            const int s0 = 32 * ks;
            const bf16x8 wf = *(const bf16x8*)(GW + ((size_t)h * 128 + t0 + fr) * 128 + s0 + 8 * g4);
#pragma unroll
            for (int n = 0; n < 4; ++n) {
                LAS const unsigned char* p = lds + (s0 + 8 * g4 + (fr >> 2)) * GM_ROWB + (h * 64 + 16 * n + 4 * (fr & 3)) * 2;
                const bf16x8 vf = tr_frag(p, p + 4 * GM_ROWB);
                acc[m][n] = __builtin_amdgcn_mfma_f32_16x16x32_bf16(vf, wf, acc[m][n], 0, 0, 0);
            }
        }
    }
    LAS float* SS = (LAS float*)(lds + GM_SS);
#pragma unroll
    for (int m = 0; m < 4; ++m) {
        const int t = 64 * th + 16 * m + fr; const float bb = bsv[h * 128 + t]; float ss = 0.f;
#pragma unroll
        for (int n = 0; n < 4; ++n) {
            const v2u uw = *(const v2u*)(U + (size_t)(tok0 + t) * 256 + h * 64 + 16 * n + 4 * g4);
            f32x4 y; y[0] = bf_lo(uw.x) * (acc[m][n][0] + bb); y[1] = bf_hi(uw.x) * (acc[m][n][1] + bb); y[2] = bf_lo(uw.y) * (acc[m][n][2] + bb); y[3] = bf_hi(uw.y) * (acc[m][n][3] + bb);
            acc[m][n] = y; ss += (y[0] * y[0] + y[1] * y[1]) + (y[2] * y[2] + y[3] * y[3]);
        }
        ss = add_xor16(ss); ss = add_xor32(ss);
        if (g4 == 0) SS[h * 128 + t] = ss;
    }
    WG_BARRIER();
#pragma unroll
    for (int m = 0; m < 4; ++m) {
        const int t = 64 * th + 16 * m + fr;
        const float tot = (SS[t] + SS[128 + t]) + (SS[256 + t] + SS[384 + t]);
        const float r = __builtin_amdgcn_rsqf(tot * (1.0f / 256.0f) + 1e-6f);
#pragma unroll
        for (int n = 0; n < 4; ++n) { v2u o; o.x = pk2(acc[m][n][0] * r, acc[m][n][1] * r); o.y = pk2(acc[m][n][2] * r, acc[m][n][3] * r);
            *(v2u*)(YC + (size_t)(tok0 + t) * DM + h * 64 + 16 * n + 4 * g4) = o; }
    }
    WG_BARRIER();
}

constexpr int AT_ROWB = 272;
constexpr int AT_V = 192 * AT_ROWB, AT_SS = 2 * 192 * AT_ROWB;
__device__ __forceinline__ void attn_item(unsigned char* ws, int L, LAS unsigned char* lds, int item, int wv, int lane_unused) {
    const int lane = fresh_lane();
    const int b = item >> 7, q0 = (item & 127) * 64, tokb = b * SEQL, tid = wv * 64 + lane;
    const bf16* Q = (const bf16*)(ws + WS_Q); const bf16* K = (const bf16*)(ws + WS_K); const bf16* V = (const bf16*)(ws + WS_V); bf16* YC = (bf16*)(ws + WS_YCAT);
    for (int q = tid; q < 192 * 16; q += NWAVES * 64) { const int r = q >> 4, c = q & 15, j = q0 - 128 + r;
        v4u kx = (v4u){0u, 0u, 0u, 0u}, vx = kx;
        if (j >= 0) { kx = *(const v4u*)(K + (size_t)(tokb + j) * 128 + c * 8); vx = *(const v4u*)(V + (size_t)(tokb + j) * 128 + c * 8); }
        *(LAS v4u*)(lds + r * AT_ROWB + c * 16) = kx; *(LAS v4u*)(lds + AT_V + r * AT_ROWB + c * 16) = vx; }
    WG_BARRIER();
    const int hq = wv, hkv = wv >> 2, fr = lane & 15, g4 = lane >> 4;
    const float sink2 = ((const float*)(ws + TAB_SMALL))[L * SM_STRIDE + SM_SINK + hq] * LOG2E;
    LAS float* SS = (LAS float*)(lds + AT_SS);
    for (int qt = 0; qt < 4; ++qt) {
        const size_t tq = (size_t)(tokb + q0 + 16 * qt + fr);
        bf16x8 qf[2];
#pragma unroll
        for (int ks = 0; ks < 2; ++ks) qf[ks] = *(const bf16x8*)(Q + tq * 512 + hq * 64 + 32 * ks + 8 * g4);
        f32x4 s[12];
#pragma unroll
        for (int kt = 0; kt < 12; ++kt) { s[kt] = (f32x4){0.f, 0.f, 0.f, 0.f};
#pragma unroll
            for (int ks = 0; ks < 2; ++ks) { const bf16x8 kf = *(LAS const bf16x8*)(lds + (16 * kt + fr) * AT_ROWB + (hkv * 64 + 32 * ks + 8 * g4) * 2);
                s[kt] = __builtin_amdgcn_mfma_f32_16x16x32_bf16(kf, qf[ks], s[kt], 0, 0, 0); } }
        const int diff0 = 128 + 16 * qt + fr - 4 * g4, j0 = q0 - 128 + 4 * g4;
        float mx = -INFINITY;
#pragma unroll
        for (int kt = 0; kt < 12; ++kt)
#pragma unroll
            for (int r = 0; r < 4; ++r) { const int diff = diff0 - 16 * kt - r; const bool ok = (diff >= 0) && (diff < 128) && (j0 + 16 * kt + r >= 0);
                s[kt][r] = ok ? s[kt][r] : -INFINITY; mx = fmaxf(mx, s[kt][r]); }
        mx = max_xor16(mx); mx = max_xor32(mx); mx = fmaxf(mx, sink2);
        float sum = 0.f;
#pragma unroll
        for (int kt = 0; kt < 12; ++kt)
#pragma unroll
            for (int r = 0; r < 4; ++r) { s[kt][r] = __builtin_amdgcn_exp2f(s[kt][r] - mx); sum += s[kt][r]; }
        sum = add_xor16(sum); sum = add_xor32(sum); sum += __builtin_amdgcn_exp2f(sink2 - mx);
        const float inv_l = __builtin_amdgcn_rcpf(sum);
        f32x4 o[4];
#pragma unroll
        for (int dt = 0; dt < 4; ++dt) o[dt] = (f32x4){0.f, 0.f, 0.f, 0.f};
#pragma unroll
        for (int kk = 0; kk < 6; ++kk) {
            v4u pw; pw.x = pk2(s[2 * kk][0], s[2 * kk][1]); pw.y = pk2(s[2 * kk][2], s[2 * kk][3]); pw.z = pk2(s[2 * kk + 1][0], s[2 * kk + 1][1]); pw.w = pk2(s[2 * kk + 1][2], s[2 * kk + 1][3]);
            const bf16x8 pf = __builtin_bit_cast(bf16x8, pw);
#pragma unroll
            for (int dt = 0; dt < 4; ++dt) {
                LAS const unsigned char* p = lds + AT_V + (32 * kk + 4 * g4 + (fr >> 2)) * AT_ROWB + (hkv * 64 + 16 * dt + 4 * (fr & 3)) * 2;
                const bf16x8 vf = tr_frag(p, p + 16 * AT_ROWB);
                o[dt] = __builtin_amdgcn_mfma_f32_16x16x32_bf16(vf, pf, o[dt], 0, 0, 0);
            }
        }
        float ss = 0.f;
#pragma unroll
        for (int dt = 0; dt < 4; ++dt) { o[dt] = o[dt] * inv_l; ss += (o[dt][0] * o[dt][0] + o[dt][1] * o[dt][1]) + (o[dt][2] * o[dt][2] + o[dt][3] * o[dt][3]); }
        ss = add_xor16(ss); ss = add_xor32(ss);
        if (g4 == 0) SS[hq * 64 + 16 * qt + fr] = ss;
        WG_BARRIER();
        float tot = 0.f;
#pragma unroll
        for (int hh = 0; hh < 8; ++hh) tot += SS[hh * 64 + 16 * qt + fr];
        const float r = __builtin_amdgcn_rsqf(tot * (1.0f / 512.0f) + 1e-6f);
#pragma unroll
        for (int dt = 0; dt < 4; ++dt) { v2u ow; ow.x = pk2(o[dt][0] * r, o[dt][1] * r); ow.y = pk2(o[dt][2] * r, o[dt][3] * r);
            *(v2u*)(YC + tq * DM + 256 + hq * 64 + 16 * dt + 4 * g4) = ow; }
    }
    WG_BARRIER();
}
__device__ __forceinline__ double d_exp(double x) {
    const double k = __builtin_rint(x * 1.4426950408889634), r = x - k * 0.6931471805599453;
    double e = 1.0, term = 1.0;
    for (int n = 1; n <= 20; ++n) { term *= r / (double)n; e += term; }
    const long long bits = (long long)(1023 + (int)k) << 52;
    return e * __builtin_bit_cast(double, bits);
}
__device__ __forceinline__ void d_sincos(double th, double& sn, double& cs) {
    const double q = __builtin_rint(th * 0.15915494309189535), r = th - q * 6.283185307179586, r2 = -r * r;
    double s = r, c = 1.0, ts = r, tc = 1.0;
    for (int n = 1; n <= 14; ++n) { tc *= r2 / (double)((2 * n - 1) * (2 * n)); c += tc; ts *= r2 / (double)((2 * n) * (2 * n + 1)); s += ts; }
    sn = s; cs = c;
}
__device__ __forceinline__ void ssm_tables(const float* const* in, unsigned char* ws, int gtid, int nthreads) {
    for (int i = gtid; i < NLAYER * 16 * 64; i += nthreads) {
        const int p = i & 63, lg = i >> 6;
        const double lre = in[12][i], lim = in[13][i], dt = d_exp((double)in[14][lg]);
        const double er = d_exp(lre * dt); double sn, cs; d_sincos(lim * dt, sn, cs);
        const double lbr = er * cs, lbi = er * sn;
        const double nr = lbr - 1.0, ni = lbi, den = lre * lre + lim * lim;
        const double fr_ = (nr * lre + ni * lim) / den, fi_ = (ni * lre - nr * lim) / den;
        float* bbc = (float*)(ws + SSM_BBC) + (size_t)i * 32; bf16* bbt = (bf16*)(ws + SSM_BBT) + (size_t)lg * 128 * 16;
        for (int h = 0; h < 16; ++h) { const double br = in[15][i * 16 + h], bi = in[16][i * 16 + h]; const float re = (float)(fr_ * br - fi_ * bi), im = (float)(fr_ * bi + fi_ * br);
            bbc[2 * h] = re; bbc[2 * h + 1] = im; bbt[p * 16 + h] = (bf16)(pk2(re, 0.f) & 0xffffu); bbt[(64 + p) * 16 + h] = (bf16)(pk2(im, 0.f) & 0xffffu); }
        bf16* cct = (bf16*)(ws + SSM_CCT) + (size_t)lg * 16 * 128;
        for (int hp = 0; hp < 16; ++hp) { const float cre = in[17][(lg * 16 + hp) * 64 + p], cim = in[18][(lg * 16 + hp) * 64 + p]; *(unsigned*)(cct + hp * 128 + 2 * p) = pk2(cre, -cim); }
        float* pw = (float*)(ws + SSM_PW) + (size_t)lg * 65 * 128;
        double xr = 1.0, xi = 0.0;
        float* w1 = (float*)(ws + SSM_W1) + (size_t)lg * 8192;
        for (int n = 0; n <= 64; ++n) { pw[(n * 64 + p) * 2] = (float)xr; pw[(n * 64 + p) * 2 + 1] = (float)xi;
            if (n < 64) { const int t = 63 - n, ln = ((t >> 2) & 3) * 16 + (p & 15), o = ((ln * 16 + (t >> 4) * 4 + (t & 3)) * 4 + (p >> 4)) * 2; w1[o] = (float)xr; w1[o + 1] = (float)xi; }
            const double t = xr * lbr - xi * lbi; xi = xr * lbi + xi * lbr; xr = t; }
    }
}
__device__ __forceinline__ void ssm_ktable(const float* const* in, unsigned char* ws, int gtid, int nthreads) {
    bf16* KT = (bf16*)(ws + SSM_KT);
    for (int i = gtid; i < NLAYER * 16 * 64 * 256; i += nthreads) {
        const int h = i & 15, hp = (i >> 4) & 15, tau = (i >> 8) & 63, lg = i >> 14;
        const float* pw = (const float*)(ws + SSM_PW) + ((size_t)lg * 65 + tau) * 128; const float* bbc = (const float*)(ws + SSM_BBC) + (size_t)lg * 64 * 32 + 2 * h;
        const float* cre = in[17] + (size_t)(lg * 16 + hp) * 64; const float* cim = in[18] + (size_t)(lg * 16 + hp) * 64;
        float acc = 0.f;
        for (int p = 0; p < 64; ++p) { const float zr = pw[2 * p], zi = pw[2 * p + 1], br = bbc[p * 32], bi = bbc[p * 32 + 1];
            acc += cre[p] * (zr * br - zi * bi) - cim[p] * (zr * bi + zi * br); }
        if (tau == 0 && h == hp) acc += in[19][lg * 16 + hp];
        KT[i] = (bf16)(pk2(acc, 0.f) & 0xffffu);
    }
}
__device__ __forceinline__ void ssm1_item(unsigned char* ws, int L, int item, int wv, int lane_unused) {
    const int tok0 = item * 64;
    const bf16* ZC = (const bf16*)(ws + WS_ZC); float* S = (float*)(ws + SSM_S);
    const bf16x8 zero8 = (bf16x8){0, 0, 0, 0, 0, 0, 0, 0};
    for (int gi = 0; gi < 2; ++gi) {
        const int g = 2 * wv + gi, lg = L * 16 + g;
        const int lane = fresh_lane(), fr = lane & 15, g4 = lane >> 4;
        const bf16* bbt = (const bf16*)(ws + SSM_BBT) + (size_t)lg * 128 * 16; const float* w1 = (const float*)(ws + SSM_W1) + (size_t)lg * 8192 + lane * 128;
        bf16x8 bfr[8];
#pragma unroll
        for (int n = 0; n < 8; ++n) bfr[n] = (g4 < 2) ? *(const bf16x8*)(bbt + (16 * n + fr) * 16 + 8 * g4) : zero8;
        float sre[4] = {0.f, 0.f, 0.f, 0.f}, sim[4] = {0.f, 0.f, 0.f, 0.f};
#pragma unroll
        for (int m = 0; m < 4; ++m) {
            const bf16x8 uf = (g4 < 2) ? *(const bf16x8*)(ZC + (size_t)(tok0 + 16 * m + fr) * 256 + g * 16 + 8 * g4) : zero8;
            f32x4 d[8];
#pragma unroll
            for (int n = 0; n < 8; ++n) d[n] = __builtin_amdgcn_mfma_f32_16x16x32_bf16(uf, bfr[n], (f32x4){0.f, 0.f, 0.f, 0.f}, 0, 0, 0);
#pragma unroll
            for (int r = 0; r < 4; ++r) { const f32x4 wa = *(const f32x4*)(w1 + (m * 4 + r) * 8), wb = *(const f32x4*)(w1 + (m * 4 + r) * 8 + 4);
                const float wre[4] = {wa[0], wa[2], wb[0], wb[2]}, wim[4] = {wa[1], wa[3], wb[1], wb[3]};
#pragma unroll
                for (int q = 0; q < 4; ++q) { const float br = d[q][r], bi = d[q + 4][r];
                    sre[q] += wre[q] * br - wim[q] * bi; sim[q] += wre[q] * bi + wim[q] * br; } }
        }
#pragma unroll
        for (int q = 0; q < 4; ++q) { sre[q] = add_xor16(sre[q]); sre[q] = add_xor32(sre[q]); sim[q] = add_xor16(sim[q]); sim[q] = add_xor32(sim[q]);
            if (g4 == 0) *(f32x2_t*)(S + ((size_t)(item * 16 + g) * 64 + 16 * q + fr) * 2) = (f32x2_t){sre[q], sim[q]}; }
    }
}
constexpr int S2_ROWB = 528, S2_XIN = 80 * S2_ROWB, S2_YT = S2_XIN + 8192, S2_SS = S2_YT + 64 * S2_ROWB;
__device__ __forceinline__ void ssm2_item(unsigned char* ws, int L, LAS unsigned char* lds, int item, int wv, int lane_unused) {
    const int lane = fresh_lane();
    const int tok0 = item * 64, b = item >> 7, c = item & 127, tid = wv * 64 + lane, fr = lane & 15, g4 = lane >> 4;
    const bf16* ZC = (const bf16*)(ws + WS_ZC); const float* S = (const float*)(ws + SSM_S);
    for (int q = tid; q < 80 * 32; q += NWAVES * 64) { const int r = q >> 5, cc = q & 31; v4u x = (v4u){0u, 0u, 0u, 0u};
        if (r >= 16) x = *(const v4u*)(ZC + (size_t)(tok0 + r - 16) * 256 + cc * 8);
        *(LAS v4u*)(lds + r * S2_ROWB + cc * 16) = x; }
#pragma unroll
    for (int k = 0; k < 2; ++k) { const int ch = tid + 512 * k, g = ch >> 6, p = ch & 63;
        const f32x2_t lam = *(const f32x2_t*)((const float*)(ws + SSM_PW) + ((size_t)(L * 16 + g) * 65 + 64) * 128 + 2 * p);
        float xr = 0.f, xi = 0.f; const float* sp = S + ((size_t)(b * 128) * 1024 + ch) * 2;
#pragma unroll 16
        for (int cp = 0; cp < c; ++cp) { const f32x2_t s = *(const f32x2_t*)(sp + (size_t)cp * 2048); const float t = lam[0] * xr - lam[1] * xi + s[0]; xi = lam[0] * xi + lam[1] * xr + s[1]; xr = t; }
        *(LAS f32x2_t*)(lds + S2_XIN + ch * 8) = (f32x2_t){xr, xi}; }
    WG_BARRIER();
    for (int gi = 0; gi < 2; ++gi) {
        const int g = 2 * wv + gi, lg = L * 16 + g;
        int fr, g4; { const int l2 = fresh_lane(); fr = l2 & 15; g4 = l2 >> 4; }
        const bf16* kt = (const bf16*)(ws + SSM_KT) + (size_t)lg * 64 * 256 + fr * 16 + 8 * (g4 & 1);
        LAS const unsigned char* ub = lds + (16 + fr - (g4 >> 1)) * S2_ROWB + (g * 16 + 8 * (g4 & 1)) * 2;
        f32x4 acc[4];
#pragma unroll
        for (int m = 0; m < 4; ++m) acc[m] = (f32x4){0.f, 0.f, 0.f, 0.f};
#pragma unroll
        for (int seg = 0; seg < 4; ++seg)
            for (int lp = 8 * seg; lp < 8 * seg + 8; ++lp) {
                const bf16x8 kf = *(const bf16x8*)(kt + (2 * lp + (g4 >> 1)) * 256);
#pragma unroll
                for (int m = seg; m < 4; ++m) { const bf16x8 uf = *(LAS const bf16x8*)(ub + (16 * m - 2 * lp) * S2_ROWB); acc[m] = __builtin_amdgcn_mfma_f32_16x16x32_bf16(uf, kf, acc[m], 0, 0, 0); }
            }
        { const int l2 = fresh_lane(); fr = l2 & 15; g4 = l2 >> 4; }
        const bf16* cct = (const bf16*)(ws + SSM_CCT) + (size_t)lg * 16 * 128 + fr * 128 + 8 * g4;
        const float* pwg = (const float*)(ws + SSM_PW) + (size_t)lg * 65 * 128;
#pragma unroll
        for (int ks = 0; ks < 4; ++ks) {
            const bf16x8 cf = *(const bf16x8*)(cct + 32 * ks);
            const int p4 = 16 * ks + 4 * g4;
            const f32x4 x01 = *(LAS const f32x4*)(lds + S2_XIN + (g * 64 + p4) * 8), x23 = *(LAS const f32x4*)(lds + S2_XIN + (g * 64 + p4) * 8 + 16);
#pragma unroll
            for (int m = 0; m < 4; ++m) {
                const float* w = pwg + ((size_t)(16 * m + fr + 1) * 64 + p4) * 2;
                const f32x4 w01 = *(const f32x4*)w, w23 = *(const f32x4*)(w + 4);
                v4u zw; zw.x = pk2(w01[0] * x01[0] - w01[1] * x01[1], w01[0] * x01[1] + w01[1] * x01[0]); zw.y = pk2(w01[2] * x01[2] - w01[3] * x01[3], w01[2] * x01[3] + w01[3] * x01[2]);
                zw.z = pk2(w23[0] * x23[0] - w23[1] * x23[1], w23[0] * x23[1] + w23[1] * x23[0]); zw.w = pk2(w23[2] * x23[2] - w23[3] * x23[3], w23[2] * x23[3] + w23[3] * x23[2]);
                acc[m] = __builtin_amdgcn_mfma_f32_16x16x32_bf16(__builtin_bit_cast(bf16x8, zw), cf, acc[m], 0, 0, 0);
            }
        }
#pragma unroll
        for (int m = 0; m < 4; ++m)
#pragma unroll
            for (int r = 0; r < 4; ++r) *(LAS bf16*)(lds + S2_YT + (16 * m + 4 * g4 + r) * S2_ROWB + (g * 16 + fr) * 2) = (bf16)(pk2(gelu_fast(acc[m][r]), 0.f) & 0xffffu);
    }
    WG_BARRIER();
    {
        const int l2 = fresh_lane(), fr = l2 & 15, g4 = l2 >> 4;
        const bf16* wg = (const bf16*)(ws + WS_W + (size_t)L * LW_STRIDE + LW_GLU) + (size_t)(32 * wv + fr) * 256 + 8 * g4;
        LAS const unsigned char* yb = lds + S2_YT + fr * S2_ROWB + 16 * g4;
        f32x4 ga[2][4], gb[2][4];
#pragma unroll
        for (int nt = 0; nt < 2; ++nt)
#pragma unroll
            for (int m = 0; m < 4; ++m) { ga[nt][m] = (f32x4){0.f, 0.f, 0.f, 0.f}; gb[nt][m] = (f32x4){0.f, 0.f, 0.f, 0.f}; }
#pragma unroll 2
        for (int ks = 0; ks < 8; ++ks) {
            bf16x8 yf[4];
#pragma unroll
            for (int m = 0; m < 4; ++m) yf[m] = *(LAS const bf16x8*)(yb + 16 * m * S2_ROWB + 64 * ks);
#pragma unroll
            for (int nt = 0; nt < 2; ++nt) {
                const bf16x8 wa = *(const bf16x8*)(wg + (size_t)(16 * nt) * 256 + 32 * ks), wb = *(const bf16x8*)(wg + (size_t)(256 + 16 * nt) * 256 + 32 * ks);
#pragma unroll
                for (int m = 0; m < 4; ++m) { ga[nt][m] = __builtin_amdgcn_mfma_f32_16x16x32_bf16(wa, yf[m], ga[nt][m], 0, 0, 0); gb[nt][m] = __builtin_amdgcn_mfma_f32_16x16x32_bf16(wb, yf[m], gb[nt][m], 0, 0, 0); }
            }
        }
        LAS float* SS = (LAS float*)(lds + S2_SS);
#pragma unroll
        for (int m = 0; m < 4; ++m) { float ss = 0.f;
#pragma unroll
            for (int nt = 0; nt < 2; ++nt)
#pragma unroll
                for (int r = 0; r < 4; ++r) { const float v = ga[nt][m][r] * sigmoid_fast(gb[nt][m][r]); ga[nt][m][r] = v; ss += v * v; }
            ss = add_xor16(ss); ss = add_xor32(ss);
            if (g4 == 0) SS[wv * 64 + 16 * m + fr] = ss; }
        WG_BARRIER();
        bf16* YC = (bf16*)(ws + WS_YCAT);
#pragma unroll
        for (int m = 0; m < 4; ++m) { float tot = 0.f;
#pragma unroll
            for (int w8 = 0; w8 < 8; ++w8) tot += SS[w8 * 64 + 16 * m + fr];
            const float rr = __builtin_amdgcn_rsqf(tot * (1.0f / 256.0f) + 1e-6f);
#pragma unroll
            for (int nt = 0; nt < 2; ++nt) { v2u o; o.x = pk2(ga[nt][m][0] * rr, ga[nt][m][1] * rr); o.y = pk2(ga[nt][m][2] * rr, ga[nt][m][3] * rr);
                *(v2u*)(YC + (size_t)(tok0 + 16 * m + fr) * DM + 768 + 32 * wv + 16 * nt + 4 * g4) = o; } }
    }
    WG_BARRIER();
}
#define XB_TMO      128
#define XB_XCNT(j)  (256  + 64 * (j))
#define XB_XSUB(j)  (1280 + 64 * (j))
#define XB_XGEN(j)  (2304 + 64 * (j))
#define XB_TOP      3328
#define XB_TOPGEN   3392
#define XCD_BAR_WORDS 3456
#define XB_SPIN_CAP (1u << 18)

__device__ __forceinline__ unsigned xb_ld(unsigned* p)              { return __hip_atomic_load(p, __ATOMIC_RELAXED, __HIP_MEMORY_SCOPE_AGENT); }
__device__ __forceinline__ unsigned xb_add(unsigned* p, unsigned v) { return __hip_atomic_fetch_add(p, v, __ATOMIC_RELAXED, __HIP_MEMORY_SCOPE_AGENT); }
__device__ __forceinline__ unsigned xb_xcc_id() { return (unsigned)__builtin_amdgcn_s_getreg((3 << 11) | 20) & 0xFu; }
#define XB_SPIN(cond, bar) do { unsigned _sp = 0; while (cond) { __builtin_amdgcn_s_sleep(1); \
    if ((++_sp & 255u) == 0u) { if (xb_ld(&(bar)[XB_TMO])) break; if (_sp > XB_SPIN_CAP) { atomicAdd(&(bar)[XB_TMO], 1u); break; } } } } while (0)

struct XcdBarrier {
    unsigned* bar; unsigned x;
    volatile LAS unsigned* st;
};

__device__ __forceinline__ XcdBarrier xcd_barrier_post(unsigned* bar, volatile LAS unsigned* st, bool leader) {
    XcdBarrier b; b.bar = bar; b.x = xb_xcc_id(); b.st = st;
    if (leader) (void)xb_add(&bar[XB_XCNT(b.x)], 1u);
    return b;
}
__device__ __forceinline__ void xcd_barrier_complete(unsigned* bar, unsigned x, unsigned& nloc, unsigned& nx) {
    const unsigned G = gridDim.x * gridDim.y * gridDim.z;
    unsigned sum, cnt, mine, sp = 0u;
    for (;;) {
        sum = 0u; cnt = 0u; mine = 0u;
#pragma unroll
        for (unsigned j = 0; j < 16; ++j) { const unsigned c = xb_ld(&bar[XB_XCNT(j)]); sum += c; cnt += (c > 0u) ? 1u : 0u; mine = (j == x) ? c : mine; }
        if (sum == G) break;
        __builtin_amdgcn_s_sleep(1);
        if ((++sp & 255u) == 0u) { if (xb_ld(&bar[XB_TMO])) break; if (sp > XB_SPIN_CAP) { atomicAdd(&bar[XB_TMO], 1u); break; } }
    }
    nloc = mine > 0u ? mine : 1u; nx = cnt > 0u ? cnt : 1u;
}

__device__ __forceinline__ void xcd_barrier(const XcdBarrier& b, bool leader) {
    asm volatile("s_waitcnt vmcnt(0)" ::: "memory");
    __syncthreads();
    if (leader) {
        unsigned* bar = b.bar;
        __builtin_amdgcn_s_waitcnt(0);
        unsigned nloc = b.st[0], nx = b.st[1];
        if (nloc == 0u) { xcd_barrier_complete(bar, b.x, nloc, nx); b.st[0] = nloc; b.st[1] = nx; }
        const unsigned old = xb_add(&bar[XB_XSUB(b.x)], 1u);
        const unsigned gen = old / nloc;
        if (old + 1u == (gen + 1u) * nloc) {
            __builtin_amdgcn_fence(__ATOMIC_RELEASE, "agent");
            asm volatile("s_waitcnt vmcnt(0)" ::: "memory");
            const unsigned og = xb_add(&bar[XB_TOP], 1u);
            const unsigned tg = og / nx;
            if (og + 1u == (tg + 1u) * nx) xb_add(&bar[XB_TOPGEN], 1u);
            else XB_SPIN(xb_ld(&bar[XB_TOPGEN]) == tg, bar);
            __builtin_amdgcn_fence(__ATOMIC_ACQUIRE, "agent");
            xb_add(&bar[XB_XGEN(b.x)], 1u);
            asm volatile("s_waitcnt vmcnt(0)" ::: "memory");
        } else {
            XB_SPIN(xb_ld(&bar[XB_XGEN(b.x)]) == gen, bar);
            __builtin_amdgcn_fence(__ATOMIC_ACQUIRE, "agent");
            asm volatile("s_waitcnt vmcnt(0)" ::: "memory");
        }
    }
    __syncthreads();
}
constexpr int LDS_BYTES = 147456;

__device__ __forceinline__ void prep_transpose_item(const float* W, int K, int N, const float* g, bf16* WT, LAS float* scr, int item, int lane, bool perm) {
    const int nblk = N / 32, kb = item / nblk, nb = item % nblk, k0 = 64 * kb, p0 = 32 * nb;
    const int c0 = p0 & 255, lbase = perm ? (p0 & ~255) + 64 * ((c0 >> 5) & 3) + 32 * (c0 >> 7) : p0;
#pragma unroll 8
    for (int i = 0; i < 32; ++i) { const int kk = 2 * i + (lane >> 5); float w = W[(size_t)(k0 + kk) * N + lbase + (lane & 31)]; if (g) w *= g[k0 + kk]; scr[kk * 33 + (lane & 31)] = w; }
    asm volatile("s_waitcnt lgkmcnt(0)" ::: "memory");
    const int c = lane & 7;
#pragma unroll
    for (int j = 0; j < 4; ++j) { const int x = (lane >> 3) + 8 * j; const int px = perm ? 8 * ((x >> 2) & 3) + 4 * (x >> 4) + (x & 3) : x; const LAS float* s = scr + (8 * c) * 33 + px;
        v4u o; o.x = pk2(s[0 * 33], s[1 * 33]); o.y = pk2(s[2 * 33], s[3 * 33]); o.z = pk2(s[4 * 33], s[5 * 33]); o.w = pk2(s[6 * 33], s[7 * 33]);
        *(v4u*)(WT + (size_t)(p0 + x) * K + k0 + 8 * c) = o; }
    asm volatile("s_waitcnt lgkmcnt(0)" ::: "memory");
}
struct Args { const float* in[30]; float* out; unsigned char* ws; int s_lo, s_hi; };

__device__ __forceinline__ void prologue_phase(const Args& a, unsigned char* ws, float* outp, LAS unsigned char* lds, int gw, int NGW, int wave, int lane) {
    LAS float* scr = (LAS float*)(lds + wave * 16384);
    constexpr int I_IN = 16 * 48, I_OUT = 16 * 32, I_FF1 = 16 * 128, I_FF2 = 64 * 32, I_GATE = 16 * 32, I_PROJ = 4 * 32, I_GLU = 4 * 8, I_L = I_IN + I_OUT + I_FF1 + I_FF2 + I_GATE + I_PROJ + 2 * I_GLU;
    for (int it = gw; it < NLAYER * I_L; it += NGW) {
        const int L = it / I_L; int r = it % I_L; unsigned char* wl = ws + WS_W + (size_t)L * LW_STRIDE;
        const float* W; const float* gg; bf16* WT; int K, N; bool perm = true;
        if (r < I_IN) { W = a.in[4] + (size_t)L * DM * NIN; K = DM; N = NIN; gg = a.in[3] + L * DM; WT = (bf16*)(wl + LW_IN); }
        else if ((r -= I_IN) < I_OUT) { W = a.in[23] + (size_t)L * DM * DM; K = DM; N = DM; gg = a.in[22] + L * DM; WT = (bf16*)(wl + LW_OUT); }
        else if ((r -= I_OUT) < I_FF1) { W = a.in[25] + (size_t)L * DM * DFF; K = DM; N = DFF; gg = a.in[24] + L * DM; WT = (bf16*)(wl + LW_FF1); }
        else if ((r -= I_FF1) < I_FF2) { W = a.in[26] + (size_t)L * DFF * DM; K = DFF; N = DM; gg = nullptr; WT = (bf16*)(wl + LW_FF2); }
        else if ((r -= I_FF2) < I_GATE) { W = a.in[28] + (size_t)L * DM * DM; K = DM; N = DM; gg = a.in[27] + L * DM; WT = (bf16*)(wl + LW_GATE); }
        else if ((r -= I_GATE) < I_PROJ) { W = a.in[29] + (size_t)L * 256 * DM; K = 256; N = DM; gg = nullptr; WT = (bf16*)(wl + LW_PROJ); }
        else if ((r -= I_PROJ) < I_GLU) { W = a.in[20] + (size_t)L * 65536; K = 256; N = 256; gg = nullptr; WT = (bf16*)(wl + LW_GLU); perm = false; }
        else { r -= I_GLU; W = a.in[21] + (size_t)L * 65536; K = 256; N = 256; gg = nullptr; WT = (bf16*)(wl + LW_GLU) + 65536; perm = false; }
        prep_transpose_item(W, K, N, gg, WT, scr, r, lane, perm);
    }
    {
        const float* x = a.in[0]; float* h = outp; bf16* hb = (bf16*)(ws + WS_YCAT); float* ssq = (float*)(ws + TAB_SSQ0);
        for (int m = gw; m < NTOK; m += NGW) {
            const f32x4* xr = (const f32x4*)(x + (size_t)m * DM) + lane; f32x4* hr = (f32x4*)(h + (size_t)m * DM) + lane;
            unsigned long long* o8 = (unsigned long long*)(hb + (size_t)m * DM) + lane; float s = 0.f;
#pragma unroll
            for (int j = 0; j < 4; ++j) { const f32x4 v = xr[64 * j]; hr[64 * j] = v; s += (v[0] * v[0] + v[1] * v[1]) + (v[2] * v[2] + v[3] * v[3]);
                o8[64 * j] = (unsigned long long)pk2(v[0], v[1]) | ((unsigned long long)pk2(v[2], v[3]) << 32); }
            s = wave_sum(s);
            if (lane < 4) ssq[lane * NTOK + m] = (lane == 0) ? s : 0.f;
        }
    }
    {
        const int* pos = (const int*)a.in[2]; float* cosT = (float*)(ws + TAB_COS); float* sinT = (float*)(ws + TAB_SIN);
        for (int i = gw * 64 + lane; i < NTOK * 32; i += NGW * 64) { const int tok = i >> 5, k = i & 31;
            const double rev = (double)pos[tok] * ROPE_INV_REV[k]; const float r = (float)(rev - __builtin_rint(rev));
            cosT[i] = __builtin_amdgcn_cosf(r); sinT[i] = __builtin_amdgcn_sinf(r); }
    }
    {
        bf16* gwt = (bf16*)(ws + TAB_GW);
        for (int i = gw * 64 + lane; i < NLAYER * 4 * 128 * 128; i += NGW * 64) { const int s_ = i & 127, t_ = (i >> 7) & 127; gwt[i] = (bf16)(pk2(s_ <= t_ ? a.in[7][i] : 0.f, 0.f) & 0xffffu); }
    }
    ssm_tables(a.in, ws, gw * 64 + lane, NGW * 64);
    {
        float* sm = (float*)(ws + TAB_SMALL);
        for (int i = gw * 64 + lane; i < NLAYER * SM_STRIDE; i += NGW * 64) { const int L = i / SM_STRIDE, o = i % SM_STRIDE; float v = 0.f;
            if (o < SM_LNB) v = a.in[5][L * 256 + o]; else if (o < SM_QG) v = a.in[6][L * 256 + o - SM_LNB]; else if (o < SM_KG) v = a.in[9][L * 64 + o - SM_QG];
            else if (o < SM_SINK) v = a.in[10][L * 64 + o - SM_KG]; else if (o < SM_SINK + 8) v = a.in[11][L * 8 + o - SM_SINK];
            else if (o >= SM_GBS && o < SM_GBS + 512) v = a.in[8][L * 512 + o - SM_GBS];
            sm[i] = v; }
    }
}

enum { ST_IN = 0, ST_MIX, ST_CARRY, ST_SSM2, ST_OUT, ST_FF1, ST_FF2, ST_PLE, NSTEP };
#ifndef PG8_SP2
#define PG8_SP2 true
#endif
#ifndef PG8_ALIGN
#define PG8_ALIGN true
#endif
__global__ void __launch_bounds__(NWAVES * 64, 2) mk_fwd(Args args) {
    extern __shared__ __attribute__((aligned(16))) unsigned char lds_raw[];
    LAS unsigned char* lds = (LAS unsigned char*)lds_raw;
    const int G = gridDim.x;
    const int wave0 = __builtin_amdgcn_readfirstlane(threadIdx.x >> 6);
    volatile LAS unsigned* MISC = (volatile LAS unsigned*)(lds + 131072);
    { const int l0 = fresh_lane(); if (wave0 == 0) MISC[l0] = 0u; }
    __syncthreads();
    XcdBarrier bar = xcd_barrier_post((unsigned*)(args.ws + WS_CTL) + 4096, MISC, wave0 == 0 && fresh_lane() == 0);
    for (int s = args.s_lo; s < args.s_hi; ++s) {
        if (s > args.s_lo) xcd_barrier(bar, wave0 == 0 && fresh_lane() == 0);
        unsigned long long z0 = 0ull; int bx = blockIdx.x; int wv = wave0;
        asm volatile("" : "+s"(z0), "+s"(bx), "+s"(wv));
        unsigned char* ws = args.ws + z0; float* outp = args.out + z0;
        const int vcu = (G % 8 == 0) ? (bx % 8) * (G / 8) + bx / 8 : bx;
#define FRESH_TID(name) int name = fresh_lane(); name += wv * 64
        if (s == 0) { FRESH_TID(t0); prologue_phase(args, ws, outp, lds, vcu * NWAVES + wv, G * NWAVES, wv, t0 & 63); asm volatile("s_waitcnt vmcnt(0) lgkmcnt(0)" ::: "memory"); __syncthreads(); continue; }
        const int L = (s - 1) / NSTEP, st = (s - 1) % NSTEP, par = L & 1;
        unsigned char* wl = ws + WS_W + (size_t)L * LW_STRIDE;
        if (st == ST_IN) {
            {
                FRESH_TID(t1); const int lane = t1 & 63;
                if (L == 0) ssm_ktable(args.in, ws, (vcu * NWAVES + wv) * 64 + lane, G * NWAVES * 64);
                const float* pl = args.in[1] + (size_t)L * NTOK * 256; bf16* pb = (bf16*)(ws + WS_PB);
                for (int m = vcu * NWAVES + wv; m < NTOK; m += G * NWAVES) { const f32x4 v = ((const f32x4*)(pl + (size_t)m * 256))[lane];
                    ((unsigned long long*)(pb + (size_t)m * 256))[lane] = (unsigned long long)pk2(v[0], v[1]) | ((unsigned long long)pk2(v[2], v[3]) << 32); }
                asm volatile("s_waitcnt vmcnt(0)" ::: "memory");
            }
            pg8::Gemm g{(const bf16*)(ws + WS_YCAT), (const bf16*)(wl + LW_IN), NTOK, NIN, DM}; pg8::StaticOrder S; S.init(NTOK, NIN, G, bx);
            pg8::EpiIn E{ws, par, L};
            { FRESH_TID(tl); pg8::gemm_phase<pg8::EpiIn, pg8::StaticOrder, PG8_ALIGN, PG8_SP2>(lds, g, S, E, tl); }
        } else if (st == ST_MIX) {
            FRESH_TID(tm); const int lane = tm & 63;
            for (int it = vcu; it < 256 + 128 + 256; it += G) { if (it < 256) attn_item(ws, L, lds, it, wv, lane); else if (it < 384) gmlp_item(ws, L, lds, it - 256, wv, lane); else ssm1_item(ws, L, it - 384, wv, lane); }
        } else if (st == ST_SSM2) {
            FRESH_TID(tm); const int lane = tm & 63;
            for (int it = vcu; it < 256; it += G) ssm2_item(ws, L, lds, it, wv, lane);
        } else if (st == ST_CARRY) {
            pg8::Gemm g{(const bf16*)(ws + WS_PB), (const bf16*)(wl + LW_PROJ), NTOK, DM, 256}; pg8::StaticOrder S; S.init(NTOK, DM, G, bx);
            pg8::EpiProj E{ws};
            { FRESH_TID(tl); pg8::gemm_phase<pg8::EpiProj, pg8::StaticOrder, PG8_ALIGN, PG8_SP2>(lds, g, S, E, tl); }
        } else if (st == ST_OUT || st == ST_FF2) {
            const bool o = (st == ST_OUT);
            pg8::Gemm g{(const bf16*)(ws + (o ? WS_YCAT : WS_HID)), (const bf16*)(wl + (o ? LW_OUT : LW_FF2)), NTOK, DM, o ? DM : DFF}; pg8::StaticOrder S; S.init(NTOK, DM, G, bx);
            pg8::EpiRes<false> E{outp, ws, o ? (par ^ 1) : par};
            { FRESH_TID(tl); pg8::gemm_phase<pg8::EpiRes<false>, pg8::StaticOrder, false, PG8_SP2>(lds, g, S, E, tl); }
        } else if (st == ST_FF1) {
            pg8::Gemm g{(const bf16*)(ws + WS_HB), (const bf16*)(wl + LW_FF1), NTOK, DFF, DM}; pg8::StaticOrder S; S.init(NTOK, DFF, G, bx);
            pg8::EpiFF1 E{ws, par ^ 1};
            { FRESH_TID(tl); pg8::gemm_phase<pg8::EpiFF1, pg8::StaticOrder, PG8_ALIGN, PG8_SP2>(lds, g, S, E, tl); }
        } else if (st == ST_PLE) {
            pg8::Gemm g{(const bf16*)(ws + WS_HB), (const bf16*)(wl + LW_GATE), NTOK, DM, DM}; pg8::StaticOrder S; S.init(NTOK, DM, G, bx);
            pg8::EpiRes<true> E{outp, ws, par ^ 1};
            { FRESH_TID(tl); pg8::gemm_phase<pg8::EpiRes<true>, pg8::StaticOrder, false, PG8_SP2>(lds, g, S, E, tl); }
        }
    }
}
extern "C" void kernel_launch(void* const* d_in, const int* in_sizes, int n_in, void* d_out, int out_size, void* d_ws, size_t ws_size, hipStream_t stream) {
    static int grid = 0;
    if (grid == 0) {
        if (n_in != 30 || out_size != NTOK * DM || ws_size < WS_END) { fprintf(stderr, "kernel_launch: unexpected shapes / workspace (n_in %d out %d ws %zu)\n", n_in, out_size, ws_size); grid = -1; return; }
        int dev = 0, cus = 0, per_cu = 0;
        (void)hipGetDevice(&dev); (void)hipDeviceGetAttribute(&cus, hipDeviceAttributeMultiprocessorCount, dev);
        (void)hipFuncSetAttribute((const void*)mk_fwd, hipFuncAttributeMaxDynamicSharedMemorySize, LDS_BYTES);
        (void)hipOccupancyMaxActiveBlocksPerMultiprocessor(&per_cu, (const void*)mk_fwd, NWAVES * 64, LDS_BYTES);
        (void)hipGetLastError();
        grid = (per_cu >= 1 && cus == 256) ? 256 : -1;
        if (grid < 0) { fprintf(stderr, "kernel_launch: needs 256 CUs with one resident workgroup each (cus %d per_cu %d)\n", cus, per_cu); return; }
    }
    if (grid < 0) return;
    (void)hipMemsetAsync((char*)d_ws + WS_CTL, 0, CTL_ZERO_BYTES, stream);
    Args a{};
    for (int i = 0; i < 30; ++i) a.in[i] = (const float*)d_in[i];
    a.out = (float*)d_out; a.ws = (unsigned char*)d_ws;
    unsigned char* ws = (unsigned char*)d_ws;
    const float* const* F = a.in;
#define LAUNCH_STEPS(lo, hi) do { a.s_lo = (lo); a.s_hi = (hi); hipLaunchKernelGGL(mk_fwd, dim3(grid), dim3(NWAVES * 64), LDS_BYTES, stream, a); } while (0)
#ifndef MK_SINGLE
#define MK_SINGLE 1
#endif
#if MK_SINGLE
    LAUNCH_STEPS(0, 1 + NLAYER * NSTEP);
#else
    for (int s = 0; s < 1 + NLAYER * NSTEP; ++s) LAUNCH_STEPS(s, s + 1);
#endif
}
```

```cpp
#include <hip/hip_runtime.h>
#include <cstdio>
#include <cstdint>
#include <math.h>

#define NTOK 16384
#define SEQL 8192
#define DM 1024
#define NIN 1536
#define DFF 4096
#define NLAYER 4
constexpr float QSCALE = 0.125f * 1.4426950408889634f;
constexpr float LOG2E = 1.4426950408889634f;

constexpr size_t MiB = 1u << 20;
constexpr size_t WS_CTL = 0, CTL_ZERO_BYTES = 1 * MiB;
constexpr size_t WS_W = 2 * MiB;
constexpr size_t LW_IN = 0, LW_OUT = 3 * MiB, LW_FF1 = 5 * MiB, LW_FF2 = 13 * MiB, LW_GATE = 21 * MiB, LW_PROJ = 23 * MiB, LW_GLU = 23 * MiB + 512 * 1024, LW_STRIDE = 24 * MiB;
constexpr size_t WS_TAB = 98 * MiB;
constexpr size_t TAB_COS = WS_TAB, TAB_SIN = WS_TAB + 2 * MiB, TAB_SSQ0 = WS_TAB + 4 * MiB, TAB_SSQ1 = TAB_SSQ0 + 256 * 1024, TAB_GW = TAB_SSQ1 + 256 * 1024, TAB_SMALL = TAB_GW + 512 * 1024, TAB_END = TAB_SMALL + 64 * 1024;
constexpr int SM_LNG = 0, SM_LNB = 256, SM_QG = 512, SM_KG = 576, SM_SINK = 640, SM_GBS = 1024  , SM_STRIDE = 2048;
constexpr size_t WS_HB = 104 * MiB;
constexpr size_t WS_U = 138 * MiB, WS_VLN = 146 * MiB, WS_Q = 154 * MiB, WS_K = 170 * MiB, WS_V = 174 * MiB, WS_ZC = 178 * MiB;
constexpr size_t WS_YCAT = 186 * MiB;
constexpr size_t WS_HID = 138 * MiB;
constexpr size_t WS_PPROJ = 266 * MiB;
constexpr size_t WS_YF = 218 * MiB;
constexpr size_t WS_YSSM = 282 * MiB;
constexpr size_t WS_PB = 298 * MiB;
constexpr size_t WS_SSM = 306 * MiB;
constexpr size_t SSM_PW = WS_SSM;
constexpr size_t SSM_KT = SSM_PW + 2304 * 1024;
constexpr size_t SSM_BBT = SSM_KT + 2 * MiB;
constexpr size_t SSM_CCT = SSM_BBT + 256 * 1024;
constexpr size_t SSM_BBC = SSM_CCT + 256 * 1024;
constexpr size_t SSM_S = SSM_BBC + 512 * 1024;
constexpr size_t SSM_W1 = SSM_S + 2 * MiB;
constexpr size_t WS_END = SSM_W1 + 2 * MiB;
static_assert(WS_END <= 316 * MiB, "ssm region");
static_assert(TAB_END <= WS_HB && WS_HB + 32 * MiB <= WS_U && WS_HID + 128 * MiB <= WS_PPROJ && WS_YF + 64 * MiB <= WS_YSSM && WS_YSSM + 16 * MiB <= WS_PB, "ws map");
static_assert(WS_W + NLAYER * LW_STRIDE <= WS_TAB, "weights");

typedef float f32x2_t __attribute__((ext_vector_type(2)));
typedef __bf16 bf16x2_t __attribute__((ext_vector_type(2)));
__device__ __forceinline__ unsigned pk2(float lo, float hi) { f32x2_t v = {lo, hi}; bf16x2_t b = __builtin_convertvector(v, bf16x2_t); return __builtin_bit_cast(unsigned, b); }
__device__ __forceinline__ float bf_lo(unsigned w) { return __uint_as_float(w << 16); }
__device__ __forceinline__ float bf_hi(unsigned w) { return __uint_as_float(w & 0xffff0000u); }
__device__ __forceinline__ float bf2f(unsigned short b) { return __uint_as_float(((unsigned)b) << 16); }
template <int X> __device__ __forceinline__ float xor_lane(float v) { return __int_as_float(__builtin_amdgcn_ds_swizzle(__float_as_int(v), (X << 10) | 0x1f)); }
__device__ __forceinline__ float add_xor16(float v) { return v + xor_lane<16>(v); }
__device__ __forceinline__ float add_xor32(float v) { auto r = __builtin_amdgcn_permlane32_swap(__float_as_uint(v), __float_as_uint(v), false, false); return __uint_as_float(r[0]) + __uint_as_float(r[1]); }
__device__ __forceinline__ float wave_sum(float v) {
    v += xor_lane<1>(v); v += xor_lane<2>(v); v += xor_lane<4>(v); v += xor_lane<8>(v); v = add_xor16(v); return add_xor32(v);
}
__device__ __forceinline__ float wave_sum_shfl(float v) {
#pragma unroll
    for (int o = 1; o < 64; o <<= 1) v += __shfl_xor(v, o);
    return v;
}
__device__ __forceinline__ int fresh_lane() { int l; asm volatile("v_mbcnt_lo_u32_b32 %0, -1, 0\n\tv_mbcnt_hi_u32_b32 %0, -1, %0" : "=v"(l)); return l; }
__device__ __forceinline__ float gelu_fast(float x) {
    const float u = x * (1.0f + 0.044715f * x * x);
    const float t = __builtin_amdgcn_exp2f(u * 2.3022082f);
    return x - x * __builtin_amdgcn_rcpf(1.0f + t);
}
__device__ __forceinline__ float sigmoid_fast(float x) { return __builtin_amdgcn_rcpf(1.0f + __builtin_amdgcn_exp2f(-x * LOG2E)); }
__device__ __forceinline__ float gelu_tanh(float x) { const float k0 = 0.7978845608028654f, k1 = 0.044715f; float u = k0 * (x + k1 * x * x * x); return 0.5f * x * (1.0f + tanhf(u)); }
__device__ const double ROPE_INV_REV[32] = {0.15915494309189535, 0.11934937021124886, 0.08949940160889101, 0.06711508300522726, 0.050329212104487035, 0.03774158471741977, 0.0283021958306234, 0.02122365276477766, 0.015915494309189534, 0.011934937021124886, 0.008949940160889102, 0.006711508300522725, 0.005032921210448704, 0.003774158471741977, 0.00283021958306234, 0.0021223652764777662, 0.0015915494309189536, 0.0011934937021124885, 0.0008949940160889102, 0.0006711508300522726, 0.0005032921210448703, 0.00037741584717419774, 0.00028302195830623395, 0.0002122365276477766, 0.00015915494309189535, 0.00011934937021124886, 8.949940160889102e-05, 6.711508300522725e-05, 5.0329212104487035e-05, 3.774158471741978e-05, 2.8302195830623396e-05, 2.122365276477766e-05};
namespace pg8 {
#define PG8_LAS __attribute__((address_space(3)))
typedef unsigned short bf16_t;
typedef short bf16x8 __attribute__((ext_vector_type(8)));
typedef float f32x4 __attribute__((ext_vector_type(4)));
typedef unsigned u32x4 __attribute__((ext_vector_type(4)));
constexpr int BM = 256, BK = 64, HALF = 128, HTB = HALF * BK * 2  , STAGE_BYTES = 8 * HTB, NXCD = 8, WGM = 8;

__host__ __device__ __forceinline__ int lds_byte(int r, int c) { const int st = (r >> 4) * 2 + (c >> 5), rr = r & 15, cc = c & 31, ob = rr * 64 + cc * 2; return st * 1024 + (ob ^ (((ob >> 9) & 1) << 5)); }
__host__ __device__ __forceinline__ void stage_rc(int b, int& R, int& C) { const int st = b / 1024, sb = b % 1024, swz = sb ^ (((sb >> 9) & 1) << 5); R = (st >> 1) * 16 + swz / 64; C = (st & 1) * 32 + (swz % 64) / 2; }
__host__ __device__ __forceinline__ int perm32(int rho) { const int n = rho >> 4, i = rho & 15; return 8 * (i >> 2) + 4 * n + (i & 3); }

struct Unit { int pm, pn; };
struct Gemm { const bf16_t* A; const bf16_t* Bt; int M, N, K; };

struct StaticOrder {
    int nM, nN, nwg, G, c;
    __host__ __device__ void init(int M, int N, int G_, int c_) { nM = M / BM; nN = N / BM; nwg = nM * nN; G = G_; c = c_; }
    __host__ __device__ bool next(int i, Unit& u) const {
        const long L = (long)i * G + c; if (L >= nwg) return false;
        int wgid = (int)L; { const int q = nwg / NXCD, r = nwg % NXCD, xcd = wgid % NXCD, off = wgid / NXCD; wgid = (xcd < r ? xcd * (q + 1) : r * (q + 1) + (xcd - r) * q) + off; }
        const int nig = WGM * nN, gid = wgid / nig, fm = gid * WGM, gsz = (nM - fm) < WGM ? (nM - fm) : WGM;
        u.pm = fm + ((wgid % nig) % gsz); u.pn = (wgid % nig) / gsz; return true;
    }
    __device__ __forceinline__ void a_ready(const Unit&) const {}
    __device__ __forceinline__ void done(const Unit&) const {}
};

template <class Epi, class Sched, bool ALIGN_EPI = false, bool SP2 = false>
__device__ __forceinline__ void gemm_phase(PG8_LAS unsigned char* lds, const Gemm g, const Sched& S, const Epi& E, const int tid) {
    const int wid = __builtin_amdgcn_readfirstlane(tid >> 6), lane = tid & 63, wr = wid >> 2, wc = wid & 3, fr = lane & 15, fq = lane >> 4;
    const int K = g.K, nt = K / BK;
    unsigned voffA[2], voffB[2];
#pragma unroll
    for (int i = 0; i < 2; ++i) { int R, C; stage_rc(tid * 16 + i * 8192, R, C); const int Rb = Epi::PERM ? ((R & ~31) + perm32(R & 31)) : R;
        voffA[i] = (unsigned)(R * K + C) * 2u; voffB[i] = (unsigned)(Rb * K + C) * 2u; }
    const size_t kstep = (size_t)(BK * 2);
    const size_t hstep = (size_t)HALF * K * 2;
    const size_t tstep = 2 * hstep;
    const unsigned ldsw = (unsigned)wid * 1024u;
    const int aoff = lds_byte(wr * 64 + fr, fq * 8), boff = lds_byte(wc * 32 + fr, fq * 8);
#define PG8_SA(b, h) (((b) * 2 + (h)) * HTB)
#define PG8_SB(b, h) ((4 + (b) * 2 + (h)) * HTB)
#define PG8_STAGE(bufoff, gbase, voff) do { _Pragma("unroll") for (int _i = 0; _i < 2; ++_i) \
        __builtin_amdgcn_global_load_lds((const unsigned*)((const char*)(gbase) + (voff)[_i]), (PG8_LAS unsigned*)(lds + (bufoff) + ldsw + _i * 8192), 16, 0, 0); } while (0)
#define PG8_LDA(dst, b, h) do { _Pragma("unroll") for (int m = 0; m < 4; ++m) _Pragma("unroll") for (int k = 0; k < 2; ++k) dst[m][k] = *(const PG8_LAS bf16x8*)(lds + PG8_SA(b, h) + aoff + m * 2048 + k * 1024); } while (0)
#define PG8_LDB(dst, b, h) do { _Pragma("unroll") for (int n = 0; n < 2; ++n) _Pragma("unroll") for (int k = 0; k < 2; ++k) dst[n][k] = *(const PG8_LAS bf16x8*)(lds + PG8_SB(b, h) + boff + n * 2048 + k * 1024); } while (0)
#define PG8_MMA(ai, bj, At, Bt) do { __builtin_amdgcn_s_setprio(1); _Pragma("unroll") for (int m = 0; m < 4; ++m) _Pragma("unroll") for (int n = 0; n < 2; ++n) _Pragma("unroll") for (int k = 0; k < 2; ++k) \
        acc[ai][bj][m][n] = __builtin_amdgcn_mfma_f32_16x16x32_bf16(Bt[n][k], At[m][k], acc[ai][bj][m][n], 0, 0, 0); __builtin_amdgcn_s_setprio(0); } while (0)
#define PG8_WAIT_V(n) asm volatile("s_waitcnt vmcnt(" #n ")" ::: "memory")
#define PG8_WAIT_L(n) asm volatile("s_waitcnt lgkmcnt(" #n ")" ::: "memory")
#define PG8_BAR __builtin_amdgcn_s_barrier()
#define PG8_SCHED __builtin_amdgcn_sched_barrier(0)
    Unit cur, nxt; int ui = 0;
    if (!S.next(0, cur)) return;
    f32x4 acc[2][2][4][2];
#pragma unroll
    for (int a = 0; a < 2; ++a)
#pragma unroll
        for (int b = 0; b < 2; ++b)
#pragma unroll
            for (int m = 0; m < 4; ++m)
#pragma unroll
                for (int n = 0; n < 2; ++n) acc[a][b][m][n] = (f32x4){0.f, 0.f, 0.f, 0.f};
    bf16x8 At[4][2], B0[2][2], B1[2][2];
    const char* cA = (const char*)g.A + (size_t)cur.pm * tstep; const char* cB = (const char*)g.Bt + (size_t)cur.pn * tstep;
    S.a_ready(cur);
    if constexpr (SP2) {
        PG8_STAGE(PG8_SB(0, 0), cB, voffB); PG8_STAGE(PG8_SB(0, 1), cB + hstep, voffB); PG8_STAGE(PG8_SA(0, 0), cA, voffA); PG8_STAGE(PG8_SA(0, 1), cA + hstep, voffA);
        if (wr == 1) PG8_BAR;
        PG8_WAIT_V(2); PG8_BAR;
        PG8_STAGE(PG8_SB(1, 0), cB + kstep, voffB); PG8_STAGE(PG8_SA(1, 0), cA + kstep, voffA); PG8_STAGE(PG8_SB(1, 1), cB + hstep + kstep, voffB);
        PG8_WAIT_V(6); PG8_BAR;
    } else {
        PG8_STAGE(PG8_SB(0, 0), cB, voffB); PG8_STAGE(PG8_SA(0, 0), cA, voffA); PG8_STAGE(PG8_SB(0, 1), cB + hstep, voffB); PG8_STAGE(PG8_SA(0, 1), cA + hstep, voffA);
        if (wr == 1) PG8_BAR;
        PG8_WAIT_V(4); PG8_BAR;
        PG8_STAGE(PG8_SB(1, 0), cB + kstep, voffB); PG8_STAGE(PG8_SA(1, 0), cA + kstep, voffA); PG8_STAGE(PG8_SB(1, 1), cB + hstep + kstep, voffB);
        PG8_WAIT_V(6); PG8_BAR;
    }
    for (;;) {
        const bool has_next = S.next(ui + 1, nxt);
        const char* nA = has_next ? (const char*)g.A + (size_t)nxt.pm * tstep : cA; const char* nB = has_next ? (const char*)g.Bt + (size_t)nxt.pn * tstep : cB;
        for (int t = 0; t < nt; t += 2) {
            const bool last = (t == nt - 2);
            const char* a1 = cA + (size_t)(t + 1) * kstep;
            const char* a2 = last ? nA : cA + (size_t)(t + 2) * kstep; const char* b2 = last ? nB : cB + (size_t)(t + 2) * kstep;
            const char* a3 = a2 + kstep; const char* b3 = b2 + kstep;
            if (last && has_next) S.a_ready(nxt);
            if constexpr (SP2) {
            PG8_LDB(B0, 0, 0); PG8_LDB(B1, 0, 1); PG8_SCHED; PG8_LDA(At, 0, 0); PG8_STAGE(PG8_SA(1, 1), a1 + hstep, voffA);
            PG8_WAIT_V(8); PG8_WAIT_L(0); PG8_BAR; PG8_MMA(0, 0, At, B0); PG8_MMA(0, 1, At, B1); PG8_BAR; PG8_SCHED;
            PG8_LDA(At, 0, 1); PG8_STAGE(PG8_SB(0, 0), b2, voffB); PG8_STAGE(PG8_SB(0, 1), b2 + hstep, voffB); PG8_STAGE(PG8_SA(0, 0), a2, voffA);
            PG8_WAIT_V(8); PG8_WAIT_L(0); PG8_BAR; PG8_MMA(1, 0, At, B0); PG8_MMA(1, 1, At, B1); PG8_BAR; PG8_SCHED;
            PG8_LDB(B0, 1, 0); PG8_LDB(B1, 1, 1); PG8_SCHED; PG8_LDA(At, 1, 0); PG8_STAGE(PG8_SA(0, 1), a2 + hstep, voffA);
            PG8_WAIT_V(8); PG8_WAIT_L(0); PG8_BAR; PG8_MMA(0, 0, At, B0); PG8_MMA(0, 1, At, B1); PG8_BAR; PG8_SCHED;
            PG8_LDA(At, 1, 1); PG8_STAGE(PG8_SB(1, 0), b3, voffB); PG8_STAGE(PG8_SB(1, 1), b3 + hstep, voffB); PG8_STAGE(PG8_SA(1, 0), a3, voffA);
            PG8_WAIT_V(8); PG8_WAIT_L(0); PG8_BAR; PG8_MMA(1, 0, At, B0); PG8_MMA(1, 1, At, B1); PG8_BAR; PG8_SCHED;
            } else {
            PG8_LDB(B0, 0, 0); PG8_SCHED; PG8_LDA(At, 0, 0); PG8_STAGE(PG8_SA(1, 1), a1 + hstep, voffA);
            PG8_WAIT_L(8); PG8_BAR; PG8_WAIT_L(0); PG8_MMA(0, 0, At, B0); PG8_BAR; PG8_SCHED;
            PG8_LDB(B1, 0, 1); PG8_STAGE(PG8_SB(0, 0), b2, voffB);
            PG8_BAR; PG8_WAIT_L(0); PG8_MMA(0, 1, At, B1); PG8_BAR;
            PG8_LDA(At, 0, 1); PG8_STAGE(PG8_SA(0, 0), a2, voffA);
            PG8_BAR; PG8_WAIT_L(0); PG8_MMA(1, 0, At, B0); PG8_BAR; PG8_SCHED;
            PG8_STAGE(PG8_SB(0, 1), b2 + hstep, voffB);
            PG8_WAIT_V(6); PG8_BAR; PG8_MMA(1, 1, At, B1); PG8_BAR;
            PG8_LDB(B0, 1, 0); PG8_SCHED; PG8_LDA(At, 1, 0); PG8_STAGE(PG8_SA(0, 1), a2 + hstep, voffA);
            PG8_WAIT_L(8); PG8_BAR; PG8_WAIT_L(0); PG8_MMA(0, 0, At, B0); PG8_BAR; PG8_SCHED;
            PG8_LDB(B1, 1, 1); PG8_STAGE(PG8_SB(1, 0), b3, voffB);
            PG8_BAR; PG8_WAIT_L(0); PG8_MMA(0, 1, At, B1); PG8_BAR;
            PG8_LDA(At, 1, 1); PG8_STAGE(PG8_SA(1, 0), a3, voffA);
            PG8_BAR; PG8_WAIT_L(0); PG8_MMA(1, 0, At, B0); PG8_BAR; PG8_SCHED;
            PG8_STAGE(PG8_SB(1, 1), b3 + hstep, voffB);
            PG8_WAIT_V(6); PG8_BAR; PG8_MMA(1, 1, At, B1); PG8_BAR;
            }
        }
        if constexpr (ALIGN_EPI) { if (wr == 0) PG8_BAR; }
        if constexpr (!Epi::AFTER_DRAIN) { const int l2 = fresh_lane();
            E(acc, cur, wr, wc, l2 & 15, l2 >> 4); S.done(cur); }
        if (!has_next) break;
#pragma unroll
        for (int a = 0; a < 2; ++a)
#pragma unroll
            for (int b = 0; b < 2; ++b)
#pragma unroll
                for (int m = 0; m < 4; ++m)
#pragma unroll
                    for (int n = 0; n < 2; ++n) acc[a][b][m][n] = (f32x4){0.f, 0.f, 0.f, 0.f};
        cur = nxt; cA = nA; cB = nB; ++ui;
        if constexpr (ALIGN_EPI) { if (wr == 1) PG8_BAR; }
    }
    PG8_WAIT_V(0);
    if constexpr (!ALIGN_EPI) { if (wr == 0) PG8_BAR; }
    PG8_BAR;
    if constexpr (Epi::AFTER_DRAIN) { const int l2 = fresh_lane();
        E.fused(acc, cur, wr, wc, l2 & 15, l2 >> 4, lds, wid, l2); S.done(cur); }
#undef PG8_SA
#undef PG8_SB
#undef PG8_STAGE
#undef PG8_LDA
#undef PG8_LDB
#undef PG8_MMA
#undef PG8_WAIT_V
#undef PG8_WAIT_L
#undef PG8_BAR
#undef PG8_SCHED
}
}
namespace pg8 {
__device__ __forceinline__ float rstd_row(const float* ssq, int row) {
    const float s = (ssq[row] + ssq[NTOK + row]) + (ssq[2 * NTOK + row] + ssq[3 * NTOK + row]);
    return __builtin_amdgcn_rsqf(s * (1.0f / 1024.0f) + 1e-6f);
}
__device__ __forceinline__ void store8(bf16_t* p, const float (&v)[8]) {
    u32x4 w; w.x = pk2(v[0], v[1]); w.y = pk2(v[2], v[3]); w.z = pk2(v[4], v[5]); w.w = pk2(v[6], v[7]); *(u32x4*)p = w;
}
struct EpiIn {
    static constexpr bool PERM = false, AFTER_DRAIN = false;
    unsigned char* ws; int par, L;
    __device__ __forceinline__ void operator()(const f32x4 (&acc)[2][2][4][2], const Unit& u, int wr, int wc, int fr, int fq) const {
        const int pn = u.pn;
        const float* ssq = (const float*)(ws + (par ? TAB_SSQ1 : TAB_SSQ0)); const float* cosT = (const float*)(ws + TAB_COS); const float* sinT = (const float*)(ws + TAB_SIN);
        const float* sm = (const float*)(ws + TAB_SMALL) + L * SM_STRIDE; const float* lng = sm + SM_LNG; const float* lnb = sm + SM_LNB; const float* qg = sm + SM_QG; const float* kg = sm + SM_KG;
        bf16_t* U = (bf16_t*)(ws + WS_U); bf16_t* VLN = (bf16_t*)(ws + WS_VLN); bf16_t* Q = (bf16_t*)(ws + WS_Q); bf16_t* K = (bf16_t*)(ws + WS_K); bf16_t* V = (bf16_t*)(ws + WS_V); bf16_t* ZC = (bf16_t*)(ws + WS_ZC);
        int mode, ld, cb; bf16_t* dst; const float* gp = nullptr; const float* bp = nullptr;
        if (pn < 2) { const int head = 2 * pn + (wc >> 1); ld = 256; cb = head * 64; if (wc & 1) { mode = 1; dst = VLN; gp = lng + head * 64; bp = lnb + head * 64; } else { mode = 0; dst = U; } }
        else if (pn < 4) { mode = 2; dst = Q; ld = 512; cb = (4 * (pn - 2) + wc) * 64; gp = qg; }
        else if (pn == 4) { ld = 128; if (wc < 2) { mode = 3; dst = K; cb = wc * 64; gp = kg; } else { mode = 4; dst = V; cb = (wc - 2) * 64; } }
        else { mode = 4; dst = ZC; ld = 256; cb = wc * 64; }
        float g[16], bb[16];
#pragma unroll
        for (int i = 0; i < 16; ++i) { g[i] = 1.f; bb[i] = 0.f; }
        if (gp) {
#pragma unroll
            for (int bj = 0; bj < 2; ++bj)
#pragma unroll
                for (int n = 0; n < 2; ++n) { const f32x4 t = *(const f32x4*)(gp + 32 * bj + 8 * fq + 4 * n); g[bj * 8 + n * 4 + 0] = t[0]; g[bj * 8 + n * 4 + 1] = t[1]; g[bj * 8 + n * 4 + 2] = t[2]; g[bj * 8 + n * 4 + 3] = t[3]; }
        }
        if (bp) {
#pragma unroll
            for (int bj = 0; bj < 2; ++bj)
#pragma unroll
                for (int n = 0; n < 2; ++n) { const f32x4 t = *(const f32x4*)(bp + 32 * bj + 8 * fq + 4 * n); bb[bj * 8 + n * 4 + 0] = t[0]; bb[bj * 8 + n * 4 + 1] = t[1]; bb[bj * 8 + n * 4 + 2] = t[2]; bb[bj * 8 + n * 4 + 3] = t[3]; }
        }
#pragma unroll
        for (int ai = 0; ai < 2; ++ai)
#pragma unroll
            for (int m = 0; m < 4; ++m) {
                const int row = u.pm * BM + ai * HALF + wr * 64 + m * 16 + fr;
                const float rs = rstd_row(ssq, row);
                float v[16];
#pragma unroll
                for (int bj = 0; bj < 2; ++bj)
#pragma unroll
                    for (int n = 0; n < 2; ++n)
#pragma unroll
                        for (int j = 0; j < 4; ++j) v[bj * 8 + n * 4 + j] = acc[ai][bj][m][n][j] * rs;
                if (mode <= 1) {
#pragma unroll
                    for (int i = 0; i < 16; ++i) v[i] = gelu_fast(v[i]);
                    if (mode == 1) {
                        float s = 0.f;
#pragma unroll
                        for (int i = 0; i < 16; ++i) s += v[i];
                        s = add_xor16(s); s = add_xor32(s);
                        const float mu = s * (1.0f / 64.0f); float q = 0.f;
#pragma unroll
                        for (int i = 0; i < 16; ++i) { v[i] -= mu; q += v[i] * v[i]; }
                        q = add_xor16(q); q = add_xor32(q);
                        const float r = __builtin_amdgcn_rsqf(q * (1.0f / 64.0f) + 1e-6f);
#pragma unroll
                        for (int i = 0; i < 16; ++i) v[i] = v[i] * r * g[i] + bb[i];
                    }
                } else if (mode <= 3) {
                    float q = 0.f;
#pragma unroll
                    for (int i = 0; i < 16; ++i) q += v[i] * v[i];
                    q = add_xor16(q); q = add_xor32(q);
                    const float r = __builtin_amdgcn_rsqf(q * (1.0f / 64.0f) + 1e-6f) * (mode == 2 ? QSCALE : 1.0f);
#pragma unroll
                    for (int i = 0; i < 16; ++i) v[i] = v[i] * r * g[i];
                    const float* cp = cosT + (size_t)row * 32 + 8 * fq; const float* sp = sinT + (size_t)row * 32 + 8 * fq;
#pragma unroll
                    for (int n = 0; n < 2; ++n) { const f32x4 c4 = *(const f32x4*)(cp + 4 * n), s4 = *(const f32x4*)(sp + 4 * n);
#pragma unroll
                        for (int j = 0; j < 4; ++j) { const float x1 = v[n * 4 + j], x2 = v[8 + n * 4 + j]; v[n * 4 + j] = x1 * c4[j] - x2 * s4[j]; v[8 + n * 4 + j] = x2 * c4[j] + x1 * s4[j]; } }
                }
                bf16_t* rp = dst + (size_t)row * ld + cb + 8 * fq;
                { float t[8];
#pragma unroll
                  for (int i = 0; i < 8; ++i) t[i] = v[i];
                  store8(rp, t);
#pragma unroll
                  for (int i = 0; i < 8; ++i) t[i] = v[8 + i];
                  store8(rp + 32, t); }
            }
    }
};
struct EpiFF1 {
    static constexpr bool PERM = false, AFTER_DRAIN = false;
    unsigned char* ws; int par;
    __device__ __forceinline__ void operator()(const f32x4 (&acc)[2][2][4][2], const Unit& u, int wr, int wc, int fr, int fq) const {
        const float* ssq = (const float*)(ws + (par ? TAB_SSQ1 : TAB_SSQ0)); bf16_t* HID = (bf16_t*)(ws + WS_HID);
#pragma unroll
        for (int ai = 0; ai < 2; ++ai)
#pragma unroll
            for (int m = 0; m < 4; ++m) {
                const int row = u.pm * BM + ai * HALF + wr * 64 + m * 16 + fr;
                const float rs = rstd_row(ssq, row);
                bf16_t* rp = HID + (size_t)row * DFF + u.pn * BM + wc * 64 + 8 * fq;
#pragma unroll
                for (int bj = 0; bj < 2; ++bj) { float t[8];
#pragma unroll
                    for (int n = 0; n < 2; ++n)
#pragma unroll
                        for (int j = 0; j < 4; ++j) { float x = acc[ai][bj][m][n][j] * rs; x = x > 0.f ? x : 0.f; t[n * 4 + j] = x * x; }
                    store8(rp + 32 * bj, t); }
            }
    }
};
struct EpiProj {
    static constexpr bool PERM = false, AFTER_DRAIN = false;
    unsigned char* ws;
    __device__ __forceinline__ void operator()(const f32x4 (&acc)[2][2][4][2], const Unit& u, int wr, int wc, int fr, int fq) const {
        bf16_t* O = (bf16_t*)(ws + WS_PPROJ);
#pragma unroll
        for (int ai = 0; ai < 2; ++ai)
#pragma unroll
            for (int m = 0; m < 4; ++m) {
                const int row = u.pm * BM + ai * HALF + wr * 64 + m * 16 + fr;
                bf16_t* rp = O + (size_t)row * DM + u.pn * BM + wc * 64 + 8 * fq;
#pragma unroll
                for (int bj = 0; bj < 2; ++bj) { float t[8];
#pragma unroll
                    for (int n = 0; n < 2; ++n)
#pragma unroll
                        for (int j = 0; j < 4; ++j) t[n * 4 + j] = acc[ai][bj][m][n][j];
                    store8(rp + 32 * bj, t); }
            }
    }
};
template <bool GATED> struct EpiRes {
    static constexpr bool PERM = false, AFTER_DRAIN = true;
    float* h; unsigned char* ws; int par_out;
    __device__ __forceinline__ void fused(f32x4 (&acc)[2][2][4][2], const Unit& u, int wr, int wc, int fr, int fq, PG8_LAS unsigned char* lds, int wid, int lane) const {
        bf16_t* HBo = (bf16_t*)(ws + (GATED ? WS_YCAT : WS_HB)); float* ssq_out = (float*)(ws + (par_out ? TAB_SSQ1 : TAB_SSQ0));
        const float* ssq_in = (const float*)(ws + (par_out ? TAB_SSQ0 : TAB_SSQ1)); const bf16_t* PP = (const bf16_t*)(ws + WS_PPROJ);
        PG8_LAS float* P = (PG8_LAS float*)lds;
        const int cb = u.pn * BM + wc * 64 + 8 * fq;
#pragma unroll
        for (int ai = 0; ai < 2; ++ai)
#pragma unroll
            for (int m = 0; m < 4; ++m) {
                const int rl = ai * HALF + wr * 64 + m * 16 + fr, row = u.pm * BM + rl;
                float* hp = h + (size_t)row * DM + cb;
                float rs = 1.f; if (GATED) rs = rstd_row(ssq_in, row);
                float ss = 0.f;
#pragma unroll
                for (int bj = 0; bj < 2; ++bj) {
                    f32x4 o0 = *(const f32x4*)(hp + 32 * bj), o1 = *(const f32x4*)(hp + 32 * bj + 4);
                    f32x4 a0 = acc[ai][bj][m][0], a1 = acc[ai][bj][m][1];
                    if (GATED) {
                        const u32x4 pw = *(const u32x4*)(PP + (size_t)row * DM + cb + 32 * bj);
                        a0[0] = sigmoid_fast(a0[0] * rs) * bf_lo(pw.x); a0[1] = sigmoid_fast(a0[1] * rs) * bf_hi(pw.x);
                        a0[2] = sigmoid_fast(a0[2] * rs) * bf_lo(pw.y); a0[3] = sigmoid_fast(a0[3] * rs) * bf_hi(pw.y);
                        a1[0] = sigmoid_fast(a1[0] * rs) * bf_lo(pw.z); a1[1] = sigmoid_fast(a1[1] * rs) * bf_hi(pw.z);
                        a1[2] = sigmoid_fast(a1[2] * rs) * bf_lo(pw.w); a1[3] = sigmoid_fast(a1[3] * rs) * bf_hi(pw.w);
                    }
                    o0 += a0; o1 += a1;
                    *(f32x4*)(hp + 32 * bj) = o0; *(f32x4*)(hp + 32 * bj + 4) = o1;
                    ss += (o0[0] * o0[0] + o0[1] * o0[1]) + (o0[2] * o0[2] + o0[3] * o0[3]) + (o1[0] * o1[0] + o1[1] * o1[1]) + (o1[2] * o1[2] + o1[3] * o1[3]);
                    float t[8] = {o0[0], o0[1], o0[2], o0[3], o1[0], o1[1], o1[2], o1[3]};
                    store8(HBo + (size_t)row * DM + cb + 32 * bj, t);
                }
                ss = add_xor16(ss); ss = add_xor32(ss);
                if (fq == 0) P[rl * 4 + wc] = ss;
                asm volatile("" ::: "memory");
            }
        asm volatile("s_waitcnt lgkmcnt(0)" ::: "memory"); __builtin_amdgcn_s_barrier(); asm volatile("" ::: "memory");
        const int tid = wid * 64 + lane;
        if (tid < 256) ssq_out[u.pn * NTOK + u.pm * BM + tid] = (P[tid * 4] + P[tid * 4 + 1]) + (P[tid * 4 + 2] + P[tid * 4 + 3]);
        asm volatile("s_waitcnt lgkmcnt(0)" ::: "memory"); __builtin_amdgcn_s_barrier(); asm volatile("" ::: "memory");
    }
};
}
typedef unsigned short bf16;
#define LAS __attribute__((address_space(3)))
typedef unsigned v4u __attribute__((ext_vector_type(4)));
typedef unsigned v2u __attribute__((ext_vector_type(2)));
typedef float f32x4 __attribute__((ext_vector_type(4)));
typedef short bf16x8 __attribute__((ext_vector_type(8)));
typedef short s16x4 __attribute__((ext_vector_type(4)));
constexpr int NWAVES = 8;
__device__ __forceinline__ float max_xor16(float v) { return fmaxf(v, xor_lane<16>(v)); }
__device__ __forceinline__ float max_xor32(float v) { auto r = __builtin_amdgcn_permlane32_swap(__float_as_uint(v), __float_as_uint(v), false, false); return fmaxf(__uint_as_float(r[0]), __uint_as_float(r[1])); }
__device__ __forceinline__ bf16x8 tr_frag(LAS const unsigned char* p, LAS const unsigned char* p2) {
    const s16x4 lo = __builtin_bit_cast(s16x4, __builtin_amdgcn_ds_read_tr16_b64_v4i16((LAS s16x4*)p));
    const s16x4 hi = __builtin_bit_cast(s16x4, __builtin_amdgcn_ds_read_tr16_b64_v4i16((LAS s16x4*)p2));
    return (bf16x8){lo[0], lo[1], lo[2], lo[3], hi[0], hi[1], hi[2], hi[3]};
}
#define WG_BARRIER() do { asm volatile("s_waitcnt vmcnt(0) lgkmcnt(0)" ::: "memory"); __builtin_amdgcn_s_barrier(); asm volatile("" ::: "memory"); } while (0)

constexpr int GM_ROWB = 528;
constexpr int GM_SS = 128 * GM_ROWB;
__device__ __forceinline__ void gmlp_item(unsigned char* ws, int L, LAS unsigned char* lds, int item, int wv, int lane_unused) {
    const int lane = fresh_lane();
    const int tok0 = item * 128, tid = wv * 64 + lane;
    const bf16* VLN = (const bf16*)(ws + WS_VLN); const bf16* U = (const bf16*)(ws + WS_U); bf16* YC = (bf16*)(ws + WS_YCAT);
    const bf16* GW = (const bf16*)(ws + TAB_GW) + (size_t)L * 4 * 128 * 128;
    const float* bsv = (const float*)(ws + TAB_SMALL) + L * SM_STRIDE + SM_GBS;
    for (int q = tid; q < 128 * 32; q += NWAVES * 64) { const int s = q >> 5, c = q & 31;
        const v4u x = *(const v4u*)(VLN + (size_t)(tok0 + s) * 256 + c * 8); *(LAS v4u*)(lds + s * GM_ROWB + c * 16) = x; }
    const int h = wv >> 1, th = wv & 1, fr = lane & 15, g4 = lane >> 4;
    bf16x8 wfa[4][4];
#pragma unroll
    for (int m = 0; m < 4; ++m)
#pragma unroll
        for (int ks = 0; ks < 4; ++ks) if (32 * ks <= 64 * th + 16 * m + 15) wfa[m][ks] = *(const bf16x8*)(GW + ((size_t)h * 128 + 64 * th + 16 * m + fr) * 128 + 32 * ks + 8 * g4);
    WG_BARRIER();
    f32x4 acc[4][4];
#pragma unroll
    for (int m = 0; m < 4; ++m)
#pragma unroll
        for (int n = 0; n < 4; ++n) acc[m][n] = (f32x4){0.f, 0.f, 0.f, 0.f};
    v2u uwa[4][4];
#pragma unroll
    for (int m = 0; m < 4; ++m)
#pragma unroll
        for (int n = 0; n < 4; ++n) uwa[m][n] = *(const v2u*)(U + (size_t)(tok0 + 64 * th + 16 * m + fr) * 256 + h * 64 + 16 * n + 4 * g4);
#pragma unroll
    for (int m = 0; m < 4; ++m) {
#pragma unroll
        for (int ks = 0; ks < 4; ++ks) {
            if (32 * ks <= 64 * th + 16 * m + 15) {
#pragma unroll
                for (int n = 0; n < 4; ++n) {
                    LAS const unsigned char* p = lds + (32 * ks + 8 * g4 + (fr >> 2)) * GM_ROWB + (h * 64 + 16 * n + 4 * (fr & 3)) * 2;
                    const bf16x8 vf = tr_frag(p, p + 4 * GM_ROWB);
                    acc[m][n] = __builtin_amdgcn_mfma_f32_16x16x32_bf16(vf, wfa[m][ks], acc[m][n], 0, 0, 0);
                }
            }
        }
    }
    LAS float* SS = (LAS float*)(lds + GM_SS);
#pragma unroll
    for (int m = 0; m < 4; ++m) {
        const int t = 64 * th + 16 * m + fr; const float bb = bsv[h * 128 + t]; float ss = 0.f;
#pragma unroll
        for (int n = 0; n < 4; ++n) {
            const v2u uw = uwa[m][n];
            f32x4 y; y[0] = bf_lo(uw.x) * (acc[m][n][0] + bb); y[1] = bf_hi(uw.x) * (acc[m][n][1] + bb); y[2] = bf_lo(uw.y) * (acc[m][n][2] + bb); y[3] = bf_hi(uw.y) * (acc[m][n][3] + bb);
            acc[m][n] = y; ss += (y[0] * y[0] + y[1] * y[1]) + (y[2] * y[2] + y[3] * y[3]);
        }
        ss = add_xor16(ss); ss = add_xor32(ss);
        if (g4 == 0) SS[h * 128 + t] = ss;
    }
    WG_BARRIER();
#pragma unroll
    for (int m = 0; m < 4; ++m) {
        const int t = 64 * th + 16 * m + fr;
        const float tot = (SS[t] + SS[128 + t]) + (SS[256 + t] + SS[384 + t]);
        const float r = __builtin_amdgcn_rsqf(tot * (1.0f / 256.0f) + 1e-6f);
#pragma unroll
        for (int n = 0; n < 4; ++n) { v2u o; o.x = pk2(acc[m][n][0] * r, acc[m][n][1] * r); o.y = pk2(acc[m][n][2] * r, acc[m][n][3] * r);
            *(v2u*)(YC + (size_t)(tok0 + t) * DM + h * 64 + 16 * n + 4 * g4) = o; }
    }
    WG_BARRIER();
}

constexpr int AT_ROWB = 272;
constexpr int AT_V = 192 * AT_ROWB, AT_SS = 2 * 192 * AT_ROWB;
__device__ __forceinline__ void attn_item(unsigned char* ws, int L, LAS unsigned char* lds, int item, int wv, int lane_unused) {
    const int lane = fresh_lane();
    const int b = item >> 7, q0 = (item & 127) * 64, tokb = b * SEQL, tid = wv * 64 + lane;
    const bf16* Q = (const bf16*)(ws + WS_Q); const bf16* K = (const bf16*)(ws + WS_K); const bf16* V = (const bf16*)(ws + WS_V); bf16* YC = (bf16*)(ws + WS_YCAT);
    for (int q = tid; q < 192 * 16; q += NWAVES * 64) { const int r = q >> 4, c = q & 15, j = q0 - 128 + r;
        v4u kx = (v4u){0u, 0u, 0u, 0u}, vx = kx;
        if (j >= 0) { kx = *(const v4u*)(K + (size_t)(tokb + j) * 128 + c * 8); vx = *(const v4u*)(V + (size_t)(tokb + j) * 128 + c * 8); }
        *(LAS v4u*)(lds + r * AT_ROWB + c * 16) = kx; *(LAS v4u*)(lds + AT_V + r * AT_ROWB + c * 16) = vx; }
    const int hq = wv, hkv = wv >> 2, fr = lane & 15, g4 = lane >> 4;
    bf16x8 qfa[4][2];
#pragma unroll
    for (int qt = 0; qt < 4; ++qt)
#pragma unroll
        for (int ks = 0; ks < 2; ++ks) qfa[qt][ks] = *(const bf16x8*)(Q + (size_t)(tokb + q0 + 16 * qt + fr) * 512 + hq * 64 + 32 * ks + 8 * g4);
    WG_BARRIER();
    const float sink2 = ((const float*)(ws + TAB_SMALL))[L * SM_STRIDE + SM_SINK + hq] * LOG2E;
    LAS float* SS = (LAS float*)(lds + AT_SS);
#pragma unroll
    for (int qt = 0; qt < 4; ++qt) {
        const size_t tq = (size_t)(tokb + q0 + 16 * qt + fr);
        const bf16x8 qf[2] = {qfa[qt][0], qfa[qt][1]};
        f32x4 s[12];
#pragma unroll
        for (int kt = 0; kt < 12; ++kt) { s[kt] = (f32x4){0.f, 0.f, 0.f, 0.f};
#pragma unroll
            for (int ks = 0; ks < 2; ++ks) { const bf16x8 kf = *(LAS const bf16x8*)(lds + (16 * kt + fr) * AT_ROWB + (hkv * 64 + 32 * ks + 8 * g4) * 2);
                s[kt] = __builtin_amdgcn_mfma_f32_16x16x32_bf16(kf, qf[ks], s[kt], 0, 0, 0); } }
        const int diff0 = 128 + 16 * qt + fr - 4 * g4, j0 = q0 - 128 + 4 * g4;
        float mx = -INFINITY;
#pragma unroll
        for (int kt = 0; kt < 12; ++kt)
#pragma unroll
            for (int r = 0; r < 4; ++r) { const int diff = diff0 - 16 * kt - r; const bool ok = (diff >= 0) && (diff < 128) && (j0 + 16 * kt + r >= 0);
                s[kt][r] = ok ? s[kt][r] : -INFINITY; mx = fmaxf(mx, s[kt][r]); }
        mx = max_xor16(mx); mx = max_xor32(mx); mx = fmaxf(mx, sink2);
        float sum = 0.f;
#pragma unroll
        for (int kt = 0; kt < 12; ++kt)
#pragma unroll
            for (int r = 0; r < 4; ++r) { s[kt][r] = __builtin_amdgcn_exp2f(s[kt][r] - mx); sum += s[kt][r]; }
        sum = add_xor16(sum); sum = add_xor32(sum); sum += __builtin_amdgcn_exp2f(sink2 - mx);
        const float inv_l = __builtin_amdgcn_rcpf(sum);
        f32x4 o[4];
#pragma unroll
        for (int dt = 0; dt < 4; ++dt) o[dt] = (f32x4){0.f, 0.f, 0.f, 0.f};
#pragma unroll
        for (int kk = 0; kk < 6; ++kk) {
            v4u pw; pw.x = pk2(s[2 * kk][0], s[2 * kk][1]); pw.y = pk2(s[2 * kk][2], s[2 * kk][3]); pw.z = pk2(s[2 * kk + 1][0], s[2 * kk + 1][1]); pw.w = pk2(s[2 * kk + 1][2], s[2 * kk + 1][3]);
            const bf16x8 pf = __builtin_bit_cast(bf16x8, pw);
#pragma unroll
            for (int dt = 0; dt < 4; ++dt) {
                LAS const unsigned char* p = lds + AT_V + (32 * kk + 4 * g4 + (fr >> 2)) * AT_ROWB + (hkv * 64 + 16 * dt + 4 * (fr & 3)) * 2;
                const bf16x8 vf = tr_frag(p, p + 16 * AT_ROWB);
                o[dt] = __builtin_amdgcn_mfma_f32_16x16x32_bf16(vf, pf, o[dt], 0, 0, 0);
            }
        }
        float ss = 0.f;
#pragma unroll
        for (int dt = 0; dt < 4; ++dt) { o[dt] = o[dt] * inv_l; ss += (o[dt][0] * o[dt][0] + o[dt][1] * o[dt][1]) + (o[dt][2] * o[dt][2] + o[dt][3] * o[dt][3]); }
        ss = add_xor16(ss); ss = add_xor32(ss);
        if (g4 == 0) SS[hq * 64 + 16 * qt + fr] = ss;
        WG_BARRIER();
        float tot = 0.f;
#pragma unroll
        for (int hh = 0; hh < 8; ++hh) tot += SS[hh * 64 + 16 * qt + fr];
        const float r = __builtin_amdgcn_rsqf(tot * (1.0f / 512.0f) + 1e-6f);
#pragma unroll
        for (int dt = 0; dt < 4; ++dt) { v2u ow; ow.x = pk2(o[dt][0] * r, o[dt][1] * r); ow.y = pk2(o[dt][2] * r, o[dt][3] * r);
            *(v2u*)(YC + tq * DM + 256 + hq * 64 + 16 * dt + 4 * g4) = ow; }
    }
    WG_BARRIER();
}
__device__ __forceinline__ double d_exp(double x) {
    const double k = __builtin_rint(x * 1.4426950408889634), r = x - k * 0.6931471805599453;
    double e = 1.0, term = 1.0;
    for (int n = 1; n <= 20; ++n) { term *= r / (double)n; e += term; }
    const long long bits = (long long)(1023 + (int)k) << 52;
    return e * __builtin_bit_cast(double, bits);
}
__device__ __forceinline__ void d_sincos(double th, double& sn, double& cs) {
    const double q = __builtin_rint(th * 0.15915494309189535), r = th - q * 6.283185307179586, r2 = -r * r;
    double s = r, c = 1.0, ts = r, tc = 1.0;
    for (int n = 1; n <= 14; ++n) { tc *= r2 / (double)((2 * n - 1) * (2 * n)); c += tc; ts *= r2 / (double)((2 * n) * (2 * n + 1)); s += ts; }
    sn = s; cs = c;
}
__device__ __forceinline__ void ssm_tables(const float* const* in, unsigned char* ws, int gtid, int nthreads) {
    for (int i = gtid; i < NLAYER * 16 * 64; i += nthreads) {
        const int p = i & 63, lg = i >> 6;
        const double lre = in[12][i], lim = in[13][i], dt = d_exp((double)in[14][lg]);
        const double er = d_exp(lre * dt); double sn, cs; d_sincos(lim * dt, sn, cs);
        const double lbr = er * cs, lbi = er * sn;
        const double nr = lbr - 1.0, ni = lbi, den = lre * lre + lim * lim;
        const double fr_ = (nr * lre + ni * lim) / den, fi_ = (ni * lre - nr * lim) / den;
        float* bbc = (float*)(ws + SSM_BBC) + (size_t)i * 32; bf16* bbt = (bf16*)(ws + SSM_BBT) + (size_t)lg * 128 * 16;
        for (int h = 0; h < 16; ++h) { const double br = in[15][i * 16 + h], bi = in[16][i * 16 + h]; const float re = (float)(fr_ * br - fi_ * bi), im = (float)(fr_ * bi + fi_ * br);
            bbc[2 * h] = re; bbc[2 * h + 1] = im; bbt[p * 16 + h] = (bf16)(pk2(re, 0.f) & 0xffffu); bbt[(64 + p) * 16 + h] = (bf16)(pk2(im, 0.f) & 0xffffu); }
        bf16* cct = (bf16*)(ws + SSM_CCT) + (size_t)lg * 16 * 128;
        for (int hp = 0; hp < 16; ++hp) { const float cre = in[17][(lg * 16 + hp) * 64 + p], cim = in[18][(lg * 16 + hp) * 64 + p]; *(unsigned*)(cct + hp * 128 + 2 * p) = pk2(cre, -cim); }
        float* pw = (float*)(ws + SSM_PW) + (size_t)lg * 65 * 128;
        double xr = 1.0, xi = 0.0;
        float* w1 = (float*)(ws + SSM_W1) + (size_t)lg * 8192;
        for (int n = 0; n <= 64; ++n) { pw[(n * 64 + p) * 2] = (float)xr; pw[(n * 64 + p) * 2 + 1] = (float)xi;
            if (n < 64) { const int t = 63 - n, ln = ((t >> 2) & 3) * 16 + (p & 15), o = ((ln * 16 + (t >> 4) * 4 + (t & 3)) * 4 + (p >> 4)) * 2; w1[o] = (float)xr; w1[o + 1] = (float)xi; }
            const double t = xr * lbr - xi * lbi; xi = xr * lbi + xi * lbr; xr = t; }
    }
}
__device__ __forceinline__ void ssm_ktable(const float* const* in, unsigned char* ws, int gtid, int nthreads) {
    bf16* KT = (bf16*)(ws + SSM_KT);
    for (int i = gtid; i < NLAYER * 16 * 64 * 256; i += nthreads) {
        const int h = i & 15, hp = (i >> 4) & 15, tau = (i >> 8) & 63, lg = i >> 14;
        const float* pw = (const float*)(ws + SSM_PW) + ((size_t)lg * 65 + tau) * 128; const float* bbc = (const float*)(ws + SSM_BBC) + (size_t)lg * 64 * 32 + 2 * h;
        const float* cre = in[17] + (size_t)(lg * 16 + hp) * 64; const float* cim = in[18] + (size_t)(lg * 16 + hp) * 64;
        float acc = 0.f;
        for (int p = 0; p < 64; ++p) { const float zr = pw[2 * p], zi = pw[2 * p + 1], br = bbc[p * 32], bi = bbc[p * 32 + 1];
            acc += cre[p] * (zr * br - zi * bi) - cim[p] * (zr * bi + zi * br); }
        if (tau == 0 && h == hp) acc += in[19][lg * 16 + hp];
        KT[i] = (bf16)(pk2(acc, 0.f) & 0xffffu);
    }
}
__device__ __forceinline__ void ssm1_item(unsigned char* ws, int L, int item, int wv, int lane_unused) {
    const int tok0 = item * 64;
    const bf16* ZC = (const bf16*)(ws + WS_ZC); float* S = (float*)(ws + SSM_S);
    const bf16x8 zero8 = (bf16x8){0, 0, 0, 0, 0, 0, 0, 0};
    for (int gi = 0; gi < 2; ++gi) {
        const int g = 2 * wv + gi, lg = L * 16 + g;
        const int lane = fresh_lane(), fr = lane & 15, g4 = lane >> 4;
        const bf16* bbt = (const bf16*)(ws + SSM_BBT) + (size_t)lg * 128 * 16; const float* pw = (const float*)(ws + SSM_PW) + (size_t)lg * 65 * 128;
        bf16x8 bfr[8];
#pragma unroll
        for (int n = 0; n < 8; ++n) bfr[n] = (g4 < 2) ? *(const bf16x8*)(bbt + (16 * n + fr) * 16 + 8 * g4) : zero8;
        bf16x8 uf[4];
#pragma unroll
        for (int m = 0; m < 4; ++m) uf[m] = (g4 < 2) ? *(const bf16x8*)(ZC + (size_t)(tok0 + 16 * m + fr) * 256 + g * 16 + 8 * g4) : zero8;
        f32x2_t l1[4], l16[4], lg4[4];
#pragma unroll
        for (int q = 0; q < 4; ++q) { l1[q] = *(const f32x2_t*)(pw + (1 * 64 + 16 * q + fr) * 2); l16[q] = *(const f32x2_t*)(pw + (16 * 64 + 16 * q + fr) * 2); lg4[q] = *(const f32x2_t*)(pw + ((12 - 4 * g4) * 64 + 16 * q + fr) * 2); }
        float sre[4] = {0.f, 0.f, 0.f, 0.f}, sim[4] = {0.f, 0.f, 0.f, 0.f};
#pragma unroll
        for (int m = 0; m < 4; ++m) {
            f32x4 d[8];
#pragma unroll
            for (int n = 0; n < 8; ++n) d[n] = __builtin_amdgcn_mfma_f32_16x16x32_bf16(uf[m], bfr[n], (f32x4){0.f, 0.f, 0.f, 0.f}, 0, 0, 0);
#pragma unroll
            for (int q = 0; q < 4; ++q) {
                float ir = d[q][0], ii = d[q + 4][0];
#pragma unroll
                for (int r = 1; r < 4; ++r) { const float t = l1[q][0] * ir - l1[q][1] * ii + d[q][r]; ii = l1[q][0] * ii + l1[q][1] * ir + d[q + 4][r]; ir = t; }
                const float t = l16[q][0] * sre[q] - l16[q][1] * sim[q] + ir; sim[q] = l16[q][0] * sim[q] + l16[q][1] * sre[q] + ii; sre[q] = t;
            }
        }
#pragma unroll
        for (int q = 0; q < 4; ++q) { const float t = lg4[q][0] * sre[q] - lg4[q][1] * sim[q]; sim[q] = lg4[q][0] * sim[q] + lg4[q][1] * sre[q]; sre[q] = t; }
#pragma unroll
        for (int q = 0; q < 4; ++q) { sre[q] = add_xor16(sre[q]); sre[q] = add_xor32(sre[q]); sim[q] = add_xor16(sim[q]); sim[q] = add_xor32(sim[q]);
            if (g4 == 0) *(f32x2_t*)(S + ((size_t)(item * 16 + g) * 64 + 16 * q + fr) * 2) = (f32x2_t){sre[q], sim[q]}; }
    }
}
__device__ __forceinline__ void ssm_scan(unsigned char* ws, int L, LAS unsigned char* lds, int bg, int wv) {
    const int lane = fresh_lane(), b = bg >> 4, g = bg & 15;
    const f32x2_t lam = *(const f32x2_t*)((const float*)(ws + SSM_PW) + ((size_t)(L * 16 + g) * 65 + 64) * 128 + 2 * lane);
    float* sp = (float*)(ws + SSM_S) + (((size_t)(b * 128 + 16 * wv) * 16 + g) * 64 + lane) * 2;
    f32x2_t sv[16];
#pragma unroll
    for (int j = 0; j < 16; ++j) sv[j] = *(const f32x2_t*)(sp + (size_t)j * 2048);
    float pr[16], pi[16]; float xr = 0.f, xi = 0.f, wr = 1.f, wi = 0.f;
#pragma unroll
    for (int j = 0; j < 16; ++j) { pr[j] = xr; pi[j] = xi; const float t = lam[0] * xr - lam[1] * xi + sv[j][0]; xi = lam[0] * xi + lam[1] * xr + sv[j][1]; xr = t;
        const float tw = wr * lam[0] - wi * lam[1]; wi = wr * lam[1] + wi * lam[0]; wr = tw; }
    LAS f32x2_t* E = (LAS f32x2_t*)lds;
    E[wv * 64 + lane] = (f32x2_t){xr, xi};
    WG_BARRIER();
    float br = 0.f, bi = 0.f;
    for (int w2 = 0; w2 < wv; ++w2) { const f32x2_t e = E[w2 * 64 + lane]; const float t = wr * br - wi * bi + e[0]; bi = wr * bi + wi * br + e[1]; br = t; }
    float qr = 1.f, qi = 0.f;
#pragma unroll
    for (int j = 0; j < 16; ++j) { *(f32x2_t*)(sp + (size_t)j * 2048) = (f32x2_t){qr * br - qi * bi + pr[j], qr * bi + qi * br + pi[j]};
        const float tq = qr * lam[0] - qi * lam[1]; qi = qr * lam[1] + qi * lam[0]; qr = tq; }
    WG_BARRIER();
}
constexpr int S2_ROWB = 528, S2_XIN = 80 * S2_ROWB, S2_YT = S2_XIN + 8192, S2_SS = S2_YT + 64 * S2_ROWB;
__device__ __forceinline__ void ssm2_item(unsigned char* ws, int L, LAS unsigned char* lds, int item, int wv, int lane_unused) {
    const int lane = fresh_lane();
    const int tok0 = item * 64, b = item >> 7, c = item & 127, tid = wv * 64 + lane, fr = lane & 15, g4 = lane >> 4;
    const bf16* ZC = (const bf16*)(ws + WS_ZC); const float* S = (const float*)(ws + SSM_S);
    for (int q = tid; q < 80 * 32; q += NWAVES * 64) { const int r = q >> 5, cc = q & 31; v4u x = (v4u){0u, 0u, 0u, 0u};
        if (r >= 16) x = *(const v4u*)(ZC + (size_t)(tok0 + r - 16) * 256 + cc * 8);
        *(LAS v4u*)(lds + r * S2_ROWB + cc * 16) = x; }
#pragma unroll
    for (int k = 0; k < 2; ++k) { const int ch = tid + 512 * k; *(LAS f32x2_t*)(lds + S2_XIN + ch * 8) = *(const f32x2_t*)(S + ((size_t)item * 1024 + ch) * 2); }
    WG_BARRIER();
    for (int gi = 0; gi < 2; ++gi) {
        const int g = 2 * wv + gi, lg = L * 16 + g;
        int fr, g4; { const int l2 = fresh_lane(); fr = l2 & 15; g4 = l2 >> 4; }
        const bf16* kt = (const bf16*)(ws + SSM_KT) + (size_t)lg * 64 * 256 + fr * 16 + 8 * (g4 & 1);
        LAS const unsigned char* ub = lds + (16 + fr - (g4 >> 1)) * S2_ROWB + (g * 16 + 8 * (g4 & 1)) * 2;
        f32x4 acc[4];
#pragma unroll
        for (int m = 0; m < 4; ++m) acc[m] = (f32x4){0.f, 0.f, 0.f, 0.f};
        bf16x8 kfa[32];
#pragma unroll
        for (int lp = 0; lp < 32; ++lp) kfa[lp] = *(const bf16x8*)(kt + (2 * lp + (g4 >> 1)) * 256);
#pragma unroll
        for (int seg = 0; seg < 4; ++seg)
#pragma unroll
            for (int lp = 8 * seg; lp < 8 * seg + 8; ++lp) {
#pragma unroll
                for (int m = seg; m < 4; ++m) { const bf16x8 uf = *(LAS const bf16x8*)(ub + (16 * m - 2 * lp) * S2_ROWB); acc[m] = __builtin_amdgcn_mfma_f32_16x16x32_bf16(uf, kfa[lp], acc[m], 0, 0, 0); }
            }
        { const int l2 = fresh_lane(); fr = l2 & 15; g4 = l2 >> 4; }
        const bf16* cct = (const bf16*)(ws + SSM_CCT) + (size_t)lg * 16 * 128 + fr * 128 + 8 * g4;
        const float* pwg = (const float*)(ws + SSM_PW) + (size_t)lg * 65 * 128;
#pragma unroll
        for (int ks = 0; ks < 4; ++ks) {
            const bf16x8 cf = *(const bf16x8*)(cct + 32 * ks);
            const int p4 = 16 * ks + 4 * g4;
            const f32x4 x01 = *(LAS const f32x4*)(lds + S2_XIN + (g * 64 + p4) * 8), x23 = *(LAS const f32x4*)(lds + S2_XIN + (g * 64 + p4) * 8 + 16);
#pragma unroll
            for (int m = 0; m < 4; ++m) {
                const float* w = pwg + ((size_t)(16 * m + fr + 1) * 64 + p4) * 2;
                const f32x4 w01 = *(const f32x4*)w, w23 = *(const f32x4*)(w + 4);
                v4u zw; zw.x = pk2(w01[0] * x01[0] - w01[1] * x01[1], w01[0] * x01[1] + w01[1] * x01[0]); zw.y = pk2(w01[2] * x01[2] - w01[3] * x01[3], w01[2] * x01[3] + w01[3] * x01[2]);
                zw.z = pk2(w23[0] * x23[0] - w23[1] * x23[1], w23[0] * x23[1] + w23[1] * x23[0]); zw.w = pk2(w23[2] * x23[2] - w23[3] * x23[3], w23[2] * x23[3] + w23[3] * x23[2]);
                acc[m] = __builtin_amdgcn_mfma_f32_16x16x32_bf16(__builtin_bit_cast(bf16x8, zw), cf, acc[m], 0, 0, 0);
            }
        }
#pragma unroll
        for (int m = 0; m < 4; ++m)
#pragma unroll
            for (int r = 0; r < 4; ++r) *(LAS bf16*)(lds + S2_YT + (16 * m + 4 * g4 + r) * S2_ROWB + (g * 16 + fr) * 2) = (bf16)(pk2(gelu_fast(acc[m][r]), 0.f) & 0xffffu);
    }
    WG_BARRIER();
    {
        const int l2 = fresh_lane(), fr = l2 & 15, g4 = l2 >> 4;
        const bf16* wg = (const bf16*)(ws + WS_W + (size_t)L * LW_STRIDE + LW_GLU) + (size_t)(32 * wv + fr) * 256 + 8 * g4;
        LAS const unsigned char* yb = lds + S2_YT + fr * S2_ROWB + 16 * g4;
        f32x4 ga[2][4], gb[2][4];
#pragma unroll
        for (int nt = 0; nt < 2; ++nt)
#pragma unroll
            for (int m = 0; m < 4; ++m) { ga[nt][m] = (f32x4){0.f, 0.f, 0.f, 0.f}; gb[nt][m] = (f32x4){0.f, 0.f, 0.f, 0.f}; }
#pragma unroll
        for (int kh = 0; kh < 2; ++kh) {
            bf16x8 wa[4][2], wb[4][2];
#pragma unroll
            for (int k4 = 0; k4 < 4; ++k4)
#pragma unroll
                for (int nt = 0; nt < 2; ++nt) { wa[k4][nt] = *(const bf16x8*)(wg + (size_t)(16 * nt) * 256 + 32 * (4 * kh + k4)); wb[k4][nt] = *(const bf16x8*)(wg + (size_t)(256 + 16 * nt) * 256 + 32 * (4 * kh + k4)); }
#pragma unroll
            for (int k4 = 0; k4 < 4; ++k4) {
                bf16x8 yf[4];
#pragma unroll
                for (int m = 0; m < 4; ++m) yf[m] = *(LAS const bf16x8*)(yb + 16 * m * S2_ROWB + 64 * (4 * kh + k4));
#pragma unroll
                for (int nt = 0; nt < 2; ++nt)
#pragma unroll
                    for (int m = 0; m < 4; ++m) { ga[nt][m] = __builtin_amdgcn_mfma_f32_16x16x32_bf16(wa[k4][nt], yf[m], ga[nt][m], 0, 0, 0); gb[nt][m] = __builtin_amdgcn_mfma_f32_16x16x32_bf16(wb[k4][nt], yf[m], gb[nt][m], 0, 0, 0); }
            }
        }
        LAS float* SS = (LAS float*)(lds + S2_SS);
#pragma unroll
        for (int m = 0; m < 4; ++m) { float ss = 0.f;
#pragma unroll
            for (int nt = 0; nt < 2; ++nt)
#pragma unroll
                for (int r = 0; r < 4; ++r) { const float v = ga[nt][m][r] * sigmoid_fast(gb[nt][m][r]); ga[nt][m][r] = v; ss += v * v; }
            ss = add_xor16(ss); ss = add_xor32(ss);
            if (g4 == 0) SS[wv * 64 + 16 * m + fr] = ss; }
        WG_BARRIER();
        bf16* YC = (bf16*)(ws + WS_YCAT);
#pragma unroll
        for (int m = 0; m < 4; ++m) { float tot = 0.f;
#pragma unroll
            for (int w8 = 0; w8 < 8; ++w8) tot += SS[w8 * 64 + 16 * m + fr];
            const float rr = __builtin_amdgcn_rsqf(tot * (1.0f / 256.0f) + 1e-6f);
#pragma unroll
            for (int nt = 0; nt < 2; ++nt) { v2u o; o.x = pk2(ga[nt][m][0] * rr, ga[nt][m][1] * rr); o.y = pk2(ga[nt][m][2] * rr, ga[nt][m][3] * rr);
                *(v2u*)(YC + (size_t)(tok0 + 16 * m + fr) * DM + 768 + 32 * wv + 16 * nt + 4 * g4) = o; } }
    }
    WG_BARRIER();
}
#define XB_TMO      128
#define XB_XCNT(j)  (256  + 64 * (j))
#define XB_XSUB(j)  (1280 + 64 * (j))
#define XB_XGEN(j)  (2304 + 64 * (j))
#define XB_TOP      3328
#define XB_TOPGEN   3392
#define XCD_BAR_WORDS 3456
#define XB_SPIN_CAP (1u << 18)

__device__ __forceinline__ unsigned xb_ld(unsigned* p)              { return __hip_atomic_load(p, __ATOMIC_RELAXED, __HIP_MEMORY_SCOPE_AGENT); }
__device__ __forceinline__ unsigned xb_add(unsigned* p, unsigned v) { return __hip_atomic_fetch_add(p, v, __ATOMIC_RELAXED, __HIP_MEMORY_SCOPE_AGENT); }
__device__ __forceinline__ unsigned xb_xcc_id() { return (unsigned)__builtin_amdgcn_s_getreg((3 << 11) | 20) & 0xFu; }
#define XB_SPIN(cond, bar) do { unsigned _sp = 0; while (cond) { __builtin_amdgcn_s_sleep(1); \
    if ((++_sp & 255u) == 0u) { if (xb_ld(&(bar)[XB_TMO])) break; if (_sp > XB_SPIN_CAP) { atomicAdd(&(bar)[XB_TMO], 1u); break; } } } } while (0)

struct XcdBarrier {
    unsigned* bar; unsigned x;
    volatile LAS unsigned* st;
};

__device__ __forceinline__ XcdBarrier xcd_barrier_post(unsigned* bar, volatile LAS unsigned* st, bool leader) {
    XcdBarrier b; b.bar = bar; b.x = xb_xcc_id(); b.st = st;
    if (leader) (void)xb_add(&bar[XB_XCNT(b.x)], 1u);
    return b;
}
__device__ __forceinline__ void xcd_barrier_complete(unsigned* bar, unsigned x, unsigned& nloc, unsigned& nx) {
    const unsigned G = gridDim.x * gridDim.y * gridDim.z;
    unsigned sum, cnt, mine, sp = 0u;
    for (;;) {
        sum = 0u; cnt = 0u; mine = 0u;
#pragma unroll
        for (unsigned j = 0; j < 16; ++j) { const unsigned c = xb_ld(&bar[XB_XCNT(j)]); sum += c; cnt += (c > 0u) ? 1u : 0u; mine = (j == x) ? c : mine; }
        if (sum == G) break;
        __builtin_amdgcn_s_sleep(1);
        if ((++sp & 255u) == 0u) { if (xb_ld(&bar[XB_TMO])) break; if (sp > XB_SPIN_CAP) { atomicAdd(&bar[XB_TMO], 1u); break; } }
    }
    nloc = mine > 0u ? mine : 1u; nx = cnt > 0u ? cnt : 1u;
}

__device__ __forceinline__ void xcd_barrier(const XcdBarrier& b, bool leader) {
    asm volatile("s_waitcnt vmcnt(0)" ::: "memory");
    __syncthreads();
    if (leader) {
        unsigned* bar = b.bar;
        __builtin_amdgcn_s_waitcnt(0);
        unsigned nloc = b.st[0], nx = b.st[1];
        if (nloc == 0u) { xcd_barrier_complete(bar, b.x, nloc, nx); b.st[0] = nloc; b.st[1] = nx; }
        const unsigned old = xb_add(&bar[XB_XSUB(b.x)], 1u);
        const unsigned gen = old / nloc;
        if (old + 1u == (gen + 1u) * nloc) {
            __builtin_amdgcn_fence(__ATOMIC_RELEASE, "agent");
            asm volatile("s_waitcnt vmcnt(0)" ::: "memory");
            const unsigned og = xb_add(&bar[XB_TOP], 1u);
            const unsigned tg = og / nx;
            if (og + 1u == (tg + 1u) * nx) xb_add(&bar[XB_TOPGEN], 1u);
            else XB_SPIN(xb_ld(&bar[XB_TOPGEN]) == tg, bar);
            __builtin_amdgcn_fence(__ATOMIC_ACQUIRE, "agent");
            xb_add(&bar[XB_XGEN(b.x)], 1u);
            asm volatile("s_waitcnt vmcnt(0)" ::: "memory");
        } else {
            XB_SPIN(xb_ld(&bar[XB_XGEN(b.x)]) == gen, bar);
            __builtin_amdgcn_fence(__ATOMIC_ACQUIRE, "agent");
            asm volatile("s_waitcnt vmcnt(0)" ::: "memory");
        }
    }
    __syncthreads();
}
constexpr int LDS_BYTES = 147456;

__device__ __forceinline__ void prep_transpose_item(const float* W, int K, int N, const float* g, bf16* WT, LAS float* scr, int item, int lane, bool perm) {
    const int nblk = N / 64, kb = item / nblk, nb = item % nblk, k0 = 64 * kb, l0 = 64 * nb;
    const float* wp = W + (size_t)k0 * N + l0 + lane;
    float w[64];
#pragma unroll
    for (int i = 0; i < 64; ++i) w[i] = wp[(size_t)i * N];
    if (g) {
#pragma unroll
        for (int i = 0; i < 64; ++i) w[i] *= g[k0 + i];
    }
#pragma unroll
    for (int i = 0; i < 64; ++i) scr[i * 65 + lane] = w[i];
    asm volatile("s_waitcnt lgkmcnt(0)" ::: "memory");
    const int c = lane & 7;
#pragma unroll
    for (int j = 0; j < 8; ++j) { const int ll = (lane >> 3) + 8 * j;
        int prow;
        if (perm) { const int bj = ll >> 5, y = ll & 31, x = 16 * ((y >> 2) & 1) + 4 * (y >> 3) + (y & 3), wc = (l0 >> 6) & 3; prow = (l0 & ~255) + 128 * bj + 32 * wc + x; }
        else prow = l0 + ll;
        const LAS float* s = scr + (8 * c) * 65 + ll;
        v4u o; o.x = pk2(s[0 * 65], s[1 * 65]); o.y = pk2(s[2 * 65], s[3 * 65]); o.z = pk2(s[4 * 65], s[5 * 65]); o.w = pk2(s[6 * 65], s[7 * 65]);
        *(v4u*)(WT + (size_t)prow * K + k0 + 8 * c) = o; }
    asm volatile("s_waitcnt lgkmcnt(0)" ::: "memory");
}
struct Args { const float* in[30]; float* out; unsigned char* ws; int s_lo, s_hi; };

__device__ __forceinline__ void prologue_phase(const Args& a, unsigned char* ws, float* outp, LAS unsigned char* lds, int gw, int NGW, int wave, int lane) {
    LAS float* scr = (LAS float*)(lds + wave * 16640);
    constexpr int I_IN = 16 * 24, I_OUT = 16 * 16, I_FF1 = 16 * 64, I_FF2 = 64 * 16, I_GATE = 16 * 16, I_PROJ = 4 * 16, I_GLU = 4 * 4, I_L = I_IN + I_OUT + I_FF1 + I_FF2 + I_GATE + I_PROJ + 2 * I_GLU;
    for (int it = gw; it < NLAYER * I_L; it += NGW) {
        const int L = it / I_L; int r = it % I_L; unsigned char* wl = ws + WS_W + (size_t)L * LW_STRIDE;
        const float* W; const float* gg; bf16* WT; int K, N; bool perm = true;
        if (r < I_IN) { W = a.in[4] + (size_t)L * DM * NIN; K = DM; N = NIN; gg = a.in[3] + L * DM; WT = (bf16*)(wl + LW_IN); }
        else if ((r -= I_IN) < I_OUT) { W = a.in[23] + (size_t)L * DM * DM; K = DM; N = DM; gg = a.in[22] + L * DM; WT = (bf16*)(wl + LW_OUT); }
        else if ((r -= I_OUT) < I_FF1) { W = a.in[25] + (size_t)L * DM * DFF; K = DM; N = DFF; gg = a.in[24] + L * DM; WT = (bf16*)(wl + LW_FF1); }
        else if ((r -= I_FF1) < I_FF2) { W = a.in[26] + (size_t)L * DFF * DM; K = DFF; N = DM; gg = nullptr; WT = (bf16*)(wl + LW_FF2); }
        else if ((r -= I_FF2) < I_GATE) { W = a.in[28] + (size_t)L * DM * DM; K = DM; N = DM; gg = a.in[27] + L * DM; WT = (bf16*)(wl + LW_GATE); }
        else if ((r -= I_GATE) < I_PROJ) { W = a.in[29] + (size_t)L * 256 * DM; K = 256; N = DM; gg = nullptr; WT = (bf16*)(wl + LW_PROJ); }
        else if ((r -= I_PROJ) < I_GLU) { W = a.in[20] + (size_t)L * 65536; K = 256; N = 256; gg = nullptr; WT = (bf16*)(wl + LW_GLU); perm = false; }
        else { r -= I_GLU; W = a.in[21] + (size_t)L * 65536; K = 256; N = 256; gg = nullptr; WT = (bf16*)(wl + LW_GLU) + 65536; perm = false; }
        prep_transpose_item(W, K, N, gg, WT, scr, r, lane, perm);
    }
    {
        const float* x = a.in[0]; float* h = outp; bf16* hb = (bf16*)(ws + WS_YCAT); float* ssq = (float*)(ws + TAB_SSQ0);
        for (int m = gw; m < NTOK; m += 2 * NGW) {
            f32x4 v[2][4];
#pragma unroll
            for (int u = 0; u < 2; ++u)
#pragma unroll
                for (int j = 0; j < 4; ++j) v[u][j] = ((const f32x4*)(x + (size_t)(m + u * NGW) * DM) + lane)[64 * j];
#pragma unroll
            for (int u = 0; u < 2; ++u) { const int mm = m + u * NGW; f32x4* hr = (f32x4*)(h + (size_t)mm * DM) + lane; unsigned long long* o8 = (unsigned long long*)(hb + (size_t)mm * DM) + lane; float s = 0.f;
#pragma unroll
                for (int j = 0; j < 4; ++j) { const f32x4 t = v[u][j]; hr[64 * j] = t; s += (t[0] * t[0] + t[1] * t[1]) + (t[2] * t[2] + t[3] * t[3]);
                    o8[64 * j] = (unsigned long long)pk2(t[0], t[1]) | ((unsigned long long)pk2(t[2], t[3]) << 32); }
                s = wave_sum(s);
                if (lane < 4) ssq[lane * NTOK + mm] = (lane == 0) ? s : 0.f; }
        }
    }
    {
        const int* pos = (const int*)a.in[2]; float* cosT = (float*)(ws + TAB_COS); float* sinT = (float*)(ws + TAB_SIN);
        for (int i = gw * 64 + lane; i < NTOK * 32; i += NGW * 64) { const int tok = i >> 5, k = i & 31;
            const double rev = (double)pos[tok] * ROPE_INV_REV[k]; const float r = (float)(rev - __builtin_rint(rev));
            cosT[i] = __builtin_amdgcn_cosf(r); sinT[i] = __builtin_amdgcn_sinf(r); }
    }
    {
        bf16* gwt = (bf16*)(ws + TAB_GW);
        for (int i = gw * 64 + lane; i < NLAYER * 4 * 128 * 128; i += NGW * 64) { const int s_ = i & 127, t_ = (i >> 7) & 127; gwt[i] = (bf16)(pk2(s_ <= t_ ? a.in[7][i] : 0.f, 0.f) & 0xffffu); }
    }
    ssm_tables(a.in, ws, gw * 64 + lane, NGW * 64);
    {
        float* sm = (float*)(ws + TAB_SMALL);
        for (int i = gw * 64 + lane; i < NLAYER * SM_STRIDE; i += NGW * 64) { const int L = i / SM_STRIDE, o = i % SM_STRIDE; float v = 0.f;
            if (o < SM_LNB) v = a.in[5][L * 256 + o]; else if (o < SM_QG) v = a.in[6][L * 256 + o - SM_LNB]; else if (o < SM_KG) v = a.in[9][L * 64 + o - SM_QG];
            else if (o < SM_SINK) v = a.in[10][L * 64 + o - SM_KG]; else if (o < SM_SINK + 8) v = a.in[11][L * 8 + o - SM_SINK];
            else if (o >= SM_GBS && o < SM_GBS + 512) v = a.in[8][L * 512 + o - SM_GBS];
            sm[i] = v; }
    }
}

enum { ST_IN = 0, ST_MIX, ST_CARRY, ST_SSM2, ST_OUT, ST_FF1, ST_FF2, ST_PLE, NSTEP };
#ifndef PG8_SP2
#define PG8_SP2 true
#endif
#ifndef PG8_ALIGN
#define PG8_ALIGN true
#endif
__global__ void __launch_bounds__(NWAVES * 64, 2) mk_fwd(Args args) {
    extern __shared__ __attribute__((aligned(16))) unsigned char lds_raw[];
    LAS unsigned char* lds = (LAS unsigned char*)lds_raw;
    const int G = gridDim.x;
    const int wave0 = __builtin_amdgcn_readfirstlane(threadIdx.x >> 6);
    volatile LAS unsigned* MISC = (volatile LAS unsigned*)(lds + 143360);
    { const int l0 = fresh_lane(); if (wave0 == 0) MISC[l0] = 0u; }
    __syncthreads();
    XcdBarrier bar = xcd_barrier_post((unsigned*)(args.ws + WS_CTL) + 4096, MISC, wave0 == 0 && fresh_lane() == 0);
#ifndef PROBE_DUP
#define PROBE_DUP (-2)
#endif
#ifndef PROBE_XBAR
#define PROBE_XBAR 0
#endif
    for (int i = args.s_lo; i < args.s_hi; ++i) {
        if (i > args.s_lo) { xcd_barrier(bar, wave0 == 0 && fresh_lane() == 0);
            for (int xb = 0; xb < PROBE_XBAR; ++xb) xcd_barrier(bar, wave0 == 0 && fresh_lane() == 0); }
        int s = i;
        if (PROBE_DUP == -1) s = i > 0 ? i - 1 : 0;
        else if (PROBE_DUP >= 0) { if (i > 0) { const int j = (i - 1) % (NSTEP + 1), Lq = (i - 1) / (NSTEP + 1); s = 1 + Lq * NSTEP + (j <= PROBE_DUP ? j : j - 1); } }
        unsigned long long z0 = 0ull; int bx = blockIdx.x; int wv = wave0;
        asm volatile("" : "+s"(z0), "+s"(bx), "+s"(wv));
        unsigned char* ws = args.ws + z0; float* outp = args.out + z0;
        const int vcu = (G % 8 == 0) ? (bx % 8) * (G / 8) + bx / 8 : bx;
#define FRESH_TID(name) int name = fresh_lane(); name += wv * 64
        if (s == 0) { FRESH_TID(t0); prologue_phase(args, ws, outp, lds, vcu * NWAVES + wv, G * NWAVES, wv, t0 & 63); asm volatile("s_waitcnt vmcnt(0) lgkmcnt(0)" ::: "memory"); __syncthreads(); continue; }
        const int L = (s - 1) / NSTEP, st = (s - 1) % NSTEP, par = L & 1;
        unsigned char* wl = ws + WS_W + (size_t)L * LW_STRIDE;
        if (st == ST_IN) {
            {
                FRESH_TID(t1); const int lane = t1 & 63;
                if (L == 0) ssm_ktable(args.in, ws, (vcu * NWAVES + wv) * 64 + lane, G * NWAVES * 64);
                const float* pl = args.in[1] + (size_t)L * NTOK * 256; bf16* pb = (bf16*)(ws + WS_PB);
                for (int m = vcu * NWAVES + wv; m < NTOK; m += G * NWAVES) { const f32x4 v = ((const f32x4*)(pl + (size_t)m * 256))[lane];
                    ((unsigned long long*)(pb + (size_t)m * 256))[lane] = (unsigned long long)pk2(v[0], v[1]) | ((unsigned long long)pk2(v[2], v[3]) << 32); }
                asm volatile("s_waitcnt vmcnt(0)" ::: "memory");
            }
            pg8::Gemm g{(const bf16*)(ws + WS_YCAT), (const bf16*)(wl + LW_IN), NTOK, NIN, DM}; pg8::StaticOrder S; S.init(NTOK, NIN, G, bx);
            pg8::EpiIn E{ws, par, L};
            { FRESH_TID(tl); pg8::gemm_phase<pg8::EpiIn, pg8::StaticOrder, PG8_ALIGN, PG8_SP2>(lds, g, S, E, tl); }
        } else if (st == ST_MIX) {
            FRESH_TID(tm); const int lane = tm & 63;
            for (int it = vcu; it < 256 + 128 + 256; it += G) { if (it < 256) attn_item(ws, L, lds, it, wv, lane); else if (it < 384) gmlp_item(ws, L, lds, it - 256, wv, lane); else ssm1_item(ws, L, it - 384, wv, lane); }
        } else if (st == ST_SSM2) {
            FRESH_TID(tm); const int lane = tm & 63;
            for (int it = vcu; it < 256; it += G) ssm2_item(ws, L, lds, it, wv, lane);
        } else if (st == ST_CARRY) {
            if (bx < 32) ssm_scan(ws, L, lds, bx, wv);
            pg8::Gemm g{(const bf16*)(ws + WS_PB), (const bf16*)(wl + LW_PROJ), NTOK, DM, 256}; pg8::StaticOrder S; S.init(NTOK, DM, G, bx);
            pg8::EpiProj E{ws};
            { FRESH_TID(tl); pg8::gemm_phase<pg8::EpiProj, pg8::StaticOrder, PG8_ALIGN, PG8_SP2>(lds, g, S, E, tl); }
        } else if (st == ST_OUT || st == ST_FF2) {
            const bool o = (st == ST_OUT);
            pg8::Gemm g{(const bf16*)(ws + (o ? WS_YCAT : WS_HID)), (const bf16*)(wl + (o ? LW_OUT : LW_FF2)), NTOK, DM, o ? DM : DFF}; pg8::StaticOrder S; S.init(NTOK, DM, G, bx);
            pg8::EpiRes<false> E{outp, ws, o ? (par ^ 1) : par};
            { FRESH_TID(tl); pg8::gemm_phase<pg8::EpiRes<false>, pg8::StaticOrder, false, PG8_SP2>(lds, g, S, E, tl); }
        } else if (st == ST_FF1) {
            pg8::Gemm g{(const bf16*)(ws + WS_HB), (const bf16*)(wl + LW_FF1), NTOK, DFF, DM}; pg8::StaticOrder S; S.init(NTOK, DFF, G, bx);
            pg8::EpiFF1 E{ws, par ^ 1};
            { FRESH_TID(tl); pg8::gemm_phase<pg8::EpiFF1, pg8::StaticOrder, PG8_ALIGN, PG8_SP2>(lds, g, S, E, tl); }
        } else if (st == ST_PLE) {
            pg8::Gemm g{(const bf16*)(ws + WS_HB), (const bf16*)(wl + LW_GATE), NTOK, DM, DM}; pg8::StaticOrder S; S.init(NTOK, DM, G, bx);
            pg8::EpiRes<true> E{outp, ws, par ^ 1};
            { FRESH_TID(tl); pg8::gemm_phase<pg8::EpiRes<true>, pg8::StaticOrder, false, PG8_SP2>(lds, g, S, E, tl); }
        }
    }
}
extern "C" void kernel_launch(void* const* d_in, const int* in_sizes, int n_in, void* d_out, int out_size, void* d_ws, size_t ws_size, hipStream_t stream) {
    static int grid = 0;
    if (grid == 0) {
        if (n_in != 30 || out_size != NTOK * DM || ws_size < WS_END) { fprintf(stderr, "kernel_launch: unexpected shapes / workspace (n_in %d out %d ws %zu)\n", n_in, out_size, ws_size); grid = -1; return; }
        int dev = 0, cus = 0, per_cu = 0;
        (void)hipGetDevice(&dev); (void)hipDeviceGetAttribute(&cus, hipDeviceAttributeMultiprocessorCount, dev);
        (void)hipFuncSetAttribute((const void*)mk_fwd, hipFuncAttributeMaxDynamicSharedMemorySize, LDS_BYTES);
        (void)hipOccupancyMaxActiveBlocksPerMultiprocessor(&per_cu, (const void*)mk_fwd, NWAVES * 64, LDS_BYTES);
        (void)hipGetLastError();
        grid = (per_cu >= 1 && cus == 256) ? 256 : -1;
        if (grid < 0) { fprintf(stderr, "kernel_launch: needs 256 CUs with one resident workgroup each (cus %d per_cu %d)\n", cus, per_cu); return; }
    }
    if (grid < 0) return;
    (void)hipMemsetAsync((char*)d_ws + WS_CTL, 0, CTL_ZERO_BYTES, stream);
    Args a{};
    for (int i = 0; i < 30; ++i) a.in[i] = (const float*)d_in[i];
    a.out = (float*)d_out; a.ws = (unsigned char*)d_ws;
    unsigned char* ws = (unsigned char*)d_ws;
    const float* const* F = a.in;
#define LAUNCH_STEPS(lo, hi) do { a.s_lo = (lo); a.s_hi = (hi); hipLaunchKernelGGL(mk_fwd, dim3(grid), dim3(NWAVES * 64), LDS_BYTES, stream, a); } while (0)
#ifndef MK_SINGLE
#define MK_SINGLE 1
#endif
#if MK_SINGLE
    LAUNCH_STEPS(0, (PROBE_DUP == -1) ? 2 + NLAYER * NSTEP : (PROBE_DUP >= 0 ? 1 + NLAYER * (NSTEP + 1) : 1 + NLAYER * NSTEP));
#else
    for (int s = 0; s < 1 + NLAYER * NSTEP; ++s) LAUNCH_STEPS(s, s + 1);
#endif
}
```

```cpp
#include <hip/hip_runtime.h>
#include <cstdio>
#include <cstdint>
#include <math.h>

#define NTOK 16384
#define SEQL 8192
#define DM 1024
#define NIN 1536
#define DFF 4096
#define NLAYER 4
constexpr float QSCALE = 0.125f * 1.4426950408889634f;
constexpr float LOG2E = 1.4426950408889634f;

constexpr size_t MiB = 1u << 20;
constexpr size_t WS_CTL = 0, CTL_ZERO_BYTES = 1 * MiB;
constexpr size_t WS_W = 2 * MiB;
constexpr size_t LW_IN = 0, LW_OUT = 3 * MiB, LW_FF1 = 5 * MiB, LW_FF2 = 13 * MiB, LW_GATE = 21 * MiB, LW_PROJ = 23 * MiB, LW_GLU = 23 * MiB + 512 * 1024, LW_STRIDE = 24 * MiB;
constexpr size_t WS_TAB = 98 * MiB;
constexpr size_t TAB_COS = WS_TAB, TAB_SIN = WS_TAB + 2 * MiB, TAB_SSQ0 = WS_TAB + 4 * MiB, TAB_SSQ1 = TAB_SSQ0 + 256 * 1024, TAB_GW = TAB_SSQ1 + 256 * 1024, TAB_SMALL = TAB_GW + 512 * 1024, TAB_END = TAB_SMALL + 64 * 1024;
constexpr int SM_LNG = 0, SM_LNB = 256, SM_QG = 512, SM_KG = 576, SM_SINK = 640, SM_GBS = 1024  , SM_STRIDE = 2048;
constexpr size_t WS_HB = 104 * MiB;
constexpr size_t WS_U = 138 * MiB, WS_VLN = 146 * MiB, WS_Q = 154 * MiB, WS_K = 170 * MiB, WS_V = 174 * MiB, WS_ZC = 178 * MiB;
constexpr size_t WS_YCAT = 186 * MiB;
constexpr size_t WS_HID = 138 * MiB;
constexpr size_t WS_PPROJ = 266 * MiB;
constexpr size_t WS_YF = 218 * MiB;
constexpr size_t WS_YSSM = 282 * MiB;
constexpr size_t WS_PB = 298 * MiB;
constexpr size_t WS_SSM = 306 * MiB;
constexpr size_t SSM_PW = WS_SSM;
constexpr size_t SSM_KT = SSM_PW + 2304 * 1024;
constexpr size_t SSM_BBT = SSM_KT + 2 * MiB;
constexpr size_t SSM_CCT = SSM_BBT + 256 * 1024;
constexpr size_t SSM_BBC = SSM_CCT + 256 * 1024;
constexpr size_t SSM_S = SSM_BBC + 512 * 1024;
constexpr size_t SSM_W1 = SSM_S + 2 * MiB;
constexpr size_t WS_END = SSM_W1 + 2 * MiB;
static_assert(WS_END <= 316 * MiB, "ssm region");
static_assert(TAB_END <= WS_HB && WS_HB + 32 * MiB <= WS_U && WS_HID + 128 * MiB <= WS_PPROJ && WS_YF + 64 * MiB <= WS_YSSM && WS_YSSM + 16 * MiB <= WS_PB, "ws map");
static_assert(WS_W + NLAYER * LW_STRIDE <= WS_TAB, "weights");

typedef float f32x2_t __attribute__((ext_vector_type(2)));
typedef __bf16 bf16x2_t __attribute__((ext_vector_type(2)));
__device__ __forceinline__ unsigned pk2(float lo, float hi) { f32x2_t v = {lo, hi}; bf16x2_t b = __builtin_convertvector(v, bf16x2_t); return __builtin_bit_cast(unsigned, b); }
__device__ __forceinline__ float bf_lo(unsigned w) { return __uint_as_float(w << 16); }
__device__ __forceinline__ float bf_hi(unsigned w) { return __uint_as_float(w & 0xffff0000u); }
__device__ __forceinline__ float bf2f(unsigned short b) { return __uint_as_float(((unsigned)b) << 16); }
template <int X> __device__ __forceinline__ float xor_lane(float v) { return __int_as_float(__builtin_amdgcn_ds_swizzle(__float_as_int(v), (X << 10) | 0x1f)); }
__device__ __forceinline__ float add_xor16(float v) { return v + xor_lane<16>(v); }
__device__ __forceinline__ float add_xor32(float v) { auto r = __builtin_amdgcn_permlane32_swap(__float_as_uint(v), __float_as_uint(v), false, false); return __uint_as_float(r[0]) + __uint_as_float(r[1]); }
__device__ __forceinline__ float wave_sum(float v) {
    v += xor_lane<1>(v); v += xor_lane<2>(v); v += xor_lane<4>(v); v += xor_lane<8>(v); v = add_xor16(v); return add_xor32(v);
}
__device__ __forceinline__ float wave_sum_shfl(float v) {
#pragma unroll
    for (int o = 1; o < 64; o <<= 1) v += __shfl_xor(v, o);
    return v;
}
__device__ __forceinline__ int fresh_lane() { int l; asm volatile("v_mbcnt_lo_u32_b32 %0, -1, 0\n\tv_mbcnt_hi_u32_b32 %0, -1, %0" : "=v"(l)); return l; }
__device__ __forceinline__ float gelu_fast(float x) {
    const float u = x * (1.0f + 0.044715f * x * x);
    const float t = __builtin_amdgcn_exp2f(u * 2.3022082f);
    return x - x * __builtin_amdgcn_rcpf(1.0f + t);
}
__device__ __forceinline__ float sigmoid_fast(float x) { return __builtin_amdgcn_rcpf(1.0f + __builtin_amdgcn_exp2f(-x * LOG2E)); }
__device__ __forceinline__ float gelu_tanh(float x) { const float k0 = 0.7978845608028654f, k1 = 0.044715f; float u = k0 * (x + k1 * x * x * x); return 0.5f * x * (1.0f + tanhf(u)); }
__device__ const double ROPE_INV_REV[32] = {0.15915494309189535, 0.11934937021124886, 0.08949940160889101, 0.06711508300522726, 0.050329212104487035, 0.03774158471741977, 0.0283021958306234, 0.02122365276477766, 0.015915494309189534, 0.011934937021124886, 0.008949940160889102, 0.006711508300522725, 0.005032921210448704, 0.003774158471741977, 0.00283021958306234, 0.0021223652764777662, 0.0015915494309189536, 0.0011934937021124885, 0.0008949940160889102, 0.0006711508300522726, 0.0005032921210448703, 0.00037741584717419774, 0.00028302195830623395, 0.0002122365276477766, 0.00015915494309189535, 0.00011934937021124886, 8.949940160889102e-05, 6.711508300522725e-05, 5.0329212104487035e-05, 3.774158471741978e-05, 2.8302195830623396e-05, 2.122365276477766e-05};
namespace pg8 {
#define PG8_LAS __attribute__((address_space(3)))
typedef unsigned short bf16_t;
typedef short bf16x8 __attribute__((ext_vector_type(8)));
typedef float f32x4 __attribute__((ext_vector_type(4)));
typedef unsigned u32x4 __attribute__((ext_vector_type(4)));
constexpr int BM = 256, BK = 64, HALF = 128, HTB = HALF * BK * 2  , STAGE_BYTES = 8 * HTB, NXCD = 8, WGM = 8;

__host__ __device__ __forceinline__ int lds_byte(int r, int c) { const int st = (r >> 4) * 2 + (c >> 5), rr = r & 15, cc = c & 31, ob = rr * 64 + cc * 2; return st * 1024 + (ob ^ (((ob >> 9) & 1) << 5)); }
__host__ __device__ __forceinline__ void stage_rc(int b, int& R, int& C) { const int st = b / 1024, sb = b % 1024, swz = sb ^ (((sb >> 9) & 1) << 5); R = (st >> 1) * 16 + swz / 64; C = (st & 1) * 32 + (swz % 64) / 2; }
__host__ __device__ __forceinline__ int perm32(int rho) { const int n = rho >> 4, i = rho & 15; return 8 * (i >> 2) + 4 * n + (i & 3); }

struct Unit { int pm, pn; };
struct Gemm { const bf16_t* A; const bf16_t* Bt; int M, N, K; };

struct StaticOrder {
    int nM, nN, nwg, G, c;
    __host__ __device__ void init(int M, int N, int G_, int c_) { nM = M / BM; nN = N / BM; nwg = nM * nN; G = G_; c = c_; }
    __host__ __device__ bool next(int i, Unit& u) const {
        const long L = (long)i * G + c; if (L >= nwg) return false;
        int wgid = (int)L; { const int q = nwg / NXCD, r = nwg % NXCD, xcd = wgid % NXCD, off = wgid / NXCD; wgid = (xcd < r ? xcd * (q + 1) : r * (q + 1) + (xcd - r) * q) + off; }
        const int nig = WGM * nN, gid = wgid / nig, fm = gid * WGM, gsz = (nM - fm) < WGM ? (nM - fm) : WGM;
        u.pm = fm + ((wgid % nig) % gsz); u.pn = (wgid % nig) / gsz; return true;
    }
    __device__ __forceinline__ void a_ready(const Unit&) const {}
    __device__ __forceinline__ void done(const Unit&) const {}
};

template <class Epi, class Sched, bool ALIGN_EPI = false, bool SP2 = false>
__device__ __forceinline__ void gemm_phase(PG8_LAS unsigned char* lds, const Gemm g, const Sched& S, const Epi& E, const int tid) {
    const int wid = __builtin_amdgcn_readfirstlane(tid >> 6), lane = tid & 63, wr = wid >> 2, wc = wid & 3, fr = lane & 15, fq = lane >> 4;
    const int K = g.K, nt = K / BK;
    unsigned voffA[2], voffB[2];
#pragma unroll
    for (int i = 0; i < 2; ++i) { int R, C; stage_rc(tid * 16 + i * 8192, R, C); const int Rb = Epi::PERM ? ((R & ~31) + perm32(R & 31)) : R;
        voffA[i] = (unsigned)(R * K + C) * 2u; voffB[i] = (unsigned)(Rb * K + C) * 2u; }
    const size_t kstep = (size_t)(BK * 2);
    const size_t hstep = (size_t)HALF * K * 2;
    const size_t tstep = 2 * hstep;
    const unsigned ldsw = (unsigned)wid * 1024u;
    const int aoff = lds_byte(wr * 64 + fr, fq * 8), boff = lds_byte(wc * 32 + fr, fq * 8);
#define PG8_SA(b, h) (((b) * 2 + (h)) * HTB)
#define PG8_SB(b, h) ((4 + (b) * 2 + (h)) * HTB)
#define PG8_STAGE(bufoff, gbase, voff) do { _Pragma("unroll") for (int _i = 0; _i < 2; ++_i) \
        __builtin_amdgcn_global_load_lds((const unsigned*)((const char*)(gbase) + (voff)[_i]), (PG8_LAS unsigned*)(lds + (bufoff) + ldsw + _i * 8192), 16, 0, 0); } while (0)
#define PG8_LDA(dst, b, h) do { _Pragma("unroll") for (int m = 0; m < 4; ++m) _Pragma("unroll") for (int k = 0; k < 2; ++k) dst[m][k] = *(const PG8_LAS bf16x8*)(lds + PG8_SA(b, h) + aoff + m * 2048 + k * 1024); } while (0)
#define PG8_LDB(dst, b, h) do { _Pragma("unroll") for (int n = 0; n < 2; ++n) _Pragma("unroll") for (int k = 0; k < 2; ++k) dst[n][k] = *(const PG8_LAS bf16x8*)(lds + PG8_SB(b, h) + boff + n * 2048 + k * 1024); } while (0)
#define PG8_MMA(ai, bj, At, Bt) do { __builtin_amdgcn_s_setprio(1); _Pragma("unroll") for (int m = 0; m < 4; ++m) _Pragma("unroll") for (int n = 0; n < 2; ++n) _Pragma("unroll") for (int k = 0; k < 2; ++k) \
        acc[ai][bj][m][n] = __builtin_amdgcn_mfma_f32_16x16x32_bf16(Bt[n][k], At[m][k], acc[ai][bj][m][n], 0, 0, 0); __builtin_amdgcn_s_setprio(0); } while (0)
#define PG8_WAIT_V(n) asm volatile("s_waitcnt vmcnt(" #n ")" ::: "memory")
#define PG8_WAIT_L(n) asm volatile("s_waitcnt lgkmcnt(" #n ")" ::: "memory")
#define PG8_BAR __builtin_amdgcn_s_barrier()
#define PG8_SCHED __builtin_amdgcn_sched_barrier(0)
    Unit cur, nxt; int ui = 0;
    if (!S.next(0, cur)) return;
    f32x4 acc[2][2][4][2];
#pragma unroll
    for (int a = 0; a < 2; ++a)
#pragma unroll
        for (int b = 0; b < 2; ++b)
#pragma unroll
            for (int m = 0; m < 4; ++m)
#pragma unroll
                for (int n = 0; n < 2; ++n) acc[a][b][m][n] = (f32x4){0.f, 0.f, 0.f, 0.f};
    bf16x8 At[4][2], B0[2][2], B1[2][2];
    const char* cA = (const char*)g.A + (size_t)cur.pm * tstep; const char* cB = (const char*)g.Bt + (size_t)cur.pn * tstep;
    S.a_ready(cur);
    if constexpr (SP2) {
        PG8_STAGE(PG8_SB(0, 0), cB, voffB); PG8_STAGE(PG8_SB(0, 1), cB + hstep, voffB); PG8_STAGE(PG8_SA(0, 0), cA, voffA); PG8_STAGE(PG8_SA(0, 1), cA + hstep, voffA);
        if (wr == 1) PG8_BAR;
        PG8_WAIT_V(2); PG8_BAR;
        PG8_STAGE(PG8_SB(1, 0), cB + kstep, voffB); PG8_STAGE(PG8_SA(1, 0), cA + kstep, voffA); PG8_STAGE(PG8_SB(1, 1), cB + hstep + kstep, voffB);
        PG8_WAIT_V(6); PG8_BAR;
    } else {
        PG8_STAGE(PG8_SB(0, 0), cB, voffB); PG8_STAGE(PG8_SA(0, 0), cA, voffA); PG8_STAGE(PG8_SB(0, 1), cB + hstep, voffB); PG8_STAGE(PG8_SA(0, 1), cA + hstep, voffA);
        if (wr == 1) PG8_BAR;
        PG8_WAIT_V(4); PG8_BAR;
        PG8_STAGE(PG8_SB(1, 0), cB + kstep, voffB); PG8_STAGE(PG8_SA(1, 0), cA + kstep, voffA); PG8_STAGE(PG8_SB(1, 1), cB + hstep + kstep, voffB);
        PG8_WAIT_V(6); PG8_BAR;
    }
    for (;;) {
        const bool has_next = S.next(ui + 1, nxt);
        const char* nA = has_next ? (const char*)g.A + (size_t)nxt.pm * tstep : cA; const char* nB = has_next ? (const char*)g.Bt + (size_t)nxt.pn * tstep : cB;
        for (int t = 0; t < nt; t += 2) {
            const bool last = (t == nt - 2);
            const char* a1 = cA + (size_t)(t + 1) * kstep;
            const char* a2 = last ? nA : cA + (size_t)(t + 2) * kstep; const char* b2 = last ? nB : cB + (size_t)(t + 2) * kstep;
            const char* a3 = a2 + kstep; const char* b3 = b2 + kstep;
            if (last && has_next) S.a_ready(nxt);
            if constexpr (SP2) {
            PG8_LDB(B0, 0, 0); PG8_LDB(B1, 0, 1); PG8_SCHED; PG8_LDA(At, 0, 0); PG8_STAGE(PG8_SA(1, 1), a1 + hstep, voffA);
            PG8_WAIT_V(8); PG8_WAIT_L(0); PG8_BAR; PG8_MMA(0, 0, At, B0); PG8_MMA(0, 1, At, B1); PG8_BAR; PG8_SCHED;
            PG8_LDA(At, 0, 1); PG8_STAGE(PG8_SB(0, 0), b2, voffB); PG8_STAGE(PG8_SB(0, 1), b2 + hstep, voffB); PG8_STAGE(PG8_SA(0, 0), a2, voffA);
            PG8_WAIT_V(8); PG8_WAIT_L(0); PG8_BAR; PG8_MMA(1, 0, At, B0); PG8_MMA(1, 1, At, B1); PG8_BAR; PG8_SCHED;
            PG8_LDB(B0, 1, 0); PG8_LDB(B1, 1, 1); PG8_SCHED; PG8_LDA(At, 1, 0); PG8_STAGE(PG8_SA(0, 1), a2 + hstep, voffA);
            PG8_WAIT_V(8); PG8_WAIT_L(0); PG8_BAR; PG8_MMA(0, 0, At, B0); PG8_MMA(0, 1, At, B1); PG8_BAR; PG8_SCHED;
            PG8_LDA(At, 1, 1); PG8_STAGE(PG8_SB(1, 0), b3, voffB); PG8_STAGE(PG8_SB(1, 1), b3 + hstep, voffB); PG8_STAGE(PG8_SA(1, 0), a3, voffA);
            PG8_WAIT_V(8); PG8_WAIT_L(0); PG8_BAR; PG8_MMA(1, 0, At, B0); PG8_MMA(1, 1, At, B1); PG8_BAR; PG8_SCHED;
            } else {
            PG8_LDB(B0, 0, 0); PG8_SCHED; PG8_LDA(At, 0, 0); PG8_STAGE(PG8_SA(1, 1), a1 + hstep, voffA);
            PG8_WAIT_L(8); PG8_BAR; PG8_WAIT_L(0); PG8_MMA(0, 0, At, B0); PG8_BAR; PG8_SCHED;
            PG8_LDB(B1, 0, 1); PG8_STAGE(PG8_SB(0, 0), b2, voffB);
            PG8_BAR; PG8_WAIT_L(0); PG8_MMA(0, 1, At, B1); PG8_BAR;
            PG8_LDA(At, 0, 1); PG8_STAGE(PG8_SA(0, 0), a2, voffA);
            PG8_BAR; PG8_WAIT_L(0); PG8_MMA(1, 0, At, B0); PG8_BAR; PG8_SCHED;
            PG8_STAGE(PG8_SB(0, 1), b2 + hstep, voffB);
            PG8_WAIT_V(6); PG8_BAR; PG8_MMA(1, 1, At, B1); PG8_BAR;
            PG8_LDB(B0, 1, 0); PG8_SCHED; PG8_LDA(At, 1, 0); PG8_STAGE(PG8_SA(0, 1), a2 + hstep, voffA);
            PG8_WAIT_L(8); PG8_BAR; PG8_WAIT_L(0); PG8_MMA(0, 0, At, B0); PG8_BAR; PG8_SCHED;
            PG8_LDB(B1, 1, 1); PG8_STAGE(PG8_SB(1, 0), b3, voffB);
            PG8_BAR; PG8_WAIT_L(0); PG8_MMA(0, 1, At, B1); PG8_BAR;
            PG8_LDA(At, 1, 1); PG8_STAGE(PG8_SA(1, 0), a3, voffA);
            PG8_BAR; PG8_WAIT_L(0); PG8_MMA(1, 0, At, B0); PG8_BAR; PG8_SCHED;
            PG8_STAGE(PG8_SB(1, 1), b3 + hstep, voffB);
            PG8_WAIT_V(6); PG8_BAR; PG8_MMA(1, 1, At, B1); PG8_BAR;
            }
        }
        if constexpr (ALIGN_EPI) { if (wr == 0) PG8_BAR; }
        if constexpr (!Epi::AFTER_DRAIN) { const int l2 = fresh_lane();
            E(acc, cur, wr, wc, l2 & 15, l2 >> 4); S.done(cur); }
        if (!has_next) break;
#pragma unroll
        for (int a = 0; a < 2; ++a)
#pragma unroll
            for (int b = 0; b < 2; ++b)
#pragma unroll
                for (int m = 0; m < 4; ++m)
#pragma unroll
                    for (int n = 0; n < 2; ++n) acc[a][b][m][n] = (f32x4){0.f, 0.f, 0.f, 0.f};
        cur = nxt; cA = nA; cB = nB; ++ui;
        if constexpr (ALIGN_EPI) { if (wr == 1) PG8_BAR; }
    }
    PG8_WAIT_V(0);
    if constexpr (!ALIGN_EPI) { if (wr == 0) PG8_BAR; }
    PG8_BAR;
    if constexpr (Epi::AFTER_DRAIN) { const int l2 = fresh_lane();
        E.fused(acc, cur, wr, wc, l2 & 15, l2 >> 4, lds, wid, l2); S.done(cur); }
#undef PG8_SA
#undef PG8_SB
#undef PG8_STAGE
#undef PG8_LDA
#undef PG8_LDB
#undef PG8_MMA
#undef PG8_WAIT_V
#undef PG8_WAIT_L
#undef PG8_BAR
#undef PG8_SCHED
}
}
namespace pg8 {
__device__ __forceinline__ float rstd_row(const float* ssq, int row) {
    const float s = (ssq[row] + ssq[NTOK + row]) + (ssq[2 * NTOK + row] + ssq[3 * NTOK + row]);
    return __builtin_amdgcn_rsqf(s * (1.0f / 1024.0f) + 1e-6f);
}
__device__ __forceinline__ void store8(bf16_t* p, const float (&v)[8]) {
    u32x4 w; w.x = pk2(v[0], v[1]); w.y = pk2(v[2], v[3]); w.z = pk2(v[4], v[5]); w.w = pk2(v[6], v[7]); *(u32x4*)p = w;
}
struct EpiIn {
    static constexpr bool PERM = false, AFTER_DRAIN = false;
    unsigned char* ws; int par, L;
    __device__ __forceinline__ void operator()(const f32x4 (&acc)[2][2][4][2], const Unit& u, int wr, int wc, int fr, int fq) const {
        const int pn = u.pn;
        const float* ssq = (const float*)(ws + (par ? TAB_SSQ1 : TAB_SSQ0)); const float* cosT = (const float*)(ws + TAB_COS); const float* sinT = (const float*)(ws + TAB_SIN);
        const float* sm = (const float*)(ws + TAB_SMALL) + L * SM_STRIDE; const float* lng = sm + SM_LNG; const float* lnb = sm + SM_LNB; const float* qg = sm + SM_QG; const float* kg = sm + SM_KG;
        bf16_t* U = (bf16_t*)(ws + WS_U); bf16_t* VLN = (bf16_t*)(ws + WS_VLN); bf16_t* Q = (bf16_t*)(ws + WS_Q); bf16_t* K = (bf16_t*)(ws + WS_K); bf16_t* V = (bf16_t*)(ws + WS_V); bf16_t* ZC = (bf16_t*)(ws + WS_ZC);
        int mode, ld, cb; bf16_t* dst; const float* gp = nullptr; const float* bp = nullptr;
        if (pn < 2) { const int head = 2 * pn + (wc >> 1); ld = 256; cb = head * 64; if (wc & 1) { mode = 1; dst = VLN; gp = lng + head * 64; bp = lnb + head * 64; } else { mode = 0; dst = U; } }
        else if (pn < 4) { mode = 2; dst = Q; ld = 512; cb = (4 * (pn - 2) + wc) * 64; gp = qg; }
        else if (pn == 4) { ld = 128; if (wc < 2) { mode = 3; dst = K; cb = wc * 64; gp = kg; } else { mode = 4; dst = V; cb = (wc - 2) * 64; } }
        else { mode = 4; dst = ZC; ld = 256; cb = wc * 64; }
        float g[16], bb[16];
#pragma unroll
        for (int i = 0; i < 16; ++i) { g[i] = 1.f; bb[i] = 0.f; }
        if (gp) {
#pragma unroll
            for (int bj = 0; bj < 2; ++bj)
#pragma unroll
                for (int n = 0; n < 2; ++n) { const f32x4 t = *(const f32x4*)(gp + 32 * bj + 8 * fq + 4 * n); g[bj * 8 + n * 4 + 0] = t[0]; g[bj * 8 + n * 4 + 1] = t[1]; g[bj * 8 + n * 4 + 2] = t[2]; g[bj * 8 + n * 4 + 3] = t[3]; }
        }
        if (bp) {
#pragma unroll
            for (int bj = 0; bj < 2; ++bj)
#pragma unroll
                for (int n = 0; n < 2; ++n) { const f32x4 t = *(const f32x4*)(bp + 32 * bj + 8 * fq + 4 * n); bb[bj * 8 + n * 4 + 0] = t[0]; bb[bj * 8 + n * 4 + 1] = t[1]; bb[bj * 8 + n * 4 + 2] = t[2]; bb[bj * 8 + n * 4 + 3] = t[3]; }
        }
#pragma unroll
        for (int ai = 0; ai < 2; ++ai)
#pragma unroll
            for (int m = 0; m < 4; ++m) {
                const int row = u.pm * BM + ai * HALF + wr * 64 + m * 16 + fr;
                const float rs = rstd_row(ssq, row);
                float v[16];
#pragma unroll
                for (int bj = 0; bj < 2; ++bj)
#pragma unroll
                    for (int n = 0; n < 2; ++n)
#pragma unroll
                        for (int j = 0; j < 4; ++j) v[bj * 8 + n * 4 + j] = acc[ai][bj][m][n][j] * rs;
                if (mode <= 1) {
#pragma unroll
                    for (int i = 0; i < 16; ++i) v[i] = gelu_fast(v[i]);
                    if (mode == 1) {
                        float s = 0.f;
#pragma unroll
                        for (int i = 0; i < 16; ++i) s += v[i];
                        s = add_xor16(s); s = add_xor32(s);
                        const float mu = s * (1.0f / 64.0f); float q = 0.f;
#pragma unroll
                        for (int i = 0; i < 16; ++i) { v[i] -= mu; q += v[i] * v[i]; }
                        q = add_xor16(q); q = add_xor32(q);
                        const float r = __builtin_amdgcn_rsqf(q * (1.0f / 64.0f) + 1e-6f);
#pragma unroll
                        for (int i = 0; i < 16; ++i) v[i] = v[i] * r * g[i] + bb[i];
                    }
                } else if (mode <= 3) {
                    float q = 0.f;
#pragma unroll
                    for (int i = 0; i < 16; ++i) q += v[i] * v[i];
                    q = add_xor16(q); q = add_xor32(q);
                    const float r = __builtin_amdgcn_rsqf(q * (1.0f / 64.0f) + 1e-6f) * (mode == 2 ? QSCALE : 1.0f);
#pragma unroll
                    for (int i = 0; i < 16; ++i) v[i] = v[i] * r * g[i];
                    const float* cp = cosT + (size_t)row * 32 + 8 * fq; const float* sp = sinT + (size_t)row * 32 + 8 * fq;
#pragma unroll
                    for (int n = 0; n < 2; ++n) { const f32x4 c4 = *(const f32x4*)(cp + 4 * n), s4 = *(const f32x4*)(sp + 4 * n);
#pragma unroll
                        for (int j = 0; j < 4; ++j) { const float x1 = v[n * 4 + j], x2 = v[8 + n * 4 + j]; v[n * 4 + j] = x1 * c4[j] - x2 * s4[j]; v[8 + n * 4 + j] = x2 * c4[j] + x1 * s4[j]; } }
                }
                bf16_t* rp = dst + (size_t)row * ld + cb + 8 * fq;
                { float t[8];
#pragma unroll
                  for (int i = 0; i < 8; ++i) t[i] = v[i];
                  store8(rp, t);
#pragma unroll
                  for (int i = 0; i < 8; ++i) t[i] = v[8 + i];
                  store8(rp + 32, t); }
            }
    }
};
struct EpiFF1 {
    static constexpr bool PERM = false, AFTER_DRAIN = false;
    unsigned char* ws; int par;
    __device__ __forceinline__ void operator()(const f32x4 (&acc)[2][2][4][2], const Unit& u, int wr, int wc, int fr, int fq) const {
        const float* ssq = (const float*)(ws + (par ? TAB_SSQ1 : TAB_SSQ0)); bf16_t* HID = (bf16_t*)(ws + WS_HID);
#pragma unroll
        for (int ai = 0; ai < 2; ++ai)
#pragma unroll
            for (int m = 0; m < 4; ++m) {
                const int row = u.pm * BM + ai * HALF + wr * 64 + m * 16 + fr;
                const float rs = rstd_row(ssq, row);
                bf16_t* rp = HID + (size_t)row * DFF + u.pn * BM + wc * 64 + 8 * fq;
#pragma unroll
                for (int bj = 0; bj < 2; ++bj) { float t[8];
#pragma unroll
                    for (int n = 0; n < 2; ++n)
#pragma unroll
                        for (int j = 0; j < 4; ++j) { float x = acc[ai][bj][m][n][j] * rs; x = x > 0.f ? x : 0.f; t[n * 4 + j] = x * x; }
                    store8(rp + 32 * bj, t); }
            }
    }
};
struct EpiProj {
    static constexpr bool PERM = false, AFTER_DRAIN = false;
    unsigned char* ws;
    __device__ __forceinline__ void operator()(const f32x4 (&acc)[2][2][4][2], const Unit& u, int wr, int wc, int fr, int fq) const {
        bf16_t* O = (bf16_t*)(ws + WS_PPROJ);
#pragma unroll
        for (int ai = 0; ai < 2; ++ai)
#pragma unroll
            for (int m = 0; m < 4; ++m) {
                const int row = u.pm * BM + ai * HALF + wr * 64 + m * 16 + fr;
                bf16_t* rp = O + (size_t)row * DM + u.pn * BM + wc * 64 + 8 * fq;
#pragma unroll
                for (int bj = 0; bj < 2; ++bj) { float t[8];
#pragma unroll
                    for (int n = 0; n < 2; ++n)
#pragma unroll
                        for (int j = 0; j < 4; ++j) t[n * 4 + j] = acc[ai][bj][m][n][j];
                    store8(rp + 32 * bj, t); }
            }
    }
};
template <bool GATED> struct EpiRes {
    static constexpr bool PERM = false, AFTER_DRAIN = true;
    const bf16_t* hin; bf16_t* hout; float* fout; unsigned char* ws; int par_out;
    struct Pre { u32x4 hv[2]; u32x4 pp[2]; float rs; };
    __device__ __forceinline__ void load(Pre& p, const Unit& u, int g8, int wr, int wc, int fr, int fq) const {
        const int ai = g8 >> 2, m = g8 & 3, row = u.pm * BM + ai * HALF + wr * 64 + m * 16 + fr, cb = u.pn * BM + wc * 64 + 8 * fq;
#pragma unroll
        for (int bj = 0; bj < 2; ++bj) p.hv[bj] = *(const u32x4*)(hin + (size_t)row * DM + cb + 32 * bj);
        if (GATED) { const bf16_t* PP = (const bf16_t*)(ws + WS_PPROJ);
#pragma unroll
            for (int bj = 0; bj < 2; ++bj) p.pp[bj] = *(const u32x4*)(PP + (size_t)row * DM + cb + 32 * bj);
            const float* sq = (const float*)(ws + (par_out ? TAB_SSQ0 : TAB_SSQ1));
            p.rs = (sq[row] + sq[NTOK + row]) + (sq[2 * NTOK + row] + sq[3 * NTOK + row]); }
    }
    __device__ __forceinline__ void fused(f32x4 (&acc)[2][2][4][2], const Unit& u, int wr, int wc, int fr, int fq, PG8_LAS unsigned char* lds, int wid, int lane) const {
        float* ssq_out = (float*)(ws + (par_out ? TAB_SSQ1 : TAB_SSQ0));
        PG8_LAS float* P = (PG8_LAS float*)lds;
        const int cb = u.pn * BM + wc * 64 + 8 * fq;
        Pre pa, pb;
        load(pa, u, 0, wr, wc, fr, fq);
#pragma unroll
        for (int g8 = 0; g8 < 8; ++g8) {
            Pre& cur = (g8 & 1) ? pb : pa; Pre& nxt = (g8 & 1) ? pa : pb;
            if (g8 + 1 < 8) load(nxt, u, g8 + 1, wr, wc, fr, fq);
            const int ai = g8 >> 2, m = g8 & 3, rl = ai * HALF + wr * 64 + m * 16 + fr, row = u.pm * BM + rl;
            float rs = 1.f; if (GATED) rs = __builtin_amdgcn_rsqf(cur.rs * (1.0f / 1024.0f) + 1e-6f);
            float ss = 0.f;
#pragma unroll
            for (int bj = 0; bj < 2; ++bj) {
                const u32x4 hw = cur.hv[bj];
                f32x4 o0 = (f32x4){bf_lo(hw.x), bf_hi(hw.x), bf_lo(hw.y), bf_hi(hw.y)}, o1 = (f32x4){bf_lo(hw.z), bf_hi(hw.z), bf_lo(hw.w), bf_hi(hw.w)};
                f32x4 a0 = acc[ai][bj][m][0], a1 = acc[ai][bj][m][1];
                if (GATED) { const u32x4 pw = cur.pp[bj];
                    a0[0] = sigmoid_fast(a0[0] * rs) * bf_lo(pw.x); a0[1] = sigmoid_fast(a0[1] * rs) * bf_hi(pw.x);
                    a0[2] = sigmoid_fast(a0[2] * rs) * bf_lo(pw.y); a0[3] = sigmoid_fast(a0[3] * rs) * bf_hi(pw.y);
                    a1[0] = sigmoid_fast(a1[0] * rs) * bf_lo(pw.z); a1[1] = sigmoid_fast(a1[1] * rs) * bf_hi(pw.z);
                    a1[2] = sigmoid_fast(a1[2] * rs) * bf_lo(pw.w); a1[3] = sigmoid_fast(a1[3] * rs) * bf_hi(pw.w); }
                o0 += a0; o1 += a1;
                ss += (o0[0] * o0[0] + o0[1] * o0[1]) + (o0[2] * o0[2] + o0[3] * o0[3]) + (o1[0] * o1[0] + o1[1] * o1[1]) + (o1[2] * o1[2] + o1[3] * o1[3]);
                if (fout) { float* fp = fout + (size_t)row * DM + cb + 32 * bj; *(f32x4*)fp = o0; *(f32x4*)(fp + 4) = o1; }
                else { float t[8] = {o0[0], o0[1], o0[2], o0[3], o1[0], o1[1], o1[2], o1[3]}; store8(hout + (size_t)row * DM + cb + 32 * bj, t); }
            }
            ss = add_xor16(ss); ss = add_xor32(ss);
            if (fq == 0) P[rl * 4 + wc] = ss;
        }
        asm volatile("s_waitcnt lgkmcnt(0)" ::: "memory"); __builtin_amdgcn_s_barrier(); asm volatile("" ::: "memory");
        const int tid = wid * 64 + lane;
        if (tid < 256) ssq_out[u.pn * NTOK + u.pm * BM + tid] = (P[tid * 4] + P[tid * 4 + 1]) + (P[tid * 4 + 2] + P[tid * 4 + 3]);
        asm volatile("s_waitcnt lgkmcnt(0)" ::: "memory"); __builtin_amdgcn_s_barrier(); asm volatile("" ::: "memory");
    }
};
struct EpiNull {
    static constexpr bool PERM = false, AFTER_DRAIN = true;
    __device__ __forceinline__ void fused(f32x4 (&acc)[2][2][4][2], const Unit& u, int wr, int wc, int fr, int fq, PG8_LAS unsigned char* lds, int wid, int lane) const {
#pragma unroll
        for (int a = 0; a < 2; ++a)
#pragma unroll
            for (int b = 0; b < 2; ++b)
#pragma unroll
                for (int m = 0; m < 4; ++m)
#pragma unroll
                    for (int n = 0; n < 2; ++n) asm volatile("" :: "v"(acc[a][b][m][n]));
    }
};
}
typedef unsigned short bf16;
#define LAS __attribute__((address_space(3)))
typedef unsigned v4u __attribute__((ext_vector_type(4)));
typedef unsigned v2u __attribute__((ext_vector_type(2)));
typedef float f32x4 __attribute__((ext_vector_type(4)));
typedef short bf16x8 __attribute__((ext_vector_type(8)));
typedef short s16x4 __attribute__((ext_vector_type(4)));
constexpr int NWAVES = 8;
__device__ __forceinline__ float max_xor16(float v) { return fmaxf(v, xor_lane<16>(v)); }
__device__ __forceinline__ float max_xor32(float v) { auto r = __builtin_amdgcn_permlane32_swap(__float_as_uint(v), __float_as_uint(v), false, false); return fmaxf(__uint_as_float(r[0]), __uint_as_float(r[1])); }
__device__ __forceinline__ bf16x8 tr_frag(LAS const unsigned char* p, LAS const unsigned char* p2) {
    const s16x4 lo = __builtin_bit_cast(s16x4, __builtin_amdgcn_ds_read_tr16_b64_v4i16((LAS s16x4*)p));
    const s16x4 hi = __builtin_bit_cast(s16x4, __builtin_amdgcn_ds_read_tr16_b64_v4i16((LAS s16x4*)p2));
    return (bf16x8){lo[0], lo[1], lo[2], lo[3], hi[0], hi[1], hi[2], hi[3]};
}
#define WG_BARRIER() do { asm volatile("s_waitcnt vmcnt(0) lgkmcnt(0)" ::: "memory"); __builtin_amdgcn_s_barrier(); asm volatile("" ::: "memory"); } while (0)

constexpr int GM_ROWB = 528;
constexpr int GM_SS = 128 * GM_ROWB;
__device__ __forceinline__ void gmlp_item(unsigned char* ws, int L, LAS unsigned char* lds, int item, int wv, int lane_unused) {
    const int lane = fresh_lane();
    const int tok0 = item * 128, tid = wv * 64 + lane;
    const bf16* VLN = (const bf16*)(ws + WS_VLN); const bf16* U = (const bf16*)(ws + WS_U); bf16* YC = (bf16*)(ws + WS_YCAT);
    const bf16* GW = (const bf16*)(ws + TAB_GW) + (size_t)L * 4 * 128 * 128;
    const float* bsv = (const float*)(ws + TAB_SMALL) + L * SM_STRIDE + SM_GBS;
    { v4u xs[8];
#pragma unroll
      for (int i = 0; i < 8; ++i) { const int q = tid + i * 512, s = q >> 5, c = q & 31; xs[i] = *(const v4u*)(VLN + (size_t)(tok0 + s) * 256 + c * 8); }
#pragma unroll
      for (int i = 0; i < 8; ++i) { const int q = tid + i * 512, s = q >> 5, c = q & 31; *(LAS v4u*)(lds + s * GM_ROWB + c * 16) = xs[i]; } }
    const int h = wv >> 1, th = wv & 1, fr = lane & 15, g4 = lane >> 4;
    bf16x8 wfa[4][4];
#pragma unroll
    for (int m = 0; m < 4; ++m)
#pragma unroll
        for (int ks = 0; ks < 4; ++ks) if (32 * ks <= 64 * th + 16 * m + 15) wfa[m][ks] = *(const bf16x8*)(GW + ((size_t)h * 128 + 64 * th + 16 * m + fr) * 128 + 32 * ks + 8 * g4);
    WG_BARRIER();
    f32x4 acc[4][4];
#pragma unroll
    for (int m = 0; m < 4; ++m)
#pragma unroll
        for (int n = 0; n < 4; ++n) acc[m][n] = (f32x4){0.f, 0.f, 0.f, 0.f};
    v2u uwa[4][4];
#pragma unroll
    for (int m = 0; m < 4; ++m)
#pragma unroll
        for (int n = 0; n < 4; ++n) uwa[m][n] = *(const v2u*)(U + (size_t)(tok0 + 64 * th + 16 * m + fr) * 256 + h * 64 + 16 * n + 4 * g4);
#pragma unroll
    for (int m = 0; m < 4; ++m) {
#pragma unroll
        for (int ks = 0; ks < 4; ++ks) {
            if (32 * ks <= 64 * th + 16 * m + 15) {
#pragma unroll
                for (int n = 0; n < 4; ++n) {
                    LAS const unsigned char* p = lds + (32 * ks + 8 * g4 + (fr >> 2)) * GM_ROWB + (h * 64 + 16 * n + 4 * (fr & 3)) * 2;
                    const bf16x8 vf = tr_frag(p, p + 4 * GM_ROWB);
                    acc[m][n] = __builtin_amdgcn_mfma_f32_16x16x32_bf16(vf, wfa[m][ks], acc[m][n], 0, 0, 0);
                }
            }
        }
    }
    LAS float* SS = (LAS float*)(lds + GM_SS);
#pragma unroll
    for (int m = 0; m < 4; ++m) {
        const int t = 64 * th + 16 * m + fr; const float bb = bsv[h * 128 + t]; float ss = 0.f;
#pragma unroll
        for (int n = 0; n < 4; ++n) {
            const v2u uw = uwa[m][n];
            f32x4 y; y[0] = bf_lo(uw.x) * (acc[m][n][0] + bb); y[1] = bf_hi(uw.x) * (acc[m][n][1] + bb); y[2] = bf_lo(uw.y) * (acc[m][n][2] + bb); y[3] = bf_hi(uw.y) * (acc[m][n][3] + bb);
            acc[m][n] = y; ss += (y[0] * y[0] + y[1] * y[1]) + (y[2] * y[2] + y[3] * y[3]);
        }
        ss = add_xor16(ss); ss = add_xor32(ss);
        if (g4 == 0) SS[h * 128 + t] = ss;
    }
    WG_BARRIER();
#pragma unroll
    for (int m = 0; m < 4; ++m) {
        const int t = 64 * th + 16 * m + fr;
        const float tot = (SS[t] + SS[128 + t]) + (SS[256 + t] + SS[384 + t]);
        const float r = __builtin_amdgcn_rsqf(tot * (1.0f / 256.0f) + 1e-6f);
#pragma unroll
        for (int n = 0; n < 4; ++n) { v2u o; o.x = pk2(acc[m][n][0] * r, acc[m][n][1] * r); o.y = pk2(acc[m][n][2] * r, acc[m][n][3] * r);
            *(v2u*)(YC + (size_t)(tok0 + t) * DM + h * 64 + 16 * n + 4 * g4) = o; }
    }
    WG_BARRIER();
}

constexpr int AT_ROWB = 272;
constexpr int AT_V = 192 * AT_ROWB, AT_SS = 2 * 192 * AT_ROWB;
__device__ __forceinline__ void attn_item(unsigned char* ws, int L, LAS unsigned char* lds, int item, int wv, int lane_unused) {
    const int lane = fresh_lane();
    const int b = item >> 7, q0 = (item & 127) * 64, tokb = b * SEQL, tid = wv * 64 + lane;
    const bf16* Q = (const bf16*)(ws + WS_Q); const bf16* K = (const bf16*)(ws + WS_K); const bf16* V = (const bf16*)(ws + WS_V); bf16* YC = (bf16*)(ws + WS_YCAT);
    { v4u kx[6], vx[6];
#pragma unroll
      for (int i = 0; i < 6; ++i) { const int q = tid + i * 512, r = q >> 4, c = q & 15, j = q0 - 128 + r; kx[i] = (v4u){0u, 0u, 0u, 0u}; vx[i] = kx[i];
          if (j >= 0) { kx[i] = *(const v4u*)(K + (size_t)(tokb + j) * 128 + c * 8); vx[i] = *(const v4u*)(V + (size_t)(tokb + j) * 128 + c * 8); } }
#pragma unroll
      for (int i = 0; i < 6; ++i) { const int q = tid + i * 512, r = q >> 4, c = q & 15; *(LAS v4u*)(lds + r * AT_ROWB + c * 16) = kx[i]; *(LAS v4u*)(lds + AT_V + r * AT_ROWB + c * 16) = vx[i]; } }
    const int hq = wv, hkv = wv >> 2, fr = lane & 15, g4 = lane >> 4;
    bf16x8 qfa[4][2];
#pragma unroll
    for (int qt = 0; qt < 4; ++qt)
#pragma unroll
        for (int ks = 0; ks < 2; ++ks) qfa[qt][ks] = *(const bf16x8*)(Q + (size_t)(tokb + q0 + 16 * qt + fr) * 512 + hq * 64 + 32 * ks + 8 * g4);
    WG_BARRIER();
    const float sink2 = ((const float*)(ws + TAB_SMALL))[L * SM_STRIDE + SM_SINK + hq] * LOG2E;
    LAS float* SS = (LAS float*)(lds + AT_SS);
#pragma unroll
    for (int qt = 0; qt < 4; ++qt) {
        const size_t tq = (size_t)(tokb + q0 + 16 * qt + fr);
        const bf16x8 qf[2] = {qfa[qt][0], qfa[qt][1]};
        f32x4 s[12];
#pragma unroll
        for (int kt = 0; kt < 12; ++kt) { s[kt] = (f32x4){0.f, 0.f, 0.f, 0.f};
#pragma unroll
            for (int ks = 0; ks < 2; ++ks) { const bf16x8 kf = *(LAS const bf16x8*)(lds + (16 * kt + fr) * AT_ROWB + (hkv * 64 + 32 * ks + 8 * g4) * 2);
                s[kt] = __builtin_amdgcn_mfma_f32_16x16x32_bf16(kf, qf[ks], s[kt], 0, 0, 0); } }
        const int diff0 = 128 + 16 * qt + fr - 4 * g4, j0 = q0 - 128 + 4 * g4;
        float mx = -INFINITY;
#pragma unroll
        for (int kt = 0; kt < 12; ++kt)
#pragma unroll
            for (int r = 0; r < 4; ++r) { const int diff = diff0 - 16 * kt - r; const bool ok = (diff >= 0) && (diff < 128) && (j0 + 16 * kt + r >= 0);
                s[kt][r] = ok ? s[kt][r] : -INFINITY; mx = fmaxf(mx, s[kt][r]); }
        mx = max_xor16(mx); mx = max_xor32(mx); mx = fmaxf(mx, sink2);
        float sum = 0.f;
#pragma unroll
        for (int kt = 0; kt < 12; ++kt)
#pragma unroll
            for (int r = 0; r < 4; ++r) { s[kt][r] = __builtin_amdgcn_exp2f(s[kt][r] - mx); sum += s[kt][r]; }
        sum = add_xor16(sum); sum = add_xor32(sum); sum += __builtin_amdgcn_exp2f(sink2 - mx);
        const float inv_l = __builtin_amdgcn_rcpf(sum);
        f32x4 o[4];
#pragma unroll
        for (int dt = 0; dt < 4; ++dt) o[dt] = (f32x4){0.f, 0.f, 0.f, 0.f};
#pragma unroll
        for (int kk = 0; kk < 6; ++kk) {
            v4u pw; pw.x = pk2(s[2 * kk][0], s[2 * kk][1]); pw.y = pk2(s[2 * kk][2], s[2 * kk][3]); pw.z = pk2(s[2 * kk + 1][0], s[2 * kk + 1][1]); pw.w = pk2(s[2 * kk + 1][2], s[2 * kk + 1][3]);
            const bf16x8 pf = __builtin_bit_cast(bf16x8, pw);
#pragma unroll
            for (int dt = 0; dt < 4; ++dt) {
                LAS const unsigned char* p = lds + AT_V + (32 * kk + 4 * g4 + (fr >> 2)) * AT_ROWB + (hkv * 64 + 16 * dt + 4 * (fr & 3)) * 2;
                const bf16x8 vf = tr_frag(p, p + 16 * AT_ROWB);
                o[dt] = __builtin_amdgcn_mfma_f32_16x16x32_bf16(vf, pf, o[dt], 0, 0, 0);
            }
        }
        float ss = 0.f;
#pragma unroll
        for (int dt = 0; dt < 4; ++dt) { o[dt] = o[dt] * inv_l; ss += (o[dt][0] * o[dt][0] + o[dt][1] * o[dt][1]) + (o[dt][2] * o[dt][2] + o[dt][3] * o[dt][3]); }
        ss = add_xor16(ss); ss = add_xor32(ss);
        if (g4 == 0) SS[hq * 64 + 16 * qt + fr] = ss;
        WG_BARRIER();
        float tot = 0.f;
#pragma unroll
        for (int hh = 0; hh < 8; ++hh) tot += SS[hh * 64 + 16 * qt + fr];
        const float r = __builtin_amdgcn_rsqf(tot * (1.0f / 512.0f) + 1e-6f);
#pragma unroll
        for (int dt = 0; dt < 4; ++dt) { v2u ow; ow.x = pk2(o[dt][0] * r, o[dt][1] * r); ow.y = pk2(o[dt][2] * r, o[dt][3] * r);
            *(v2u*)(YC + tq * DM + 256 + hq * 64 + 16 * dt + 4 * g4) = ow; }
    }
    WG_BARRIER();
}
__device__ __forceinline__ double d_exp(double x) {
    const double k = __builtin_rint(x * 1.4426950408889634), r = x - k * 0.6931471805599453;
    double e = 1.0, term = 1.0;
    for (int n = 1; n <= 20; ++n) { term *= r / (double)n; e += term; }
    const long long bits = (long long)(1023 + (int)k) << 52;
    return e * __builtin_bit_cast(double, bits);
}
__device__ __forceinline__ void d_sincos(double th, double& sn, double& cs) {
    const double q = __builtin_rint(th * 0.15915494309189535), r = th - q * 6.283185307179586, r2 = -r * r;
    double s = r, c = 1.0, ts = r, tc = 1.0;
    for (int n = 1; n <= 14; ++n) { tc *= r2 / (double)((2 * n - 1) * (2 * n)); c += tc; ts *= r2 / (double)((2 * n) * (2 * n + 1)); s += ts; }
    sn = s; cs = c;
}
__device__ __forceinline__ void ssm_tables(const float* const* in, unsigned char* ws, int gtid, int nthreads) {
    for (int i = gtid; i < NLAYER * 16 * 64; i += nthreads) {
        const int p = i & 63, lg = i >> 6;
        const double lre = in[12][i], lim = in[13][i], dt = d_exp((double)in[14][lg]);
        const double er = d_exp(lre * dt); double sn, cs; d_sincos(lim * dt, sn, cs);
        const double lbr = er * cs, lbi = er * sn;
        const double nr = lbr - 1.0, ni = lbi, den = lre * lre + lim * lim;
        const double fr_ = (nr * lre + ni * lim) / den, fi_ = (ni * lre - nr * lim) / den;
        float* bbc = (float*)(ws + SSM_BBC) + (size_t)i * 32; bf16* bbt = (bf16*)(ws + SSM_BBT) + (size_t)lg * 128 * 16;
        for (int h = 0; h < 16; ++h) { const double br = in[15][i * 16 + h], bi = in[16][i * 16 + h]; const float re = (float)(fr_ * br - fi_ * bi), im = (float)(fr_ * bi + fi_ * br);
            bbc[2 * h] = re; bbc[2 * h + 1] = im; bbt[p * 16 + h] = (bf16)(pk2(re, 0.f) & 0xffffu); bbt[(64 + p) * 16 + h] = (bf16)(pk2(im, 0.f) & 0xffffu); }
        bf16* cct = (bf16*)(ws + SSM_CCT) + (size_t)lg * 16 * 128;
        for (int hp = 0; hp < 16; ++hp) { const float cre = in[17][(lg * 16 + hp) * 64 + p], cim = in[18][(lg * 16 + hp) * 64 + p]; *(unsigned*)(cct + hp * 128 + 2 * p) = pk2(cre, -cim); }
        float* pw = (float*)(ws + SSM_PW) + (size_t)lg * 65 * 128;
        double xr = 1.0, xi = 0.0;
        float* w1 = (float*)(ws + SSM_W1) + (size_t)lg * 8192;
        for (int n = 0; n <= 64; ++n) { pw[(n * 64 + p) * 2] = (float)xr; pw[(n * 64 + p) * 2 + 1] = (float)xi;
            if (n < 64) { const int t = 63 - n, ln = ((t >> 2) & 3) * 16 + (p & 15), o = ((ln * 16 + (t >> 4) * 4 + (t & 3)) * 4 + (p >> 4)) * 2; w1[o] = (float)xr; w1[o + 1] = (float)xi; }
            const double t = xr * lbr - xi * lbi; xi = xr * lbi + xi * lbr; xr = t; }
    }
}
__device__ __forceinline__ void ssm_ktable(const float* const* in, unsigned char* ws, int gtid, int nthreads) {
    bf16* KT = (bf16*)(ws + SSM_KT);
    for (int i = gtid; i < NLAYER * 16 * 64 * 256; i += nthreads) {
        const int h = i & 15, hp = (i >> 4) & 15, tau = (i >> 8) & 63, lg = i >> 14;
        const float* pw = (const float*)(ws + SSM_PW) + ((size_t)lg * 65 + tau) * 128; const float* bbc = (const float*)(ws + SSM_BBC) + (size_t)lg * 64 * 32 + 2 * h;
        const float* cre = in[17] + (size_t)(lg * 16 + hp) * 64; const float* cim = in[18] + (size_t)(lg * 16 + hp) * 64;
        float acc = 0.f;
        for (int p = 0; p < 64; ++p) { const float zr = pw[2 * p], zi = pw[2 * p + 1], br = bbc[p * 32], bi = bbc[p * 32 + 1];
            acc += cre[p] * (zr * br - zi * bi) - cim[p] * (zr * bi + zi * br); }
        if (tau == 0 && h == hp) acc += in[19][lg * 16 + hp];
        KT[i] = (bf16)(pk2(acc, 0.f) & 0xffffu);
    }
}
__device__ __forceinline__ void ssm1_item(unsigned char* ws, int L, int item, int wv, int lane_unused) {
    const int tok0 = item * 64;
    const bf16* ZC = (const bf16*)(ws + WS_ZC); float* S = (float*)(ws + SSM_S);
    const bf16x8 zero8 = (bf16x8){0, 0, 0, 0, 0, 0, 0, 0};
    for (int gi = 0; gi < 2; ++gi) {
        const int g = 2 * wv + gi, lg = L * 16 + g;
        const int lane = fresh_lane(), fr = lane & 15, g4 = lane >> 4;
        const bf16* bbt = (const bf16*)(ws + SSM_BBT) + (size_t)lg * 128 * 16; const float* pw = (const float*)(ws + SSM_PW) + (size_t)lg * 65 * 128;
        bf16x8 bfr[8];
#pragma unroll
        for (int n = 0; n < 8; ++n) bfr[n] = (g4 < 2) ? *(const bf16x8*)(bbt + (16 * n + fr) * 16 + 8 * g4) : zero8;
        bf16x8 uf[4];
#pragma unroll
        for (int m = 0; m < 4; ++m) uf[m] = (g4 < 2) ? *(const bf16x8*)(ZC + (size_t)(tok0 + 16 * m + fr) * 256 + g * 16 + 8 * g4) : zero8;
        f32x2_t l1[4], l16[4], lg4[4];
#pragma unroll
        for (int q = 0; q < 4; ++q) { l1[q] = *(const f32x2_t*)(pw + (1 * 64 + 16 * q + fr) * 2); l16[q] = *(const f32x2_t*)(pw + (16 * 64 + 16 * q + fr) * 2); lg4[q] = *(const f32x2_t*)(pw + ((12 - 4 * g4) * 64 + 16 * q + fr) * 2); }
        float sre[4] = {0.f, 0.f, 0.f, 0.f}, sim[4] = {0.f, 0.f, 0.f, 0.f};
#pragma unroll
        for (int m = 0; m < 4; ++m) {
            f32x4 d[8];
#pragma unroll
            for (int n = 0; n < 8; ++n) d[n] = __builtin_amdgcn_mfma_f32_16x16x32_bf16(uf[m], bfr[n], (f32x4){0.f, 0.f, 0.f, 0.f}, 0, 0, 0);
#pragma unroll
            for (int q = 0; q < 4; ++q) {
                float ir = d[q][0], ii = d[q + 4][0];
#pragma unroll
                for (int r = 1; r < 4; ++r) { const float t = l1[q][0] * ir - l1[q][1] * ii + d[q][r]; ii = l1[q][0] * ii + l1[q][1] * ir + d[q + 4][r]; ir = t; }
                const float t = l16[q][0] * sre[q] - l16[q][1] * sim[q] + ir; sim[q] = l16[q][0] * sim[q] + l16[q][1] * sre[q] + ii; sre[q] = t;
            }
        }
#pragma unroll
        for (int q = 0; q < 4; ++q) { const float t = lg4[q][0] * sre[q] - lg4[q][1] * sim[q]; sim[q] = lg4[q][0] * sim[q] + lg4[q][1] * sre[q]; sre[q] = t; }
#pragma unroll
        for (int q = 0; q < 4; ++q) { sre[q] = add_xor16(sre[q]); sre[q] = add_xor32(sre[q]); sim[q] = add_xor16(sim[q]); sim[q] = add_xor32(sim[q]);
            if (g4 == 0) *(f32x2_t*)(S + ((size_t)(item * 16 + g) * 64 + 16 * q + fr) * 2) = (f32x2_t){sre[q], sim[q]}; }
    }
}
__device__ __forceinline__ void ssm_scan(unsigned char* ws, int L, LAS unsigned char* lds, int bg, int wv) {
    const int lane = fresh_lane(), b = bg >> 4, g = bg & 15;
    const f32x2_t lam = *(const f32x2_t*)((const float*)(ws + SSM_PW) + ((size_t)(L * 16 + g) * 65 + 64) * 128 + 2 * lane);
    float* sp = (float*)(ws + SSM_S) + (((size_t)(b * 128 + 16 * wv) * 16 + g) * 64 + lane) * 2;
    f32x2_t sv[16];
#pragma unroll
    for (int j = 0; j < 16; ++j) sv[j] = *(const f32x2_t*)(sp + (size_t)j * 2048);
    float pr[16], pi[16]; float xr = 0.f, xi = 0.f, wr = 1.f, wi = 0.f;
#pragma unroll
    for (int j = 0; j < 16; ++j) { pr[j] = xr; pi[j] = xi; const float t = lam[0] * xr - lam[1] * xi + sv[j][0]; xi = lam[0] * xi + lam[1] * xr + sv[j][1]; xr = t;
        const float tw = wr * lam[0] - wi * lam[1]; wi = wr * lam[1] + wi * lam[0]; wr = tw; }
    LAS f32x2_t* E = (LAS f32x2_t*)lds;
    E[wv * 64 + lane] = (f32x2_t){xr, xi};
    WG_BARRIER();
    float br = 0.f, bi = 0.f;
    for (int w2 = 0; w2 < wv; ++w2) { const f32x2_t e = E[w2 * 64 + lane]; const float t = wr * br - wi * bi + e[0]; bi = wr * bi + wi * br + e[1]; br = t; }
    float qr = 1.f, qi = 0.f;
#pragma unroll
    for (int j = 0; j < 16; ++j) { *(f32x2_t*)(sp + (size_t)j * 2048) = (f32x2_t){qr * br - qi * bi + pr[j], qr * bi + qi * br + pi[j]};
        const float tq = qr * lam[0] - qi * lam[1]; qi = qr * lam[1] + qi * lam[0]; qr = tq; }
    WG_BARRIER();
}
constexpr int S2_ROWB = 528, S2_XIN = 80 * S2_ROWB, S2_YT = S2_XIN + 8192, S2_SS = S2_YT + 64 * S2_ROWB;
__device__ __forceinline__ void ssm2_item(unsigned char* ws, int L, LAS unsigned char* lds, int item, int wv, int lane_unused) {
    const int lane = fresh_lane();
    const int tok0 = item * 64, b = item >> 7, c = item & 127, tid = wv * 64 + lane, fr = lane & 15, g4 = lane >> 4;
    const bf16* ZC = (const bf16*)(ws + WS_ZC); const float* S = (const float*)(ws + SSM_S);
    { v4u xs[5];
#pragma unroll
      for (int i = 0; i < 5; ++i) { const int q = tid + i * 512, r = q >> 5, cc = q & 31; xs[i] = (v4u){0u, 0u, 0u, 0u}; if (r >= 16) xs[i] = *(const v4u*)(ZC + (size_t)(tok0 + r - 16) * 256 + cc * 8); }
#pragma unroll
      for (int i = 0; i < 5; ++i) { const int q = tid + i * 512, r = q >> 5, cc = q & 31; *(LAS v4u*)(lds + r * S2_ROWB + cc * 16) = xs[i]; } }
#pragma unroll
    for (int k = 0; k < 2; ++k) { const int ch = tid + 512 * k; *(LAS f32x2_t*)(lds + S2_XIN + ch * 8) = *(const f32x2_t*)(S + ((size_t)item * 1024 + ch) * 2); }
    WG_BARRIER();
    for (int gi = 0; gi < 2; ++gi) {
        const int g = 2 * wv + gi, lg = L * 16 + g;
        int fr, g4; { const int l2 = fresh_lane(); fr = l2 & 15; g4 = l2 >> 4; }
        const bf16* kt = (const bf16*)(ws + SSM_KT) + (size_t)lg * 64 * 256 + fr * 16 + 8 * (g4 & 1);
        LAS const unsigned char* ub = lds + (16 + fr - (g4 >> 1)) * S2_ROWB + (g * 16 + 8 * (g4 & 1)) * 2;
        f32x4 acc[4];
#pragma unroll
        for (int m = 0; m < 4; ++m) acc[m] = (f32x4){0.f, 0.f, 0.f, 0.f};
        bf16x8 kfa[32];
#pragma unroll
        for (int lp = 0; lp < 32; ++lp) kfa[lp] = *(const bf16x8*)(kt + (2 * lp + (g4 >> 1)) * 256);
#pragma unroll
        for (int seg = 0; seg < 4; ++seg)
#pragma unroll
            for (int lp = 8 * seg; lp < 8 * seg + 8; ++lp) {
#pragma unroll
                for (int m = seg; m < 4; ++m) { const bf16x8 uf = *(LAS const bf16x8*)(ub + (16 * m - 2 * lp) * S2_ROWB); acc[m] = __builtin_amdgcn_mfma_f32_16x16x32_bf16(uf, kfa[lp], acc[m], 0, 0, 0); }
            }
        { const int l2 = fresh_lane(); fr = l2 & 15; g4 = l2 >> 4; }
        const bf16* cct = (const bf16*)(ws + SSM_CCT) + (size_t)lg * 16 * 128 + fr * 128 + 8 * g4;
        const float* pwg = (const float*)(ws + SSM_PW) + (size_t)lg * 65 * 128;
#pragma unroll
        for (int ks = 0; ks < 4; ++ks) {
            const bf16x8 cf = *(const bf16x8*)(cct + 32 * ks);
            const int p4 = 16 * ks + 4 * g4;
            const f32x4 x01 = *(LAS const f32x4*)(lds + S2_XIN + (g * 64 + p4) * 8), x23 = *(LAS const f32x4*)(lds + S2_XIN + (g * 64 + p4) * 8 + 16);
#pragma unroll
            for (int m = 0; m < 4; ++m) {
                const float* w = pwg + ((size_t)(16 * m + fr + 1) * 64 + p4) * 2;
                const f32x4 w01 = *(const f32x4*)w, w23 = *(const f32x4*)(w + 4);
                v4u zw; zw.x = pk2(w01[0] * x01[0] - w01[1] * x01[1], w01[0] * x01[1] + w01[1] * x01[0]); zw.y = pk2(w01[2] * x01[2] - w01[3] * x01[3], w01[2] * x01[3] + w01[3] * x01[2]);
                zw.z = pk2(w23[0] * x23[0] - w23[1] * x23[1], w23[0] * x23[1] + w23[1] * x23[0]); zw.w = pk2(w23[2] * x23[2] - w23[3] * x23[3], w23[2] * x23[3] + w23[3] * x23[2]);
                acc[m] = __builtin_amdgcn_mfma_f32_16x16x32_bf16(__builtin_bit_cast(bf16x8, zw), cf, acc[m], 0, 0, 0);
            }
        }
#pragma unroll
        for (int m = 0; m < 4; ++m)
#pragma unroll
            for (int r = 0; r < 4; ++r) *(LAS bf16*)(lds + S2_YT + (16 * m + 4 * g4 + r) * S2_ROWB + (g * 16 + fr) * 2) = (bf16)(pk2(gelu_fast(acc[m][r]), 0.f) & 0xffffu);
    }
    WG_BARRIER();
    {
        const int l2 = fresh_lane(), fr = l2 & 15, g4 = l2 >> 4;
        const bf16* wg = (const bf16*)(ws + WS_W + (size_t)L * LW_STRIDE + LW_GLU) + (size_t)(32 * wv + fr) * 256 + 8 * g4;
        LAS const unsigned char* yb = lds + S2_YT + fr * S2_ROWB + 16 * g4;
        f32x4 ga[2][4], gb[2][4];
#pragma unroll
        for (int nt = 0; nt < 2; ++nt)
#pragma unroll
            for (int m = 0; m < 4; ++m) { ga[nt][m] = (f32x4){0.f, 0.f, 0.f, 0.f}; gb[nt][m] = (f32x4){0.f, 0.f, 0.f, 0.f}; }
#pragma unroll
        for (int kh = 0; kh < 2; ++kh) {
            bf16x8 wa[4][2], wb[4][2];
#pragma unroll
            for (int k4 = 0; k4 < 4; ++k4)
#pragma unroll
                for (int nt = 0; nt < 2; ++nt) { wa[k4][nt] = *(const bf16x8*)(wg + (size_t)(16 * nt) * 256 + 32 * (4 * kh + k4)); wb[k4][nt] = *(const bf16x8*)(wg + (size_t)(256 + 16 * nt) * 256 + 32 * (4 * kh + k4)); }
#pragma unroll
            for (int k4 = 0; k4 < 4; ++k4) {
                bf16x8 yf[4];
#pragma unroll
                for (int m = 0; m < 4; ++m) yf[m] = *(LAS const bf16x8*)(yb + 16 * m * S2_ROWB + 64 * (4 * kh + k4));
#pragma unroll
                for (int nt = 0; nt < 2; ++nt)
#pragma unroll
                    for (int m = 0; m < 4; ++m) { ga[nt][m] = __builtin_amdgcn_mfma_f32_16x16x32_bf16(wa[k4][nt], yf[m], ga[nt][m], 0, 0, 0); gb[nt][m] = __builtin_amdgcn_mfma_f32_16x16x32_bf16(wb[k4][nt], yf[m], gb[nt][m], 0, 0, 0); }
            }
        }
        LAS float* SS = (LAS float*)(lds + S2_SS);
#pragma unroll
        for (int m = 0; m < 4; ++m) { float ss = 0.f;
#pragma unroll
            for (int nt = 0; nt < 2; ++nt)
#pragma unroll
                for (int r = 0; r < 4; ++r) { const float v = ga[nt][m][r] * sigmoid_fast(gb[nt][m][r]); ga[nt][m][r] = v; ss += v * v; }
            ss = add_xor16(ss); ss = add_xor32(ss);
            if (g4 == 0) SS[wv * 64 + 16 * m + fr] = ss; }
        WG_BARRIER();
        bf16* YC = (bf16*)(ws + WS_YCAT);
#pragma unroll
        for (int m = 0; m < 4; ++m) { float tot = 0.f;
#pragma unroll
            for (int w8 = 0; w8 < 8; ++w8) tot += SS[w8 * 64 + 16 * m + fr];
            const float rr = __builtin_amdgcn_rsqf(tot * (1.0f / 256.0f) + 1e-6f);
#pragma unroll
            for (int nt = 0; nt < 2; ++nt) { v2u o; o.x = pk2(ga[nt][m][0] * rr, ga[nt][m][1] * rr); o.y = pk2(ga[nt][m][2] * rr, ga[nt][m][3] * rr);
                *(v2u*)(YC + (size_t)(tok0 + 16 * m + fr) * DM + 768 + 32 * wv + 16 * nt + 4 * g4) = o; } }
    }
    WG_BARRIER();
}
#define XB_TMO      128
#define XB_XCNT(j)  (256  + 64 * (j))
#define XB_XSUB(j)  (1280 + 64 * (j))
#define XB_XGEN(j)  (2304 + 64 * (j))
#define XB_TOP      3328
#define XB_TOPGEN   3392
#define XCD_BAR_WORDS 3456
#define XB_SPIN_CAP (1u << 18)

__device__ __forceinline__ unsigned xb_ld(unsigned* p)              { return __hip_atomic_load(p, __ATOMIC_RELAXED, __HIP_MEMORY_SCOPE_AGENT); }
__device__ __forceinline__ unsigned xb_add(unsigned* p, unsigned v) { return __hip_atomic_fetch_add(p, v, __ATOMIC_RELAXED, __HIP_MEMORY_SCOPE_AGENT); }
__device__ __forceinline__ unsigned xb_xcc_id() { return (unsigned)__builtin_amdgcn_s_getreg((3 << 11) | 20) & 0xFu; }
#define XB_SPIN(cond, bar) do { unsigned _sp = 0; while (cond) { __builtin_amdgcn_s_sleep(1); \
    if ((++_sp & 255u) == 0u) { if (xb_ld(&(bar)[XB_TMO])) break; if (_sp > XB_SPIN_CAP) { atomicAdd(&(bar)[XB_TMO], 1u); break; } } } } while (0)

struct XcdBarrier {
    unsigned* bar; unsigned x;
    volatile LAS unsigned* st;
};

__device__ __forceinline__ XcdBarrier xcd_barrier_post(unsigned* bar, volatile LAS unsigned* st, bool leader) {
    XcdBarrier b; b.bar = bar; b.x = xb_xcc_id(); b.st = st;
    if (leader) (void)xb_add(&bar[XB_XCNT(b.x)], 1u);
    return b;
}
__device__ __forceinline__ void xcd_barrier_complete(unsigned* bar, unsigned x, unsigned& nloc, unsigned& nx) {
    const unsigned G = gridDim.x * gridDim.y * gridDim.z;
    unsigned sum, cnt, mine, sp = 0u;
    for (;;) {
        sum = 0u; cnt = 0u; mine = 0u;
#pragma unroll
        for (unsigned j = 0; j < 16; ++j) { const unsigned c = xb_ld(&bar[XB_XCNT(j)]); sum += c; cnt += (c > 0u) ? 1u : 0u; mine = (j == x) ? c : mine; }
        if (sum == G) break;
        __builtin_amdgcn_s_sleep(1);
        if ((++sp & 255u) == 0u) { if (xb_ld(&bar[XB_TMO])) break; if (sp > XB_SPIN_CAP) { atomicAdd(&bar[XB_TMO], 1u); break; } }
    }
    nloc = mine > 0u ? mine : 1u; nx = cnt > 0u ? cnt : 1u;
}

__device__ __forceinline__ void xcd_barrier(const XcdBarrier& b, bool leader) {
    asm volatile("s_waitcnt vmcnt(0)" ::: "memory");
    __syncthreads();
    if (leader) {
        unsigned* bar = b.bar;
        __builtin_amdgcn_s_waitcnt(0);
        unsigned nloc = b.st[0], nx = b.st[1];
        if (nloc == 0u) { xcd_barrier_complete(bar, b.x, nloc, nx); b.st[0] = nloc; b.st[1] = nx; }
        const unsigned old = xb_add(&bar[XB_XSUB(b.x)], 1u);
        const unsigned gen = old / nloc;
        if (old + 1u == (gen + 1u) * nloc) {
            __builtin_amdgcn_fence(__ATOMIC_RELEASE, "agent");
            asm volatile("s_waitcnt vmcnt(0)" ::: "memory");
            const unsigned og = xb_add(&bar[XB_TOP], 1u);
            const unsigned tg = og / nx;
            if (og + 1u == (tg + 1u) * nx) xb_add(&bar[XB_TOPGEN], 1u);
            else XB_SPIN(xb_ld(&bar[XB_TOPGEN]) == tg, bar);
            __builtin_amdgcn_fence(__ATOMIC_ACQUIRE, "agent");
            xb_add(&bar[XB_XGEN(b.x)], 1u);
            asm volatile("s_waitcnt vmcnt(0)" ::: "memory");
        } else {
            XB_SPIN(xb_ld(&bar[XB_XGEN(b.x)]) == gen, bar);
            __builtin_amdgcn_fence(__ATOMIC_ACQUIRE, "agent");
            asm volatile("s_waitcnt vmcnt(0)" ::: "memory");
        }
    }
    __syncthreads();
}
constexpr int LDS_BYTES = 147456;

__device__ __forceinline__ void prep_transpose_item(const float* W, int K, int N, const float* g, bf16* WT, LAS float* scr, int item, int lane, bool perm) {
    const int nblk = N / 64, kb = item / nblk, nb = item % nblk, k0 = 64 * kb, l0 = 64 * nb;
    const float* wp = W + (size_t)k0 * N + l0 + lane;
    float w[64];
#pragma unroll
    for (int i = 0; i < 64; ++i) w[i] = wp[(size_t)i * N];
    if (g) {
#pragma unroll
        for (int i = 0; i < 64; ++i) w[i] *= g[k0 + i];
    }
#pragma unroll
    for (int i = 0; i < 64; ++i) scr[i * 65 + lane] = w[i];
    asm volatile("s_waitcnt lgkmcnt(0)" ::: "memory");
    const int c = lane & 7;
#pragma unroll
    for (int j = 0; j < 8; ++j) { const int ll = (lane >> 3) + 8 * j;
        int prow;
        if (perm) { const int bj = ll >> 5, y = ll & 31, x = 16 * ((y >> 2) & 1) + 4 * (y >> 3) + (y & 3), wc = (l0 >> 6) & 3; prow = (l0 & ~255) + 128 * bj + 32 * wc + x; }
        else prow = l0 + ll;
        const LAS float* s = scr + (8 * c) * 65 + ll;
        v4u o; o.x = pk2(s[0 * 65], s[1 * 65]); o.y = pk2(s[2 * 65], s[3 * 65]); o.z = pk2(s[4 * 65], s[5 * 65]); o.w = pk2(s[6 * 65], s[7 * 65]);
        *(v4u*)(WT + (size_t)prow * K + k0 + 8 * c) = o; }
    asm volatile("s_waitcnt lgkmcnt(0)" ::: "memory");
}
struct Args { const float* in[30]; float* out; unsigned char* ws; int s_lo, s_hi; };

__device__ __forceinline__ void prologue_phase(const Args& a, unsigned char* ws, float* outp, LAS unsigned char* lds, int gw, int NGW, int wave, int lane) {
    LAS float* scr = (LAS float*)(lds + wave * 16640);
    constexpr int I_IN = 16 * 24, I_OUT = 16 * 16, I_FF1 = 16 * 64, I_FF2 = 64 * 16, I_GATE = 16 * 16, I_PROJ = 4 * 16, I_GLU = 4 * 4, I_L = I_IN + I_OUT + I_FF1 + I_FF2 + I_GATE + I_PROJ + 2 * I_GLU;
    for (int it = gw; it < NLAYER * I_L; it += NGW) {
        const int L = it / I_L; int r = it % I_L; unsigned char* wl = ws + WS_W + (size_t)L * LW_STRIDE;
        const float* W; const float* gg; bf16* WT; int K, N; bool perm = true;
        if (r < I_IN) { W = a.in[4] + (size_t)L * DM * NIN; K = DM; N = NIN; gg = a.in[3] + L * DM; WT = (bf16*)(wl + LW_IN); }
        else if ((r -= I_IN) < I_OUT) { W = a.in[23] + (size_t)L * DM * DM; K = DM; N = DM; gg = a.in[22] + L * DM; WT = (bf16*)(wl + LW_OUT); }
        else if ((r -= I_OUT) < I_FF1) { W = a.in[25] + (size_t)L * DM * DFF; K = DM; N = DFF; gg = a.in[24] + L * DM; WT = (bf16*)(wl + LW_FF1); }
        else if ((r -= I_FF1) < I_FF2) { W = a.in[26] + (size_t)L * DFF * DM; K = DFF; N = DM; gg = nullptr; WT = (bf16*)(wl + LW_FF2); }
        else if ((r -= I_FF2) < I_GATE) { W = a.in[28] + (size_t)L * DM * DM; K = DM; N = DM; gg = a.in[27] + L * DM; WT = (bf16*)(wl + LW_GATE); }
        else if ((r -= I_GATE) < I_PROJ) { W = a.in[29] + (size_t)L * 256 * DM; K = 256; N = DM; gg = nullptr; WT = (bf16*)(wl + LW_PROJ); }
        else if ((r -= I_PROJ) < I_GLU) { W = a.in[20] + (size_t)L * 65536; K = 256; N = 256; gg = nullptr; WT = (bf16*)(wl + LW_GLU); perm = false; }
        else { r -= I_GLU; W = a.in[21] + (size_t)L * 65536; K = 256; N = 256; gg = nullptr; WT = (bf16*)(wl + LW_GLU) + 65536; perm = false; }
        prep_transpose_item(W, K, N, gg, WT, scr, r, lane, perm);
    }
    {
        const float* x = a.in[0]; bf16* hb = (bf16*)outp; float* ssq = (float*)(ws + TAB_SSQ0);
        for (int m = gw; m < NTOK; m += 2 * NGW) {
            f32x4 v[2][4];
#pragma unroll
            for (int u = 0; u < 2; ++u)
#pragma unroll
                for (int j = 0; j < 4; ++j) v[u][j] = ((const f32x4*)(x + (size_t)(m + u * NGW) * DM) + lane)[64 * j];
#pragma unroll
            for (int u = 0; u < 2; ++u) { const int mm = m + u * NGW; unsigned long long* o8 = (unsigned long long*)(hb + (size_t)mm * DM) + lane; float s = 0.f;
#pragma unroll
                for (int j = 0; j < 4; ++j) { const f32x4 t = v[u][j]; s += (t[0] * t[0] + t[1] * t[1]) + (t[2] * t[2] + t[3] * t[3]);
                    o8[64 * j] = (unsigned long long)pk2(t[0], t[1]) | ((unsigned long long)pk2(t[2], t[3]) << 32); }
                s = wave_sum(s);
                if (lane < 4) ssq[lane * NTOK + mm] = (lane == 0) ? s : 0.f; }
        }
    }
    {
        const int* pos = (const int*)a.in[2]; float* cosT = (float*)(ws + TAB_COS); float* sinT = (float*)(ws + TAB_SIN);
        for (int i = gw * 64 + lane; i < NTOK * 32; i += NGW * 64) { const int tok = i >> 5, k = i & 31;
            const double rev = (double)pos[tok] * ROPE_INV_REV[k]; const float r = (float)(rev - __builtin_rint(rev));
            cosT[i] = __builtin_amdgcn_cosf(r); sinT[i] = __builtin_amdgcn_sinf(r); }
    }
    {
        bf16* gwt = (bf16*)(ws + TAB_GW);
        for (int i = gw * 64 + lane; i < NLAYER * 4 * 128 * 128; i += NGW * 64) { const int s_ = i & 127, t_ = (i >> 7) & 127; gwt[i] = (bf16)(pk2(s_ <= t_ ? a.in[7][i] : 0.f, 0.f) & 0xffffu); }
    }
    ssm_tables(a.in, ws, gw * 64 + lane, NGW * 64);
    {
        float* sm = (float*)(ws + TAB_SMALL);
        for (int i = gw * 64 + lane; i < NLAYER * SM_STRIDE; i += NGW * 64) { const int L = i / SM_STRIDE, o = i % SM_STRIDE; float v = 0.f;
            if (o < SM_LNB) v = a.in[5][L * 256 + o]; else if (o < SM_QG) v = a.in[6][L * 256 + o - SM_LNB]; else if (o < SM_KG) v = a.in[9][L * 64 + o - SM_QG];
            else if (o < SM_SINK) v = a.in[10][L * 64 + o - SM_KG]; else if (o < SM_SINK + 8) v = a.in[11][L * 8 + o - SM_SINK];
            else if (o >= SM_GBS && o < SM_GBS + 512) v = a.in[8][L * 512 + o - SM_GBS];
            sm[i] = v; }
    }
}

enum { ST_IN = 0, ST_MIX, ST_CARRY, ST_SSM2, ST_OUT, ST_FF1, ST_FF2, ST_PLE, NSTEP };
#ifndef PG8_SP2
#define PG8_SP2 true
#endif
#ifndef PG8_ALIGN
#define PG8_ALIGN true
#endif
__global__ void __launch_bounds__(NWAVES * 64, 2) mk_fwd(Args args) {
    extern __shared__ __attribute__((aligned(16))) unsigned char lds_raw[];
    LAS unsigned char* lds = (LAS unsigned char*)lds_raw;
    const int G = gridDim.x;
    const int wave0 = __builtin_amdgcn_readfirstlane(threadIdx.x >> 6);
    volatile LAS unsigned* MISC = (volatile LAS unsigned*)(lds + 143360);
    { const int l0 = fresh_lane(); if (wave0 == 0) MISC[l0] = 0u; }
    __syncthreads();
    XcdBarrier bar = xcd_barrier_post((unsigned*)(args.ws + WS_CTL) + 4096, MISC, wave0 == 0 && fresh_lane() == 0);
#ifndef PROBE_DUP
#define PROBE_DUP (-2)
#endif
#ifndef PROBE_XBAR
#define PROBE_XBAR 0
#endif
    for (int i = args.s_lo; i < args.s_hi; ++i) {
        if (i > args.s_lo) { xcd_barrier(bar, wave0 == 0 && fresh_lane() == 0);
            for (int xb = 0; xb < PROBE_XBAR; ++xb) xcd_barrier(bar, wave0 == 0 && fresh_lane() == 0); }
        int s = i; bool null_epi = false;
        if (PROBE_DUP == -1) s = i > 0 ? i - 1 : 0;
        else if (PROBE_DUP >= 0) { if (i > 0) { const int j = (i - 1) % (NSTEP + 1), Lq = (i - 1) / (NSTEP + 1); s = 1 + Lq * NSTEP + (j <= PROBE_DUP ? j : j - 1); null_epi = (j == PROBE_DUP) && (PROBE_DUP == ST_OUT || PROBE_DUP == ST_FF2 || PROBE_DUP == ST_PLE); } }
        unsigned long long z0 = 0ull; int bx = blockIdx.x; int wv = wave0;
        asm volatile("" : "+s"(z0), "+s"(bx), "+s"(wv));
        unsigned char* ws = args.ws + z0; float* outp = args.out + z0;
        const int vcu = (G % 8 == 0) ? (bx % 8) * (G / 8) + bx / 8 : bx;
#define FRESH_TID(name) int name = fresh_lane(); name += wv * 64
        if (s == 0) { FRESH_TID(t0); prologue_phase(args, ws, outp, lds, vcu * NWAVES + wv, G * NWAVES, wv, t0 & 63); asm volatile("s_waitcnt vmcnt(0) lgkmcnt(0)" ::: "memory"); __syncthreads(); continue; }
        const int L = (s - 1) / NSTEP, st = (s - 1) % NSTEP, par = L & 1;
        unsigned char* wl = ws + WS_W + (size_t)L * LW_STRIDE;
        if (st == ST_IN) {
            {
                FRESH_TID(t1); const int lane = t1 & 63;
                if (L == 0) ssm_ktable(args.in, ws, (vcu * NWAVES + wv) * 64 + lane, G * NWAVES * 64);
                const float* pl = args.in[1] + (size_t)L * NTOK * 256; bf16* pb = (bf16*)(ws + WS_PB);
                for (int m = vcu * NWAVES + wv; m < NTOK; m += G * NWAVES) { const f32x4 v = ((const f32x4*)(pl + (size_t)m * 256))[lane];
                    ((unsigned long long*)(pb + (size_t)m * 256))[lane] = (unsigned long long)pk2(v[0], v[1]) | ((unsigned long long)pk2(v[2], v[3]) << 32); }
                asm volatile("s_waitcnt vmcnt(0)" ::: "memory");
            }
            pg8::Gemm g{(const bf16*)outp, (const bf16*)(wl + LW_IN), NTOK, NIN, DM}; pg8::StaticOrder S; S.init(NTOK, NIN, G, bx);
            pg8::EpiIn E{ws, par, L};
            { FRESH_TID(tl); pg8::gemm_phase<pg8::EpiIn, pg8::StaticOrder, PG8_ALIGN, PG8_SP2>(lds, g, S, E, tl); }
        } else if (st == ST_MIX) {
            FRESH_TID(tm); const int lane = tm & 63;
            for (int it = vcu; it < 256 + 128 + 256; it += G) { if (it < 256) attn_item(ws, L, lds, it, wv, lane); else if (it < 384) gmlp_item(ws, L, lds, it - 256, wv, lane); else ssm1_item(ws, L, it - 384, wv, lane); }
        } else if (st == ST_SSM2) {
            FRESH_TID(tm); const int lane = tm & 63;
            for (int it = vcu; it < 256; it += G) ssm2_item(ws, L, lds, it, wv, lane);
        } else if (st == ST_CARRY) {
            if (bx < 32) ssm_scan(ws, L, lds, bx, wv);
            pg8::Gemm g{(const bf16*)(ws + WS_PB), (const bf16*)(wl + LW_PROJ), NTOK, DM, 256}; pg8::StaticOrder S; S.init(NTOK, DM, G, bx);
            pg8::EpiProj E{ws};
            { FRESH_TID(tl); pg8::gemm_phase<pg8::EpiProj, pg8::StaticOrder, PG8_ALIGN, PG8_SP2>(lds, g, S, E, tl); }
        } else if (st == ST_OUT || st == ST_FF2) {
            const bool o = (st == ST_OUT);
            pg8::Gemm g{(const bf16*)(ws + (o ? WS_YCAT : WS_HID)), (const bf16*)(wl + (o ? LW_OUT : LW_FF2)), NTOK, DM, o ? DM : DFF}; pg8::StaticOrder S; S.init(NTOK, DM, G, bx);
            if (PROBE_DUP >= 0 && null_epi) { pg8::EpiNull E0; FRESH_TID(tl); pg8::gemm_phase<pg8::EpiNull, pg8::StaticOrder, false, PG8_SP2>(lds, g, S, E0, tl); }
            else { pg8::EpiRes<false> E{o ? (const bf16*)outp : (const bf16*)(ws + WS_HB), (bf16*)(ws + WS_HB), nullptr, ws, o ? (par ^ 1) : par};
            { FRESH_TID(tl); pg8::gemm_phase<pg8::EpiRes<false>, pg8::StaticOrder, false, PG8_SP2>(lds, g, S, E, tl); } }
        } else if (st == ST_FF1) {
            pg8::Gemm g{(const bf16*)(ws + WS_HB), (const bf16*)(wl + LW_FF1), NTOK, DFF, DM}; pg8::StaticOrder S; S.init(NTOK, DFF, G, bx);
            pg8::EpiFF1 E{ws, par ^ 1};
            { FRESH_TID(tl); pg8::gemm_phase<pg8::EpiFF1, pg8::StaticOrder, PG8_ALIGN, PG8_SP2>(lds, g, S, E, tl); }
        } else if (st == ST_PLE) {
            pg8::Gemm g{(const bf16*)(ws + WS_HB), (const bf16*)(wl + LW_GATE), NTOK, DM, DM}; pg8::StaticOrder S; S.init(NTOK, DM, G, bx);
            if (PROBE_DUP >= 0 && null_epi) { pg8::EpiNull E0; FRESH_TID(tl); pg8::gemm_phase<pg8::EpiNull, pg8::StaticOrder, false, PG8_SP2>(lds, g, S, E0, tl); }
            else { pg8::EpiRes<true> E{(const bf16*)(ws + WS_HB), (bf16*)outp, (L == NLAYER - 1) ? outp : nullptr, ws, par ^ 1};
            { FRESH_TID(tl); pg8::gemm_phase<pg8::EpiRes<true>, pg8::StaticOrder, false, PG8_SP2>(lds, g, S, E, tl); } }
        }
    }
}
extern "C" void kernel_launch(void* const* d_in, const int* in_sizes, int n_in, void* d_out, int out_size, void* d_ws, size_t ws_size, hipStream_t stream) {
    static int grid = 0;
    if (grid == 0) {
        if (n_in != 30 || out_size != NTOK * DM || ws_size < WS_END) { fprintf(stderr, "kernel_launch: unexpected shapes / workspace (n_in %d out %d ws %zu)\n", n_in, out_size, ws_size); grid = -1; return; }
        int dev = 0, cus = 0, per_cu = 0;
        (void)hipGetDevice(&dev); (void)hipDeviceGetAttribute(&cus, hipDeviceAttributeMultiprocessorCount, dev);
        (void)hipFuncSetAttribute((const void*)mk_fwd, hipFuncAttributeMaxDynamicSharedMemorySize, LDS_BYTES);
        (void)hipOccupancyMaxActiveBlocksPerMultiprocessor(&per_cu, (const void*)mk_fwd, NWAVES * 64, LDS_BYTES);
        (void)hipGetLastError();
        grid = (per_cu >= 1 && cus == 256) ? 256 : -1;
        if (grid < 0) { fprintf(stderr, "kernel_launch: needs 256 CUs with one resident workgroup each (cus %d per_cu %d)\n", cus, per_cu); return; }
    }
    if (grid < 0) return;
    (void)hipMemsetAsync((char*)d_ws + WS_CTL, 0, CTL_ZERO_BYTES, stream);
    Args a{};
    for (int i = 0; i < 30; ++i) a.in[i] = (const float*)d_in[i];
    a.out = (float*)d_out; a.ws = (unsigned char*)d_ws;
    unsigned char* ws = (unsigned char*)d_ws;
    const float* const* F = a.in;
#define LAUNCH_STEPS(lo, hi) do { a.s_lo = (lo); a.s_hi = (hi); hipLaunchKernelGGL(mk_fwd, dim3(grid), dim3(NWAVES * 64), LDS_BYTES, stream, a); } while (0)
#ifndef MK_SINGLE
#define MK_SINGLE 1
#endif
#if MK_SINGLE
    LAUNCH_STEPS(0, (PROBE_DUP == -1) ? 2 + NLAYER * NSTEP : (PROBE_DUP >= 0 ? 1 + NLAYER * (NSTEP + 1) : 1 + NLAYER * NSTEP));
#else
    for (int s = 0; s < 1 + NLAYER * NSTEP; ++s) LAUNCH_STEPS(s, s + 1);
#endif
}
```

```cpp
#include <hip/hip_runtime.h>
#include <cstdio>
#include <cstdint>
#include <math.h>

#define NTOK 16384
#define SEQL 8192
#define DM 1024
#define NIN 1536
#define DFF 4096
#define NLAYER 4
constexpr float QSCALE = 0.125f * 1.4426950408889634f;
constexpr float LOG2E = 1.4426950408889634f;

constexpr size_t MiB = 1u << 20;
constexpr size_t WS_CTL = 0, CTL_ZERO_BYTES = 1 * MiB;
constexpr size_t WS_W = 2 * MiB;
constexpr size_t LW_IN = 0, LW_OUT = 3 * MiB, LW_FF1 = 5 * MiB, LW_FF2 = 13 * MiB, LW_GATE = 21 * MiB, LW_PROJ = 23 * MiB, LW_GLU = 23 * MiB + 512 * 1024, LW_STRIDE = 24 * MiB;
constexpr size_t WS_TAB = 98 * MiB;
constexpr size_t TAB_COS = WS_TAB, TAB_SIN = WS_TAB + 2 * MiB, TAB_SSQ0 = WS_TAB + 4 * MiB, TAB_SSQ1 = TAB_SSQ0 + 256 * 1024, TAB_GW = TAB_SSQ1 + 256 * 1024, TAB_SMALL = TAB_GW + 512 * 1024, TAB_END = TAB_SMALL + 64 * 1024;
constexpr int SM_LNG = 0, SM_LNB = 256, SM_QG = 512, SM_KG = 576, SM_SINK = 640, SM_GBS = 1024  , SM_STRIDE = 2048;
constexpr size_t WS_HB = 104 * MiB;
constexpr size_t WS_U = 138 * MiB, WS_VLN = 146 * MiB, WS_Q = 154 * MiB, WS_K = 170 * MiB, WS_V = 174 * MiB, WS_ZC = 178 * MiB;
constexpr size_t WS_YCAT = 186 * MiB;
constexpr size_t WS_HID = 138 * MiB;
constexpr size_t WS_PPROJ = 266 * MiB;
constexpr size_t WS_YF = 218 * MiB;
constexpr size_t WS_YSSM = 282 * MiB;
constexpr size_t WS_PB = 298 * MiB;
constexpr size_t WS_SSM = 306 * MiB;
constexpr size_t SSM_PW = WS_SSM;
constexpr size_t SSM_KT = SSM_PW + 2304 * 1024;
constexpr size_t SSM_BBT = SSM_KT + 2 * MiB;
constexpr size_t SSM_CCT = SSM_BBT + 256 * 1024;
constexpr size_t SSM_BBC = SSM_CCT + 256 * 1024;
constexpr size_t SSM_S = SSM_BBC + 512 * 1024;
constexpr size_t SSM_S32 = SSM_S + 2 * MiB;
constexpr size_t WS_END = SSM_S32 + 2 * MiB;
static_assert(WS_END <= 316 * MiB, "ssm region");
static_assert(TAB_END <= WS_HB && WS_HB + 32 * MiB <= WS_U && WS_HID + 128 * MiB <= WS_PPROJ && WS_YF + 64 * MiB <= WS_YSSM && WS_YSSM + 16 * MiB <= WS_PB, "ws map");
static_assert(WS_W + NLAYER * LW_STRIDE <= WS_TAB, "weights");

typedef float f32x2_t __attribute__((ext_vector_type(2)));
typedef __bf16 bf16x2_t __attribute__((ext_vector_type(2)));
__device__ __forceinline__ unsigned pk2(float lo, float hi) { f32x2_t v = {lo, hi}; bf16x2_t b = __builtin_convertvector(v, bf16x2_t); return __builtin_bit_cast(unsigned, b); }
__device__ __forceinline__ float bf_lo(unsigned w) { return __uint_as_float(w << 16); }
__device__ __forceinline__ float bf_hi(unsigned w) { return __uint_as_float(w & 0xffff0000u); }
__device__ __forceinline__ float bf2f(unsigned short b) { return __uint_as_float(((unsigned)b) << 16); }
template <int X> __device__ __forceinline__ float xor_lane(float v) { return __int_as_float(__builtin_amdgcn_ds_swizzle(__float_as_int(v), (X << 10) | 0x1f)); }
__device__ __forceinline__ float add_xor16(float v) { return v + xor_lane<16>(v); }
__device__ __forceinline__ float add_xor32(float v) { auto r = __builtin_amdgcn_permlane32_swap(__float_as_uint(v), __float_as_uint(v), false, false); return __uint_as_float(r[0]) + __uint_as_float(r[1]); }
__device__ __forceinline__ float wave_sum(float v) {
    v += xor_lane<1>(v); v += xor_lane<2>(v); v += xor_lane<4>(v); v += xor_lane<8>(v); v = add_xor16(v); return add_xor32(v);
}
__device__ __forceinline__ float wave_sum_shfl(float v) {
#pragma unroll
    for (int o = 1; o < 64; o <<= 1) v += __shfl_xor(v, o);
    return v;
}
__device__ __forceinline__ int fresh_lane() { int l; asm volatile("v_mbcnt_lo_u32_b32 %0, -1, 0\n\tv_mbcnt_hi_u32_b32 %0, -1, %0" : "=v"(l)); return l; }
__device__ __forceinline__ float gelu_fast(float x) {
    const float u = x * (1.0f + 0.044715f * x * x);
    const float t = __builtin_amdgcn_exp2f(u * 2.3022082f);
    return x - x * __builtin_amdgcn_rcpf(1.0f + t);
}
__device__ __forceinline__ float sigmoid_fast(float x) { return __builtin_amdgcn_rcpf(1.0f + __builtin_amdgcn_exp2f(-x * LOG2E)); }
__device__ __forceinline__ float gelu_tanh(float x) { const float k0 = 0.7978845608028654f, k1 = 0.044715f; float u = k0 * (x + k1 * x * x * x); return 0.5f * x * (1.0f + tanhf(u)); }
__device__ const double ROPE_INV_REV[32] = {0.15915494309189535, 0.11934937021124886, 0.08949940160889101, 0.06711508300522726, 0.050329212104487035, 0.03774158471741977, 0.0283021958306234, 0.02122365276477766, 0.015915494309189534, 0.011934937021124886, 0.008949940160889102, 0.006711508300522725, 0.005032921210448704, 0.003774158471741977, 0.00283021958306234, 0.0021223652764777662, 0.0015915494309189536, 0.0011934937021124885, 0.0008949940160889102, 0.0006711508300522726, 0.0005032921210448703, 0.00037741584717419774, 0.00028302195830623395, 0.0002122365276477766, 0.00015915494309189535, 0.00011934937021124886, 8.949940160889102e-05, 6.711508300522725e-05, 5.0329212104487035e-05, 3.774158471741978e-05, 2.8302195830623396e-05, 2.122365276477766e-05};
namespace pg8 {
#define PG8_LAS __attribute__((address_space(3)))
typedef unsigned short bf16_t;
typedef short bf16x8 __attribute__((ext_vector_type(8)));
typedef float f32x4 __attribute__((ext_vector_type(4)));
typedef unsigned u32x4 __attribute__((ext_vector_type(4)));
constexpr int BM = 256, BK = 64, HALF = 128, HTB = HALF * BK * 2  , STAGE_BYTES = 8 * HTB, NXCD = 8, WGM = 8;

__host__ __device__ __forceinline__ int lds_byte(int r, int c) { const int st = (r >> 4) * 2 + (c >> 5), rr = r & 15, cc = c & 31, ob = rr * 64 + cc * 2; return st * 1024 + (ob ^ (((ob >> 9) & 1) << 5)); }
__host__ __device__ __forceinline__ void stage_rc(int b, int& R, int& C) { const int st = b / 1024, sb = b % 1024, swz = sb ^ (((sb >> 9) & 1) << 5); R = (st >> 1) * 16 + swz / 64; C = (st & 1) * 32 + (swz % 64) / 2; }
__host__ __device__ __forceinline__ int perm32(int rho) { const int n = rho >> 4, i = rho & 15; return 8 * (i >> 2) + 4 * n + (i & 3); }

struct Unit { int pm, pn; };
struct Gemm { const bf16_t* A; const bf16_t* Bt; int M, N, K; };

struct StaticOrder {
    int nM, nN, nwg, G, c;
    __host__ __device__ void init(int M, int N, int G_, int c_) { nM = M / BM; nN = N / BM; nwg = nM * nN; G = G_; c = c_; }
    __host__ __device__ bool next(int i, Unit& u) const {
        const long L = (long)i * G + c; if (L >= nwg) return false;
        int wgid = (int)L; { const int q = nwg / NXCD, r = nwg % NXCD, xcd = wgid % NXCD, off = wgid / NXCD; wgid = (xcd < r ? xcd * (q + 1) : r * (q + 1) + (xcd - r) * q) + off; }
        const int nig = WGM * nN, gid = wgid / nig, fm = gid * WGM, gsz = (nM - fm) < WGM ? (nM - fm) : WGM;
        u.pm = fm + ((wgid % nig) % gsz); u.pn = (wgid % nig) / gsz; return true;
    }
    __device__ __forceinline__ void a_ready(const Unit&) const {}
    __device__ __forceinline__ void done(const Unit&) const {}
};

template <class Epi, class Sched, bool ALIGN_EPI = false, bool SP2 = false>
__device__ __forceinline__ void gemm_phase(PG8_LAS unsigned char* lds, const Gemm g, const Sched& S, const Epi& E, const int tid) {
    const int wid = __builtin_amdgcn_readfirstlane(tid >> 6), lane = tid & 63, wr = wid >> 2, wc = wid & 3, fr = lane & 15, fq = lane >> 4;
    const int K = g.K, nt = K / BK;
    unsigned voffA[2], voffB[2];
#pragma unroll
    for (int i = 0; i < 2; ++i) { int R, C; stage_rc(tid * 16 + i * 8192, R, C); const int Rb = Epi::PERM ? ((R & ~31) + perm32(R & 31)) : R;
        voffA[i] = (unsigned)(R * K + C) * 2u; voffB[i] = (unsigned)(Rb * K + C) * 2u; }
    const size_t kstep = (size_t)(BK * 2);
    const size_t hstep = (size_t)HALF * K * 2;
    const size_t tstep = 2 * hstep;
    const unsigned ldsw = (unsigned)wid * 1024u;
    const int aoff = lds_byte(wr * 64 + fr, fq * 8), boff = lds_byte(wc * 32 + fr, fq * 8);
#define PG8_SA(b, h) (((b) * 2 + (h)) * HTB)
#define PG8_SB(b, h) ((4 + (b) * 2 + (h)) * HTB)
#define PG8_STAGE(bufoff, gbase, voff) do { _Pragma("unroll") for (int _i = 0; _i < 2; ++_i) \
        __builtin_amdgcn_global_load_lds((const unsigned*)((const char*)(gbase) + (voff)[_i]), (PG8_LAS unsigned*)(lds + (bufoff) + ldsw + _i * 8192), 16, 0, 0); } while (0)
#define PG8_LDA(dst, b, h) do { _Pragma("unroll") for (int m = 0; m < 4; ++m) _Pragma("unroll") for (int k = 0; k < 2; ++k) dst[m][k] = *(const PG8_LAS bf16x8*)(lds + PG8_SA(b, h) + aoff + m * 2048 + k * 1024); } while (0)
#define PG8_LDB(dst, b, h) do { _Pragma("unroll") for (int n = 0; n < 2; ++n) _Pragma("unroll") for (int k = 0; k < 2; ++k) dst[n][k] = *(const PG8_LAS bf16x8*)(lds + PG8_SB(b, h) + boff + n * 2048 + k * 1024); } while (0)
#define PG8_MMA(ai, bj, At, Bt) do { __builtin_amdgcn_s_setprio(1); _Pragma("unroll") for (int m = 0; m < 4; ++m) _Pragma("unroll") for (int n = 0; n < 2; ++n) _Pragma("unroll") for (int k = 0; k < 2; ++k) \
        acc[ai][bj][m][n] = __builtin_amdgcn_mfma_f32_16x16x32_bf16(Bt[n][k], At[m][k], acc[ai][bj][m][n], 0, 0, 0); __builtin_amdgcn_s_setprio(0); } while (0)
#define PG8_WAIT_V(n) asm volatile("s_waitcnt vmcnt(" #n ")" ::: "memory")
#define PG8_WAIT_L(n) asm volatile("s_waitcnt lgkmcnt(" #n ")" ::: "memory")
#define PG8_BAR __builtin_amdgcn_s_barrier()
#define PG8_SCHED __builtin_amdgcn_sched_barrier(0)
    Unit cur, nxt; int ui = 0;
    if (!S.next(0, cur)) return;
    f32x4 acc[2][2][4][2];
#pragma unroll
    for (int a = 0; a < 2; ++a)
#pragma unroll
        for (int b = 0; b < 2; ++b)
#pragma unroll
            for (int m = 0; m < 4; ++m)
#pragma unroll
                for (int n = 0; n < 2; ++n) acc[a][b][m][n] = (f32x4){0.f, 0.f, 0.f, 0.f};
    bf16x8 At[4][2], B0[2][2], B1[2][2];
    const char* cA = (const char*)g.A + (size_t)cur.pm * tstep; const char* cB = (const char*)g.Bt + (size_t)cur.pn * tstep;
    S.a_ready(cur);
    if constexpr (SP2) {
        PG8_STAGE(PG8_SB(0, 0), cB, voffB); PG8_STAGE(PG8_SB(0, 1), cB + hstep, voffB); PG8_STAGE(PG8_SA(0, 0), cA, voffA); PG8_STAGE(PG8_SA(0, 1), cA + hstep, voffA);
        if (wr == 1) PG8_BAR;
        PG8_WAIT_V(2); PG8_BAR;
        PG8_STAGE(PG8_SB(1, 0), cB + kstep, voffB); PG8_STAGE(PG8_SA(1, 0), cA + kstep, voffA); PG8_STAGE(PG8_SB(1, 1), cB + hstep + kstep, voffB);
        PG8_WAIT_V(6); PG8_BAR;
    } else {
        PG8_STAGE(PG8_SB(0, 0), cB, voffB); PG8_STAGE(PG8_SA(0, 0), cA, voffA); PG8_STAGE(PG8_SB(0, 1), cB + hstep, voffB); PG8_STAGE(PG8_SA(0, 1), cA + hstep, voffA);
        if (wr == 1) PG8_BAR;
        PG8_WAIT_V(4); PG8_BAR;
        PG8_STAGE(PG8_SB(1, 0), cB + kstep, voffB); PG8_STAGE(PG8_SA(1, 0), cA + kstep, voffA); PG8_STAGE(PG8_SB(1, 1), cB + hstep + kstep, voffB);
        PG8_WAIT_V(6); PG8_BAR;
    }
    for (;;) {
        const bool has_next = S.next(ui + 1, nxt);
        const char* nA = has_next ? (const char*)g.A + (size_t)nxt.pm * tstep : cA; const char* nB = has_next ? (const char*)g.Bt + (size_t)nxt.pn * tstep : cB;
        for (int t = 0; t < nt; t += 2) {
            const bool last = (t == nt - 2);
            const char* a1 = cA + (size_t)(t + 1) * kstep;
            const char* a2 = last ? nA : cA + (size_t)(t + 2) * kstep; const char* b2 = last ? nB : cB + (size_t)(t + 2) * kstep;
            const char* a3 = a2 + kstep; const char* b3 = b2 + kstep;
            if (last && has_next) S.a_ready(nxt);
            if constexpr (SP2) {
            PG8_LDB(B0, 0, 0); PG8_LDB(B1, 0, 1); PG8_SCHED; PG8_LDA(At, 0, 0); PG8_STAGE(PG8_SA(1, 1), a1 + hstep, voffA);
            PG8_WAIT_V(8); PG8_WAIT_L(0); PG8_BAR; PG8_MMA(0, 0, At, B0); PG8_MMA(0, 1, At, B1); PG8_BAR; PG8_SCHED;
            PG8_LDA(At, 0, 1); PG8_STAGE(PG8_SB(0, 0), b2, voffB); PG8_STAGE(PG8_SB(0, 1), b2 + hstep, voffB); PG8_STAGE(PG8_SA(0, 0), a2, voffA);
            PG8_WAIT_V(8); PG8_WAIT_L(0); PG8_BAR; PG8_MMA(1, 0, At, B0); PG8_MMA(1, 1, At, B1); PG8_BAR; PG8_SCHED;
            PG8_LDB(B0, 1, 0); PG8_LDB(B1, 1, 1); PG8_SCHED; PG8_LDA(At, 1, 0); PG8_STAGE(PG8_SA(0, 1), a2 + hstep, voffA);
            PG8_WAIT_V(8); PG8_WAIT_L(0); PG8_BAR; PG8_MMA(0, 0, At, B0); PG8_MMA(0, 1, At, B1); PG8_BAR; PG8_SCHED;
            PG8_LDA(At, 1, 1); PG8_STAGE(PG8_SB(1, 0), b3, voffB); PG8_STAGE(PG8_SB(1, 1), b3 + hstep, voffB); PG8_STAGE(PG8_SA(1, 0), a3, voffA);
            PG8_WAIT_V(8); PG8_WAIT_L(0); PG8_BAR; PG8_MMA(1, 0, At, B0); PG8_MMA(1, 1, At, B1); PG8_BAR; PG8_SCHED;
            } else {
            PG8_LDB(B0, 0, 0); PG8_SCHED; PG8_LDA(At, 0, 0); PG8_STAGE(PG8_SA(1, 1), a1 + hstep, voffA);
            PG8_WAIT_L(8); PG8_BAR; PG8_WAIT_L(0); PG8_MMA(0, 0, At, B0); PG8_BAR; PG8_SCHED;
            PG8_LDB(B1, 0, 1); PG8_STAGE(PG8_SB(0, 0), b2, voffB);
            PG8_BAR; PG8_WAIT_L(0); PG8_MMA(0, 1, At, B1); PG8_BAR;
            PG8_LDA(At, 0, 1); PG8_STAGE(PG8_SA(0, 0), a2, voffA);
            PG8_BAR; PG8_WAIT_L(0); PG8_MMA(1, 0, At, B0); PG8_BAR; PG8_SCHED;
            PG8_STAGE(PG8_SB(0, 1), b2 + hstep, voffB);
            PG8_WAIT_V(6); PG8_BAR; PG8_MMA(1, 1, At, B1); PG8_BAR;
            PG8_LDB(B0, 1, 0); PG8_SCHED; PG8_LDA(At, 1, 0); PG8_STAGE(PG8_SA(0, 1), a2 + hstep, voffA);
            PG8_WAIT_L(8); PG8_BAR; PG8_WAIT_L(0); PG8_MMA(0, 0, At, B0); PG8_BAR; PG8_SCHED;
            PG8_LDB(B1, 1, 1); PG8_STAGE(PG8_SB(1, 0), b3, voffB);
            PG8_BAR; PG8_WAIT_L(0); PG8_MMA(0, 1, At, B1); PG8_BAR;
            PG8_LDA(At, 1, 1); PG8_STAGE(PG8_SA(1, 0), a3, voffA);
            PG8_BAR; PG8_WAIT_L(0); PG8_MMA(1, 0, At, B0); PG8_BAR; PG8_SCHED;
            PG8_STAGE(PG8_SB(1, 1), b3 + hstep, voffB);
            PG8_WAIT_V(6); PG8_BAR; PG8_MMA(1, 1, At, B1); PG8_BAR;
            }
        }
        if constexpr (ALIGN_EPI) { if (wr == 0) PG8_BAR; }
        if constexpr (!Epi::AFTER_DRAIN) { const int l2 = fresh_lane();
            E(acc, cur, wr, wc, l2 & 15, l2 >> 4); S.done(cur); }
        if (!has_next) break;
#pragma unroll
        for (int a = 0; a < 2; ++a)
#pragma unroll
            for (int b = 0; b < 2; ++b)
#pragma unroll
                for (int m = 0; m < 4; ++m)
#pragma unroll
                    for (int n = 0; n < 2; ++n) acc[a][b][m][n] = (f32x4){0.f, 0.f, 0.f, 0.f};
        cur = nxt; cA = nA; cB = nB; ++ui;
        if constexpr (ALIGN_EPI) { if (wr == 1) PG8_BAR; }
    }
    PG8_WAIT_V(0);
    if constexpr (!ALIGN_EPI) { if (wr == 0) PG8_BAR; }
    PG8_BAR;
    if constexpr (Epi::AFTER_DRAIN) { const int l2 = fresh_lane();
        E.fused(acc, cur, wr, wc, l2 & 15, l2 >> 4, lds, wid, l2); S.done(cur); }
#undef PG8_SA
#undef PG8_SB
#undef PG8_STAGE
#undef PG8_LDA
#undef PG8_LDB
#undef PG8_MMA
#undef PG8_WAIT_V
#undef PG8_WAIT_L
#undef PG8_BAR
#undef PG8_SCHED
}
}
namespace pg8 {
__device__ __forceinline__ float rstd_row(const float* ssq, int row) {
    const float s = (ssq[row] + ssq[NTOK + row]) + (ssq[2 * NTOK + row] + ssq[3 * NTOK + row]);
    return __builtin_amdgcn_rsqf(s * (1.0f / 1024.0f) + 1e-6f);
}
__device__ __forceinline__ void store8(bf16_t* p, const float (&v)[8]) {
    u32x4 w; w.x = pk2(v[0], v[1]); w.y = pk2(v[2], v[3]); w.z = pk2(v[4], v[5]); w.w = pk2(v[6], v[7]); *(u32x4*)p = w;
}
struct EpiIn {
    static constexpr bool PERM = false, AFTER_DRAIN = false;
    unsigned char* ws; int par, L;
    __device__ __forceinline__ void operator()(const f32x4 (&acc)[2][2][4][2], const Unit& u, int wr, int wc, int fr, int fq) const {
        const int pn = u.pn;
        const float* ssq = (const float*)(ws + (par ? TAB_SSQ1 : TAB_SSQ0)); const float* cosT = (const float*)(ws + TAB_COS); const float* sinT = (const float*)(ws + TAB_SIN);
        const float* sm = (const float*)(ws + TAB_SMALL) + L * SM_STRIDE; const float* lng = sm + SM_LNG; const float* lnb = sm + SM_LNB; const float* qg = sm + SM_QG; const float* kg = sm + SM_KG;
        bf16_t* U = (bf16_t*)(ws + WS_U); bf16_t* VLN = (bf16_t*)(ws + WS_VLN); bf16_t* Q = (bf16_t*)(ws + WS_Q); bf16_t* K = (bf16_t*)(ws + WS_K); bf16_t* V = (bf16_t*)(ws + WS_V); bf16_t* ZC = (bf16_t*)(ws + WS_ZC);
        int mode, ld, cb; bf16_t* dst; const float* gp = nullptr; const float* bp = nullptr;
        if (pn < 2) { const int head = 2 * pn + (wc >> 1); ld = 256; cb = head * 64; if (wc & 1) { mode = 1; dst = VLN; gp = lng + head * 64; bp = lnb + head * 64; } else { mode = 0; dst = U; } }
        else if (pn < 4) { mode = 2; dst = Q; ld = 512; cb = (4 * (pn - 2) + wc) * 64; gp = qg; }
        else if (pn == 4) { ld = 128; if (wc < 2) { mode = 3; dst = K; cb = wc * 64; gp = kg; } else { mode = 4; dst = V; cb = (wc - 2) * 64; } }
        else { mode = 4; dst = ZC; ld = 256; cb = wc * 64; }
        float g[16], bb[16];
#pragma unroll
        for (int i = 0; i < 16; ++i) { g[i] = 1.f; bb[i] = 0.f; }
        if (gp) {
#pragma unroll
            for (int bj = 0; bj < 2; ++bj)
#pragma unroll
                for (int n = 0; n < 2; ++n) { const f32x4 t = *(const f32x4*)(gp + 32 * bj + 8 * fq + 4 * n); g[bj * 8 + n * 4 + 0] = t[0]; g[bj * 8 + n * 4 + 1] = t[1]; g[bj * 8 + n * 4 + 2] = t[2]; g[bj * 8 + n * 4 + 3] = t[3]; }
        }
        if (bp) {
#pragma unroll
            for (int bj = 0; bj < 2; ++bj)
#pragma unroll
                for (int n = 0; n < 2; ++n) { const f32x4 t = *(const f32x4*)(bp + 32 * bj + 8 * fq + 4 * n); bb[bj * 8 + n * 4 + 0] = t[0]; bb[bj * 8 + n * 4 + 1] = t[1]; bb[bj * 8 + n * 4 + 2] = t[2]; bb[bj * 8 + n * 4 + 3] = t[3]; }
        }
#pragma unroll
        for (int ai = 0; ai < 2; ++ai)
#pragma unroll
            for (int m = 0; m < 4; ++m) {
                const int row = u.pm * BM + ai * HALF + wr * 64 + m * 16 + fr;
                const float rs = rstd_row(ssq, row);
                float v[16];
#pragma unroll
                for (int bj = 0; bj < 2; ++bj)
#pragma unroll
                    for (int n = 0; n < 2; ++n)
#pragma unroll
                        for (int j = 0; j < 4; ++j) v[bj * 8 + n * 4 + j] = acc[ai][bj][m][n][j] * rs;
                if (mode <= 1) {
#pragma unroll
                    for (int i = 0; i < 16; ++i) v[i] = gelu_fast(v[i]);
                    if (mode == 1) {
                        float s = 0.f;
#pragma unroll
                        for (int i = 0; i < 16; ++i) s += v[i];
                        s = add_xor16(s); s = add_xor32(s);
                        const float mu = s * (1.0f / 64.0f); float q = 0.f;
#pragma unroll
                        for (int i = 0; i < 16; ++i) { v[i] -= mu; q += v[i] * v[i]; }
                        q = add_xor16(q); q = add_xor32(q);
                        const float r = __builtin_amdgcn_rsqf(q * (1.0f / 64.0f) + 1e-6f);
#pragma unroll
                        for (int i = 0; i < 16; ++i) v[i] = v[i] * r * g[i] + bb[i];
                    }
                } else if (mode <= 3) {
                    float q = 0.f;
#pragma unroll
                    for (int i = 0; i < 16; ++i) q += v[i] * v[i];
                    q = add_xor16(q); q = add_xor32(q);
                    const float r = __builtin_amdgcn_rsqf(q * (1.0f / 64.0f) + 1e-6f) * (mode == 2 ? QSCALE : 1.0f);
#pragma unroll
                    for (int i = 0; i < 16; ++i) v[i] = v[i] * r * g[i];
                    const float* cp = cosT + (size_t)row * 32 + 8 * fq; const float* sp = sinT + (size_t)row * 32 + 8 * fq;
#pragma unroll
                    for (int n = 0; n < 2; ++n) { const f32x4 c4 = *(const f32x4*)(cp + 4 * n), s4 = *(const f32x4*)(sp + 4 * n);
#pragma unroll
                        for (int j = 0; j < 4; ++j) { const float x1 = v[n * 4 + j], x2 = v[8 + n * 4 + j]; v[n * 4 + j] = x1 * c4[j] - x2 * s4[j]; v[8 + n * 4 + j] = x2 * c4[j] + x1 * s4[j]; } }
                }
                bf16_t* rp = dst + (size_t)row * ld + cb + 8 * fq;
                { float t[8];
#pragma unroll
                  for (int i = 0; i < 8; ++i) t[i] = v[i];
                  store8(rp, t);
#pragma unroll
                  for (int i = 0; i < 8; ++i) t[i] = v[8 + i];
                  store8(rp + 32, t); }
            }
    }
};
struct EpiFF1 {
    static constexpr bool PERM = false, AFTER_DRAIN = false;
    unsigned char* ws; int par;
    __device__ __forceinline__ void operator()(const f32x4 (&acc)[2][2][4][2], const Unit& u, int wr, int wc, int fr, int fq) const {
        const float* ssq = (const float*)(ws + (par ? TAB_SSQ1 : TAB_SSQ0)); bf16_t* HID = (bf16_t*)(ws + WS_HID);
#pragma unroll
        for (int ai = 0; ai < 2; ++ai)
#pragma unroll
            for (int m = 0; m < 4; ++m) {
                const int row = u.pm * BM + ai * HALF + wr * 64 + m * 16 + fr;
                const float rs = rstd_row(ssq, row);
                bf16_t* rp = HID + (size_t)row * DFF + u.pn * BM + wc * 64 + 8 * fq;
#pragma unroll
                for (int bj = 0; bj < 2; ++bj) { float t[8];
#pragma unroll
                    for (int n = 0; n < 2; ++n)
#pragma unroll
                        for (int j = 0; j < 4; ++j) { float x = acc[ai][bj][m][n][j] * rs; x = x > 0.f ? x : 0.f; t[n * 4 + j] = x * x; }
                    store8(rp + 32 * bj, t); }
            }
    }
};
struct EpiProj {
    static constexpr bool PERM = false, AFTER_DRAIN = false;
    unsigned char* ws;
    __device__ __forceinline__ void operator()(const f32x4 (&acc)[2][2][4][2], const Unit& u, int wr, int wc, int fr, int fq) const {
        bf16_t* O = (bf16_t*)(ws + WS_PPROJ);
#pragma unroll
        for (int ai = 0; ai < 2; ++ai)
#pragma unroll
            for (int m = 0; m < 4; ++m) {
                const int row = u.pm * BM + ai * HALF + wr * 64 + m * 16 + fr;
                bf16_t* rp = O + (size_t)row * DM + u.pn * BM + wc * 64 + 8 * fq;
#pragma unroll
                for (int bj = 0; bj < 2; ++bj) { float t[8];
#pragma unroll
                    for (int n = 0; n < 2; ++n)
#pragma unroll
                        for (int j = 0; j < 4; ++j) t[n * 4 + j] = acc[ai][bj][m][n][j];
                    store8(rp + 32 * bj, t); }
            }
    }
};
template <bool GATED> struct EpiRes {
    static constexpr bool PERM = false, AFTER_DRAIN = true;
    const bf16_t* hin; bf16_t* hout; float* fout; unsigned char* ws; int par_out;
    struct Pre { u32x4 hv[2]; u32x4 pp[2]; float rs; };
    __device__ __forceinline__ void load(Pre& p, const Unit& u, int g8, int wr, int wc, int fr, int fq) const {
        const int ai = g8 >> 2, m = g8 & 3, row = u.pm * BM + ai * HALF + wr * 64 + m * 16 + fr, cb = u.pn * BM + wc * 64 + 8 * fq;
#pragma unroll
        for (int bj = 0; bj < 2; ++bj) p.hv[bj] = *(const u32x4*)(hin + (size_t)row * DM + cb + 32 * bj);
        if (GATED) { const bf16_t* PP = (const bf16_t*)(ws + WS_PPROJ);
#pragma unroll
            for (int bj = 0; bj < 2; ++bj) p.pp[bj] = *(const u32x4*)(PP + (size_t)row * DM + cb + 32 * bj);
            const float* sq = (const float*)(ws + (par_out ? TAB_SSQ0 : TAB_SSQ1));
            p.rs = (sq[row] + sq[NTOK + row]) + (sq[2 * NTOK + row] + sq[3 * NTOK + row]); }
    }
    __device__ __forceinline__ void fused(f32x4 (&acc)[2][2][4][2], const Unit& u, int wr, int wc, int fr, int fq, PG8_LAS unsigned char* lds, int wid, int lane) const {
        float* ssq_out = (float*)(ws + (par_out ? TAB_SSQ1 : TAB_SSQ0));
        PG8_LAS float* P = (PG8_LAS float*)lds;
        const int cb = u.pn * BM + wc * 64 + 8 * fq;
        Pre pa, pb;
        load(pa, u, 0, wr, wc, fr, fq);
#pragma unroll
        for (int g8 = 0; g8 < 8; ++g8) {
            Pre& cur = (g8 & 1) ? pb : pa; Pre& nxt = (g8 & 1) ? pa : pb;
            if (g8 + 1 < 8) load(nxt, u, g8 + 1, wr, wc, fr, fq);
            const int ai = g8 >> 2, m = g8 & 3, rl = ai * HALF + wr * 64 + m * 16 + fr, row = u.pm * BM + rl;
            float rs = 1.f; if (GATED) rs = __builtin_amdgcn_rsqf(cur.rs * (1.0f / 1024.0f) + 1e-6f);
            float ss = 0.f;
#pragma unroll
            for (int bj = 0; bj < 2; ++bj) {
                const u32x4 hw = cur.hv[bj];
                f32x4 o0 = (f32x4){bf_lo(hw.x), bf_hi(hw.x), bf_lo(hw.y), bf_hi(hw.y)}, o1 = (f32x4){bf_lo(hw.z), bf_hi(hw.z), bf_lo(hw.w), bf_hi(hw.w)};
                f32x4 a0 = acc[ai][bj][m][0], a1 = acc[ai][bj][m][1];
                if (GATED) { const u32x4 pw = cur.pp[bj];
                    a0[0] = sigmoid_fast(a0[0] * rs) * bf_lo(pw.x); a0[1] = sigmoid_fast(a0[1] * rs) * bf_hi(pw.x);
                    a0[2] = sigmoid_fast(a0[2] * rs) * bf_lo(pw.y); a0[3] = sigmoid_fast(a0[3] * rs) * bf_hi(pw.y);
                    a1[0] = sigmoid_fast(a1[0] * rs) * bf_lo(pw.z); a1[1] = sigmoid_fast(a1[1] * rs) * bf_hi(pw.z);
                    a1[2] = sigmoid_fast(a1[2] * rs) * bf_lo(pw.w); a1[3] = sigmoid_fast(a1[3] * rs) * bf_hi(pw.w); }
                o0 += a0; o1 += a1;
                ss += (o0[0] * o0[0] + o0[1] * o0[1]) + (o0[2] * o0[2] + o0[3] * o0[3]) + (o1[0] * o1[0] + o1[1] * o1[1]) + (o1[2] * o1[2] + o1[3] * o1[3]);
                if (fout) { float* fp = fout + (size_t)row * DM + cb + 32 * bj; *(f32x4*)fp = o0; *(f32x4*)(fp + 4) = o1; }
                else { float t[8] = {o0[0], o0[1], o0[2], o0[3], o1[0], o1[1], o1[2], o1[3]}; store8(hout + (size_t)row * DM + cb + 32 * bj, t); }
            }
            ss = add_xor16(ss); ss = add_xor32(ss);
            if (fq == 0) P[rl * 4 + wc] = ss;
        }
        asm volatile("s_waitcnt lgkmcnt(0)" ::: "memory"); __builtin_amdgcn_s_barrier(); asm volatile("" ::: "memory");
        const int tid = wid * 64 + lane;
        if (tid < 256) ssq_out[u.pn * NTOK + u.pm * BM + tid] = (P[tid * 4] + P[tid * 4 + 1]) + (P[tid * 4 + 2] + P[tid * 4 + 3]);
        asm volatile("s_waitcnt lgkmcnt(0)" ::: "memory"); __builtin_amdgcn_s_barrier(); asm volatile("" ::: "memory");
    }
};
struct EpiNull {
    static constexpr bool PERM = false, AFTER_DRAIN = true;
    __device__ __forceinline__ void fused(f32x4 (&acc)[2][2][4][2], const Unit& u, int wr, int wc, int fr, int fq, PG8_LAS unsigned char* lds, int wid, int lane) const {
#pragma unroll
        for (int a = 0; a < 2; ++a)
#pragma unroll
            for (int b = 0; b < 2; ++b)
#pragma unroll
                for (int m = 0; m < 4; ++m)
#pragma unroll
                    for (int n = 0; n < 2; ++n) asm volatile("" :: "v"(acc[a][b][m][n]));
    }
};
}
typedef unsigned short bf16;
#define LAS __attribute__((address_space(3)))
typedef unsigned v4u __attribute__((ext_vector_type(4)));
typedef unsigned v2u __attribute__((ext_vector_type(2)));
typedef float f32x4 __attribute__((ext_vector_type(4)));
typedef short bf16x8 __attribute__((ext_vector_type(8)));
typedef short s16x4 __attribute__((ext_vector_type(4)));
constexpr int NWAVES = 8;
__device__ __forceinline__ float max_xor16(float v) { return fmaxf(v, xor_lane<16>(v)); }
__device__ __forceinline__ float max_xor32(float v) { auto r = __builtin_amdgcn_permlane32_swap(__float_as_uint(v), __float_as_uint(v), false, false); return fmaxf(__uint_as_float(r[0]), __uint_as_float(r[1])); }
__device__ __forceinline__ bf16x8 tr_frag(LAS const unsigned char* p, LAS const unsigned char* p2) {
    const s16x4 lo = __builtin_bit_cast(s16x4, __builtin_amdgcn_ds_read_tr16_b64_v4i16((LAS s16x4*)p));
    const s16x4 hi = __builtin_bit_cast(s16x4, __builtin_amdgcn_ds_read_tr16_b64_v4i16((LAS s16x4*)p2));
    return (bf16x8){lo[0], lo[1], lo[2], lo[3], hi[0], hi[1], hi[2], hi[3]};
}
#define WG_BARRIER() do { asm volatile("s_waitcnt vmcnt(0) lgkmcnt(0)" ::: "memory"); __builtin_amdgcn_s_barrier(); asm volatile("" ::: "memory"); } while (0)

constexpr int GM_ROWB = 528;
constexpr int GM_SS = 128 * GM_ROWB;
__device__ __forceinline__ void gmlp_item(unsigned char* ws, int L, LAS unsigned char* lds, int item, int wv, int lane_unused) {
    const int lane = fresh_lane();
    const int half = item & 1, tok0 = (item >> 1) * 128, tid = wv * 64 + lane;
    const bf16* VLN = (const bf16*)(ws + WS_VLN); const bf16* U = (const bf16*)(ws + WS_U); bf16* YC = (bf16*)(ws + WS_YCAT);
    const bf16* GW = (const bf16*)(ws + TAB_GW) + (size_t)L * 4 * 128 * 128;
    const float* bsv = (const float*)(ws + TAB_SMALL) + L * SM_STRIDE + SM_GBS;
    { v4u xs[8];
#pragma unroll
      for (int i = 0; i < 8; ++i) if (i < 4 || half) { const int q = tid + i * 512, s = q >> 5, c = q & 31; xs[i] = *(const v4u*)(VLN + (size_t)(tok0 + s) * 256 + c * 8); }
#pragma unroll
      for (int i = 0; i < 8; ++i) if (i < 4 || half) { const int q = tid + i * 512, s = q >> 5, c = q & 31; *(LAS v4u*)(lds + s * GM_ROWB + c * 16) = xs[i]; } }
    const int h = wv >> 1, tq = 64 * half + 32 * (wv & 1), fr = lane & 15, g4 = lane >> 4;
    bf16x8 wfa[2][4];
#pragma unroll
    for (int m = 0; m < 2; ++m)
#pragma unroll
        for (int ks = 0; ks < 4; ++ks) if (32 * ks <= tq + 16 * m + 15) wfa[m][ks] = *(const bf16x8*)(GW + ((size_t)h * 128 + tq + 16 * m + fr) * 128 + 32 * ks + 8 * g4);
    v2u uwa[2][4];
#pragma unroll
    for (int m = 0; m < 2; ++m)
#pragma unroll
        for (int n = 0; n < 4; ++n) uwa[m][n] = *(const v2u*)(U + (size_t)(tok0 + tq + 16 * m + fr) * 256 + h * 64 + 16 * n + 4 * g4);
    WG_BARRIER();
    f32x4 acc[2][4];
#pragma unroll
    for (int m = 0; m < 2; ++m)
#pragma unroll
        for (int n = 0; n < 4; ++n) acc[m][n] = (f32x4){0.f, 0.f, 0.f, 0.f};
#pragma unroll
    for (int m = 0; m < 2; ++m) {
#pragma unroll
        for (int ks = 0; ks < 4; ++ks) {
            if (32 * ks <= tq + 16 * m + 15) {
#pragma unroll
                for (int n = 0; n < 4; ++n) {
                    LAS const unsigned char* p = lds + (32 * ks + 8 * g4 + (fr >> 2)) * GM_ROWB + (h * 64 + 16 * n + 4 * (fr & 3)) * 2;
                    const bf16x8 vf = tr_frag(p, p + 4 * GM_ROWB);
                    acc[m][n] = __builtin_amdgcn_mfma_f32_16x16x32_bf16(vf, wfa[m][ks], acc[m][n], 0, 0, 0);
                }
            }
        }
    }
    LAS float* SS = (LAS float*)(lds + GM_SS);
#pragma unroll
    for (int m = 0; m < 2; ++m) {
        const int t = tq + 16 * m + fr; const float bb = bsv[h * 128 + t]; float ss = 0.f;
#pragma unroll
        for (int n = 0; n < 4; ++n) {
            const v2u uw = uwa[m][n];
            f32x4 y; y[0] = bf_lo(uw.x) * (acc[m][n][0] + bb); y[1] = bf_hi(uw.x) * (acc[m][n][1] + bb); y[2] = bf_lo(uw.y) * (acc[m][n][2] + bb); y[3] = bf_hi(uw.y) * (acc[m][n][3] + bb);
            acc[m][n] = y; ss += (y[0] * y[0] + y[1] * y[1]) + (y[2] * y[2] + y[3] * y[3]);
        }
        ss = add_xor16(ss); ss = add_xor32(ss);
        if (g4 == 0) SS[h * 128 + t] = ss;
    }
    WG_BARRIER();
#pragma unroll
    for (int m = 0; m < 2; ++m) {
        const int t = tq + 16 * m + fr;
        const float tot = (SS[t] + SS[128 + t]) + (SS[256 + t] + SS[384 + t]);
        const float r = __builtin_amdgcn_rsqf(tot * (1.0f / 256.0f) + 1e-6f);
#pragma unroll
        for (int n = 0; n < 4; ++n) { v2u o; o.x = pk2(acc[m][n][0] * r, acc[m][n][1] * r); o.y = pk2(acc[m][n][2] * r, acc[m][n][3] * r);
            *(v2u*)(YC + (size_t)(tok0 + t) * DM + h * 64 + 16 * n + 4 * g4) = o; }
    }
    WG_BARRIER();
}

constexpr int AT_ROWB = 272;
constexpr int AT_V = 192 * AT_ROWB, AT_SS = 2 * 192 * AT_ROWB;
__device__ __forceinline__ void attn_item(unsigned char* ws, int L, LAS unsigned char* lds, int item, int wv, int lane_unused) {
    const int lane = fresh_lane();
    const int b = item >> 7, q0 = (item & 127) * 64, tokb = b * SEQL, tid = wv * 64 + lane;
    const bf16* Q = (const bf16*)(ws + WS_Q); const bf16* K = (const bf16*)(ws + WS_K); const bf16* V = (const bf16*)(ws + WS_V); bf16* YC = (bf16*)(ws + WS_YCAT);
    { v4u kx[6], vx[6];
#pragma unroll
      for (int i = 0; i < 6; ++i) { const int q = tid + i * 512, r = q >> 4, c = q & 15, j = q0 - 128 + r; kx[i] = (v4u){0u, 0u, 0u, 0u}; vx[i] = kx[i];
          if (j >= 0) { kx[i] = *(const v4u*)(K + (size_t)(tokb + j) * 128 + c * 8); vx[i] = *(const v4u*)(V + (size_t)(tokb + j) * 128 + c * 8); } }
#pragma unroll
      for (int i = 0; i < 6; ++i) { const int q = tid + i * 512, r = q >> 4, c = q & 15; *(LAS v4u*)(lds + r * AT_ROWB + c * 16) = kx[i]; *(LAS v4u*)(lds + AT_V + r * AT_ROWB + c * 16) = vx[i]; } }
    const int hq = wv, hkv = wv >> 2, fr = lane & 15, g4 = lane >> 4;
    bf16x8 qfa[4][2];
#pragma unroll
    for (int qt = 0; qt < 4; ++qt)
#pragma unroll
        for (int ks = 0; ks < 2; ++ks) qfa[qt][ks] = *(const bf16x8*)(Q + (size_t)(tokb + q0 + 16 * qt + fr) * 512 + hq * 64 + 32 * ks + 8 * g4);
    WG_BARRIER();
    const float sink2 = ((const float*)(ws + TAB_SMALL))[L * SM_STRIDE + SM_SINK + hq] * LOG2E;
    LAS float* SS = (LAS float*)(lds + AT_SS);
    const bool edge = (q0 < 128);
#pragma unroll
    for (int qt = 0; qt < 4; ++qt) {
        const size_t tq = (size_t)(tokb + q0 + 16 * qt + fr);
        const bf16x8 qf[2] = {qfa[qt][0], qfa[qt][1]};
        f32x4 s[9];
#pragma unroll
        for (int i = 0; i < 9; ++i) { s[i] = (f32x4){0.f, 0.f, 0.f, 0.f};
#pragma unroll
            for (int ks = 0; ks < 2; ++ks) { const bf16x8 kf = *(LAS const bf16x8*)(lds + (16 * (qt + i) + fr) * AT_ROWB + (hkv * 64 + 32 * ks + 8 * g4) * 2);
                s[i] = __builtin_amdgcn_mfma_f32_16x16x32_bf16(kf, qf[ks], s[i], 0, 0, 0); } }
        const int dd = fr - 4 * g4;
#pragma unroll
        for (int r = 0; r < 4; ++r) { s[0][r] = (r > dd) ? s[0][r] : -INFINITY; s[8][r] = (r <= dd) ? s[8][r] : -INFINITY; }
        if (edge) { const int j0 = q0 - 128 + 16 * qt + 4 * g4;
#pragma unroll
            for (int i = 0; i < 9; ++i)
#pragma unroll
                for (int r = 0; r < 4; ++r) s[i][r] = (j0 + 16 * i + r >= 0) ? s[i][r] : -INFINITY; }
        float mx = sink2;
#pragma unroll
        for (int i = 0; i < 9; ++i) mx = fmaxf(fmaxf(mx, fmaxf(s[i][0], s[i][1])), fmaxf(s[i][2], s[i][3]));
        mx = max_xor16(mx); mx = max_xor32(mx);
        float sum = 0.f;
#pragma unroll
        for (int i = 0; i < 9; ++i)
#pragma unroll
            for (int r = 0; r < 4; ++r) { s[i][r] = __builtin_amdgcn_exp2f(s[i][r] - mx); sum += s[i][r]; }
        sum = add_xor16(sum); sum = add_xor32(sum); sum += __builtin_amdgcn_exp2f(sink2 - mx);
        const float inv_l = __builtin_amdgcn_rcpf(sum);
        f32x4 o[4];
#pragma unroll
        for (int dt = 0; dt < 4; ++dt) o[dt] = (f32x4){0.f, 0.f, 0.f, 0.f};
#pragma unroll
        for (int kk = 0; kk < 5; ++kk) {
            const int ia = 2 * kk - (qt & 1), ib = ia + 1;
            v4u pw;
            pw.x = (ia >= 0) ? pk2(s[ia < 0 ? 0 : ia][0], s[ia < 0 ? 0 : ia][1]) : 0u; pw.y = (ia >= 0) ? pk2(s[ia < 0 ? 0 : ia][2], s[ia < 0 ? 0 : ia][3]) : 0u;
            pw.z = (ib <= 8) ? pk2(s[ib > 8 ? 8 : ib][0], s[ib > 8 ? 8 : ib][1]) : 0u; pw.w = (ib <= 8) ? pk2(s[ib > 8 ? 8 : ib][2], s[ib > 8 ? 8 : ib][3]) : 0u;
            const bf16x8 pf = __builtin_bit_cast(bf16x8, pw);
            const int ktb = (qt & ~1) + 2 * kk;
#pragma unroll
            for (int dt = 0; dt < 4; ++dt) {
                LAS const unsigned char* p = lds + AT_V + (16 * ktb + 4 * g4 + (fr >> 2)) * AT_ROWB + (hkv * 64 + 16 * dt + 4 * (fr & 3)) * 2;
                const bf16x8 vf = tr_frag(p, p + 16 * AT_ROWB);
                o[dt] = __builtin_amdgcn_mfma_f32_16x16x32_bf16(vf, pf, o[dt], 0, 0, 0);
            }
        }
        float ss = 0.f;
#pragma unroll
        for (int dt = 0; dt < 4; ++dt) { o[dt] = o[dt] * inv_l; ss += (o[dt][0] * o[dt][0] + o[dt][1] * o[dt][1]) + (o[dt][2] * o[dt][2] + o[dt][3] * o[dt][3]); }
        ss = add_xor16(ss); ss = add_xor32(ss);
        if (g4 == 0) SS[hq * 64 + 16 * qt + fr] = ss;
        WG_BARRIER();
        float tot = 0.f;
#pragma unroll
        for (int hh = 0; hh < 8; ++hh) tot += SS[hh * 64 + 16 * qt + fr];
        const float r = __builtin_amdgcn_rsqf(tot * (1.0f / 512.0f) + 1e-6f);
#pragma unroll
        for (int dt = 0; dt < 4; ++dt) { v2u ow; ow.x = pk2(o[dt][0] * r, o[dt][1] * r); ow.y = pk2(o[dt][2] * r, o[dt][3] * r);
            *(v2u*)(YC + tq * DM + 256 + hq * 64 + 16 * dt + 4 * g4) = ow; }
    }
    WG_BARRIER();
}
__device__ __forceinline__ double d_exp(double x) {
    const double k = __builtin_rint(x * 1.4426950408889634), r = x - k * 0.6931471805599453;
    double e = 1.0, term = 1.0;
    for (int n = 1; n <= 20; ++n) { term *= r / (double)n; e += term; }
    const long long bits = (long long)(1023 + (int)k) << 52;
    return e * __builtin_bit_cast(double, bits);
}
__device__ __forceinline__ void d_sincos(double th, double& sn, double& cs) {
    const double q = __builtin_rint(th * 0.15915494309189535), r = th - q * 6.283185307179586, r2 = -r * r;
    double s = r, c = 1.0, ts = r, tc = 1.0;
    for (int n = 1; n <= 14; ++n) { tc *= r2 / (double)((2 * n - 1) * (2 * n)); c += tc; ts *= r2 / (double)((2 * n) * (2 * n + 1)); s += ts; }
    sn = s; cs = c;
}
__device__ __forceinline__ void ssm_tables(const float* const* in, unsigned char* ws, int gtid, int nthreads) {
    for (int i = gtid; i < NLAYER * 16 * 64; i += nthreads) {
        const int p = i & 63, lg = i >> 6;
        const double lre = in[12][i], lim = in[13][i], dt = d_exp((double)in[14][lg]);
        const double er = d_exp(lre * dt); double sn, cs; d_sincos(lim * dt, sn, cs);
        const double lbr = er * cs, lbi = er * sn;
        const double nr = lbr - 1.0, ni = lbi, den = lre * lre + lim * lim;
        const double fr_ = (nr * lre + ni * lim) / den, fi_ = (ni * lre - nr * lim) / den;
        float* bbc = (float*)(ws + SSM_BBC) + (size_t)i * 32; bf16* bbt = (bf16*)(ws + SSM_BBT) + (size_t)lg * 128 * 16;
        for (int h = 0; h < 16; ++h) { const double br = in[15][i * 16 + h], bi = in[16][i * 16 + h]; const float re = (float)(fr_ * br - fi_ * bi), im = (float)(fr_ * bi + fi_ * br);
            bbc[2 * h] = re; bbc[2 * h + 1] = im; bbt[p * 16 + h] = (bf16)(pk2(re, 0.f) & 0xffffu); bbt[(64 + p) * 16 + h] = (bf16)(pk2(im, 0.f) & 0xffffu); }
        bf16* cct = (bf16*)(ws + SSM_CCT) + (size_t)lg * 16 * 128;
        for (int hp = 0; hp < 16; ++hp) { const float cre = in[17][(lg * 16 + hp) * 64 + p], cim = in[18][(lg * 16 + hp) * 64 + p]; *(unsigned*)(cct + hp * 128 + 2 * p) = pk2(cre, -cim); }
        float* pw = (float*)(ws + SSM_PW) + (size_t)lg * 65 * 128;
        double xr = 1.0, xi = 0.0;
        for (int n = 0; n <= 64; ++n) { pw[(n * 64 + p) * 2] = (float)xr; pw[(n * 64 + p) * 2 + 1] = (float)xi;
            const double t = xr * lbr - xi * lbi; xi = xr * lbi + xi * lbr; xr = t; }
    }
}
__device__ __forceinline__ void ssm_ktable(const float* const* in, unsigned char* ws, int gwave, int nwaves) {
    const int lane = fresh_lane(), hp = lane >> 2, h4 = (lane & 3) * 4;
    bf16* KT = (bf16*)(ws + SSM_KT);
    for (int it = gwave; it < NLAYER * 16 * 64; it += nwaves) {
        const int tau = it & 63, lg = it >> 6;
        const float* pw = (const float*)(ws + SSM_PW) + ((size_t)lg * 65 + tau) * 128; const float* bbc = (const float*)(ws + SSM_BBC) + (size_t)lg * 64 * 32 + 2 * h4;
        const float* cre = in[17] + (size_t)(lg * 16 + hp) * 64; const float* cim = in[18] + (size_t)(lg * 16 + hp) * 64;
        float acc[4] = {0.f, 0.f, 0.f, 0.f};
#pragma unroll 2
        for (int p0 = 0; p0 < 64; p0 += 8) {
            f32x4 cr[2], ci[2], zw[4], bb[8][2];
#pragma unroll
            for (int k = 0; k < 2; ++k) { cr[k] = *(const f32x4*)(cre + p0 + 4 * k); ci[k] = *(const f32x4*)(cim + p0 + 4 * k); }
#pragma unroll
            for (int k = 0; k < 4; ++k) zw[k] = *(const f32x4*)(pw + 2 * p0 + 4 * k);
#pragma unroll
            for (int k = 0; k < 8; ++k) { bb[k][0] = *(const f32x4*)(bbc + (size_t)(p0 + k) * 32); bb[k][1] = *(const f32x4*)(bbc + (size_t)(p0 + k) * 32 + 4); }
#pragma unroll
            for (int k = 0; k < 8; ++k) { const float c_r = cr[k >> 2][k & 3], c_i = ci[k >> 2][k & 3], zr = zw[k >> 1][2 * (k & 1)], zi = zw[k >> 1][2 * (k & 1) + 1];
                const float pr = c_r * zr - c_i * zi, pi = c_r * zi + c_i * zr;
                acc[0] += pr * bb[k][0][0] - pi * bb[k][0][1]; acc[1] += pr * bb[k][0][2] - pi * bb[k][0][3]; acc[2] += pr * bb[k][1][0] - pi * bb[k][1][1]; acc[3] += pr * bb[k][1][2] - pi * bb[k][1][3]; }
        }
        if (tau == 0 && hp >= h4 && hp < h4 + 4) { const float dv = in[19][lg * 16 + hp];
#pragma unroll
            for (int j = 0; j < 4; ++j) if (h4 + j == hp) acc[j] += dv; }
        v2u o; o.x = pk2(acc[0], acc[1]); o.y = pk2(acc[2], acc[3]);
        *(v2u*)(KT + (size_t)it * 256 + hp * 16 + h4) = o;
    }
}
__device__ __forceinline__ void ssm1_item(unsigned char* ws, int L, int item, int wv, int lane_unused) {
    const int tok0 = item * 64;
    const bf16* ZC = (const bf16*)(ws + WS_ZC); float* S = (float*)(ws + SSM_S);
    const bf16x8 zero8 = (bf16x8){0, 0, 0, 0, 0, 0, 0, 0};
    for (int gi = 0; gi < 2; ++gi) {
        const int g = 2 * wv + gi, lg = L * 16 + g;
        const int lane = fresh_lane(), fr = lane & 15, g4 = lane >> 4;
        const bf16* bbt = (const bf16*)(ws + SSM_BBT) + (size_t)lg * 128 * 16; const float* pw = (const float*)(ws + SSM_PW) + (size_t)lg * 65 * 128;
        bf16x8 bfr[8];
#pragma unroll
        for (int n = 0; n < 8; ++n) bfr[n] = (g4 < 2) ? *(const bf16x8*)(bbt + (16 * n + fr) * 16 + 8 * g4) : zero8;
        bf16x8 uf[4];
#pragma unroll
        for (int m = 0; m < 4; ++m) uf[m] = (g4 < 2) ? *(const bf16x8*)(ZC + (size_t)(tok0 + 16 * m + fr) * 256 + g * 16 + 8 * g4) : zero8;
        f32x2_t l1[4], l16[4], lg4[4];
#pragma unroll
        for (int q = 0; q < 4; ++q) { l1[q] = *(const f32x2_t*)(pw + (1 * 64 + 16 * q + fr) * 2); l16[q] = *(const f32x2_t*)(pw + (16 * 64 + 16 * q + fr) * 2); lg4[q] = *(const f32x2_t*)(pw + ((12 - 4 * g4) * 64 + 16 * q + fr) * 2); }
        float sre[4] = {0.f, 0.f, 0.f, 0.f}, sim[4] = {0.f, 0.f, 0.f, 0.f}, hre[4], him[4];
#pragma unroll
        for (int m = 0; m < 4; ++m) {
            f32x4 d[8];
#pragma unroll
            for (int n = 0; n < 8; ++n) d[n] = __builtin_amdgcn_mfma_f32_16x16x32_bf16(uf[m], bfr[n], (f32x4){0.f, 0.f, 0.f, 0.f}, 0, 0, 0);
#pragma unroll
            for (int q = 0; q < 4; ++q) {
                float ir = d[q][0], ii = d[q + 4][0];
#pragma unroll
                for (int r = 1; r < 4; ++r) { const float t = l1[q][0] * ir - l1[q][1] * ii + d[q][r]; ii = l1[q][0] * ii + l1[q][1] * ir + d[q + 4][r]; ir = t; }
                const float t = l16[q][0] * sre[q] - l16[q][1] * sim[q] + ir; sim[q] = l16[q][0] * sim[q] + l16[q][1] * sre[q] + ii; sre[q] = t;
                if (m == 1) { hre[q] = sre[q]; him[q] = sim[q]; }
            }
        }
#pragma unroll
        for (int q = 0; q < 4; ++q) { const float t = lg4[q][0] * sre[q] - lg4[q][1] * sim[q]; sim[q] = lg4[q][0] * sim[q] + lg4[q][1] * sre[q]; sre[q] = t;
            const float t2 = lg4[q][0] * hre[q] - lg4[q][1] * him[q]; him[q] = lg4[q][0] * him[q] + lg4[q][1] * hre[q]; hre[q] = t2; }
        float* S32 = (float*)(ws + SSM_S32);
#pragma unroll
        for (int q = 0; q < 4; ++q) { sre[q] = add_xor16(sre[q]); sre[q] = add_xor32(sre[q]); sim[q] = add_xor16(sim[q]); sim[q] = add_xor32(sim[q]);
            hre[q] = add_xor16(hre[q]); hre[q] = add_xor32(hre[q]); him[q] = add_xor16(him[q]); him[q] = add_xor32(him[q]);
            if (g4 == 0) { *(f32x2_t*)(S + ((size_t)(item * 16 + g) * 64 + 16 * q + fr) * 2) = (f32x2_t){sre[q], sim[q]}; *(f32x2_t*)(S32 + ((size_t)(item * 16 + g) * 64 + 16 * q + fr) * 2) = (f32x2_t){hre[q], him[q]}; } }
    }
}
__device__ __forceinline__ void ssm_scan(unsigned char* ws, int L, LAS unsigned char* lds, int bg, int wv) {
    const int lane = fresh_lane(), b = bg >> 4, g = bg & 15;
    const f32x2_t lam = *(const f32x2_t*)((const float*)(ws + SSM_PW) + ((size_t)(L * 16 + g) * 65 + 64) * 128 + 2 * lane);
    float* sp = (float*)(ws + SSM_S) + (((size_t)(b * 128 + 16 * wv) * 16 + g) * 64 + lane) * 2;
    f32x2_t sv[16];
#pragma unroll
    for (int j = 0; j < 16; ++j) sv[j] = *(const f32x2_t*)(sp + (size_t)j * 2048);
    float pr[16], pi[16]; float xr = 0.f, xi = 0.f, wr = 1.f, wi = 0.f;
#pragma unroll
    for (int j = 0; j < 16; ++j) { pr[j] = xr; pi[j] = xi; const float t = lam[0] * xr - lam[1] * xi + sv[j][0]; xi = lam[0] * xi + lam[1] * xr + sv[j][1]; xr = t;
        const float tw = wr * lam[0] - wi * lam[1]; wi = wr * lam[1] + wi * lam[0]; wr = tw; }
    LAS f32x2_t* E = (LAS f32x2_t*)lds;
    E[wv * 64 + lane] = (f32x2_t){xr, xi};
    WG_BARRIER();
    float br = 0.f, bi = 0.f;
    for (int w2 = 0; w2 < wv; ++w2) { const f32x2_t e = E[w2 * 64 + lane]; const float t = wr * br - wi * bi + e[0]; bi = wr * bi + wi * br + e[1]; br = t; }
    float qr = 1.f, qi = 0.f;
#pragma unroll
    for (int j = 0; j < 16; ++j) { *(f32x2_t*)(sp + (size_t)j * 2048) = (f32x2_t){qr * br - qi * bi + pr[j], qr * bi + qi * br + pi[j]};
        const float tq = qr * lam[0] - qi * lam[1]; qi = qr * lam[1] + qi * lam[0]; qr = tq; }
    WG_BARRIER();
}
constexpr int S2_ROWB = 528, S2_XIN = 96 * S2_ROWB, S2_XMID = S2_XIN + 8192, S2_YT = S2_XMID + 8192, S2_SS = S2_YT + 64 * S2_ROWB;
__device__ __forceinline__ void ssm2_item(unsigned char* ws, int L, LAS unsigned char* lds, int item, int wv, int lane_unused) {
    const int lane = fresh_lane();
    const int tok0 = item * 64, tid = wv * 64 + lane;
    const bf16* ZC = (const bf16*)(ws + WS_ZC); const float* S = (const float*)(ws + SSM_S); const float* S32 = (const float*)(ws + SSM_S32);
    { v4u xs[6];
#pragma unroll
      for (int i = 0; i < 6; ++i) { const int q = tid + i * 512, r = q >> 5, cc = q & 31; xs[i] = (v4u){0u, 0u, 0u, 0u};
          if (r >= 16 && r < 48) xs[i] = *(const v4u*)(ZC + (size_t)(tok0 + r - 16) * 256 + cc * 8); else if (r >= 64) xs[i] = *(const v4u*)(ZC + (size_t)(tok0 + r - 32) * 256 + cc * 8); }
      f32x2_t xin[2], s32v[2], l32[2];
#pragma unroll
      for (int k = 0; k < 2; ++k) { const int ch = tid + 512 * k; xin[k] = *(const f32x2_t*)(S + ((size_t)item * 1024 + ch) * 2); s32v[k] = *(const f32x2_t*)(S32 + ((size_t)item * 1024 + ch) * 2);
          l32[k] = *(const f32x2_t*)((const float*)(ws + SSM_PW) + ((size_t)(L * 16 + (ch >> 6)) * 65 + 32) * 128 + 2 * (ch & 63)); }
#pragma unroll
      for (int i = 0; i < 6; ++i) { const int q = tid + i * 512, r = q >> 5, cc = q & 31; *(LAS v4u*)(lds + r * S2_ROWB + cc * 16) = xs[i]; }
#pragma unroll
      for (int k = 0; k < 2; ++k) { const int ch = tid + 512 * k; *(LAS f32x2_t*)(lds + S2_XIN + ch * 8) = xin[k];
          *(LAS f32x2_t*)(lds + S2_XMID + ch * 8) = (f32x2_t){l32[k][0] * xin[k][0] - l32[k][1] * xin[k][1] + s32v[k][0], l32[k][0] * xin[k][1] + l32[k][1] * xin[k][0] + s32v[k][1]}; } }
    const int fr = lane & 15, g4 = lane >> 4;
    bf16x8 kfa[2][16], cfa[2][4]; f32x4 pwa[2][2][4][2];
#define S2_LOAD_K(gi) do { const bf16* kt = (const bf16*)(ws + SSM_KT) + (size_t)(L * 16 + 2 * wv + (gi)) * 64 * 256 + fr * 16 + 8 * (g4 & 1); \
        _Pragma("unroll") for (int lp = 0; lp < 16; ++lp) kfa[gi][lp] = *(const bf16x8*)(kt + (2 * lp + (g4 >> 1)) * 256); } while (0)
#define S2_LOAD_C(gi) do { const int lg_ = L * 16 + 2 * wv + (gi); const bf16* cct = (const bf16*)(ws + SSM_CCT) + (size_t)lg_ * 16 * 128 + fr * 128 + 8 * g4; \
        _Pragma("unroll") for (int ks = 0; ks < 4; ++ks) cfa[gi][ks] = *(const bf16x8*)(cct + 32 * ks); \
        const float* pwg = (const float*)(ws + SSM_PW) + (size_t)lg_ * 65 * 128; \
        _Pragma("unroll") for (int mh = 0; mh < 2; ++mh) _Pragma("unroll") for (int ks = 0; ks < 4; ++ks) { const float* w = pwg + ((size_t)(16 * mh + fr + 1) * 64 + 16 * ks + 4 * g4) * 2; \
            pwa[gi][mh][ks][0] = *(const f32x4*)w; pwa[gi][mh][ks][1] = *(const f32x4*)(w + 4); } } while (0)
    S2_LOAD_K(0); S2_LOAD_C(0);
    WG_BARRIER();
#pragma unroll
    for (int gi = 0; gi < 2; ++gi) {
        const int g = 2 * wv + gi;
        if (gi == 0) { S2_LOAD_K(1); }
        f32x4 acc[4];
#pragma unroll
        for (int m = 0; m < 4; ++m) acc[m] = (f32x4){0.f, 0.f, 0.f, 0.f};
#pragma unroll
        for (int m = 0; m < 4; ++m) {
            LAS const unsigned char* ub = lds + (16 + 16 * m + ((m >> 1) << 4) + fr - (g4 >> 1)) * S2_ROWB + (g * 16 + 8 * (g4 & 1)) * 2;
#pragma unroll
            for (int lp = 0; lp < 8 * (m & 1) + 8; ++lp) { const bf16x8 uf = *(LAS const bf16x8*)(ub - 2 * lp * S2_ROWB); acc[m] = __builtin_amdgcn_mfma_f32_16x16x32_bf16(uf, kfa[gi][lp], acc[m], 0, 0, 0); }
        }
        if (gi == 0) { S2_LOAD_C(1); }
#pragma unroll
        for (int ks = 0; ks < 4; ++ks) {
            const int p4 = 16 * ks + 4 * g4;
#pragma unroll
            for (int m = 0; m < 4; ++m) {
                const int xo = ((m >> 1) ? S2_XMID : S2_XIN) + (g * 64 + p4) * 8;
                const f32x4 x01 = *(LAS const f32x4*)(lds + xo), x23 = *(LAS const f32x4*)(lds + xo + 16);
                const f32x4 w01 = pwa[gi][m & 1][ks][0], w23 = pwa[gi][m & 1][ks][1];
                v4u zw; zw.x = pk2(w01[0] * x01[0] - w01[1] * x01[1], w01[0] * x01[1] + w01[1] * x01[0]); zw.y = pk2(w01[2] * x01[2] - w01[3] * x01[3], w01[2] * x01[3] + w01[3] * x01[2]);
                zw.z = pk2(w23[0] * x23[0] - w23[1] * x23[1], w23[0] * x23[1] + w23[1] * x23[0]); zw.w = pk2(w23[2] * x23[2] - w23[3] * x23[3], w23[2] * x23[3] + w23[3] * x23[2]);
                acc[m] = __builtin_amdgcn_mfma_f32_16x16x32_bf16(__builtin_bit_cast(bf16x8, zw), cfa[gi][ks], acc[m], 0, 0, 0);
            }
        }
#pragma unroll
        for (int m = 0; m < 4; ++m)
#pragma unroll
            for (int r = 0; r < 4; ++r) *(LAS bf16*)(lds + S2_YT + (16 * m + 4 * g4 + r) * S2_ROWB + (g * 16 + fr) * 2) = (bf16)(pk2(gelu_fast(acc[m][r]), 0.f) & 0xffffu);
    }
#undef S2_LOAD_K
#undef S2_LOAD_C
    WG_BARRIER();
    {
        const int l2 = fresh_lane(), fr = l2 & 15, g4 = l2 >> 4;
        const bf16* wg = (const bf16*)(ws + WS_W + (size_t)L * LW_STRIDE + LW_GLU) + (size_t)(32 * wv + fr) * 256 + 8 * g4;
        LAS const unsigned char* yb = lds + S2_YT + fr * S2_ROWB + 16 * g4;
        f32x4 ga[2][4], gb[2][4];
#pragma unroll
        for (int nt = 0; nt < 2; ++nt)
#pragma unroll
            for (int m = 0; m < 4; ++m) { ga[nt][m] = (f32x4){0.f, 0.f, 0.f, 0.f}; gb[nt][m] = (f32x4){0.f, 0.f, 0.f, 0.f}; }
#pragma unroll
        for (int kh = 0; kh < 2; ++kh) {
            bf16x8 wa[4][2], wb[4][2];
#pragma unroll
            for (int k4 = 0; k4 < 4; ++k4)
#pragma unroll
                for (int nt = 0; nt < 2; ++nt) { wa[k4][nt] = *(const bf16x8*)(wg + (size_t)(16 * nt) * 256 + 32 * (4 * kh + k4)); wb[k4][nt] = *(const bf16x8*)(wg + (size_t)(256 + 16 * nt) * 256 + 32 * (4 * kh + k4)); }
#pragma unroll
            for (int k4 = 0; k4 < 4; ++k4) {
                bf16x8 yf[4];
#pragma unroll
                for (int m = 0; m < 4; ++m) yf[m] = *(LAS const bf16x8*)(yb + 16 * m * S2_ROWB + 64 * (4 * kh + k4));
#pragma unroll
                for (int nt = 0; nt < 2; ++nt)
#pragma unroll
                    for (int m = 0; m < 4; ++m) { ga[nt][m] = __builtin_amdgcn_mfma_f32_16x16x32_bf16(wa[k4][nt], yf[m], ga[nt][m], 0, 0, 0); gb[nt][m] = __builtin_amdgcn_mfma_f32_16x16x32_bf16(wb[k4][nt], yf[m], gb[nt][m], 0, 0, 0); }
            }
        }
        LAS float* SS = (LAS float*)(lds + S2_SS);
#pragma unroll
        for (int m = 0; m < 4; ++m) { float ss = 0.f;
#pragma unroll
            for (int nt = 0; nt < 2; ++nt)
#pragma unroll
                for (int r = 0; r < 4; ++r) { const float v = ga[nt][m][r] * sigmoid_fast(gb[nt][m][r]); ga[nt][m][r] = v; ss += v * v; }
            ss = add_xor16(ss); ss = add_xor32(ss);
            if (g4 == 0) SS[wv * 64 + 16 * m + fr] = ss; }
        WG_BARRIER();
        bf16* YC = (bf16*)(ws + WS_YCAT);
#pragma unroll
        for (int m = 0; m < 4; ++m) { float tot = 0.f;
#pragma unroll
            for (int w8 = 0; w8 < 8; ++w8) tot += SS[w8 * 64 + 16 * m + fr];
            const float rr = __builtin_amdgcn_rsqf(tot * (1.0f / 256.0f) + 1e-6f);
#pragma unroll
            for (int nt = 0; nt < 2; ++nt) { v2u o; o.x = pk2(ga[nt][m][0] * rr, ga[nt][m][1] * rr); o.y = pk2(ga[nt][m][2] * rr, ga[nt][m][3] * rr);
                *(v2u*)(YC + (size_t)(tok0 + 16 * m + fr) * DM + 768 + 32 * wv + 16 * nt + 4 * g4) = o; } }
    }
    WG_BARRIER();
}
#define XB_TMO      128
#define XB_XCNT(j)  (256  + 64 * (j))
#define XB_XSUB(j)  (1280 + 64 * (j))
#define XB_XGEN(j)  (2304 + 64 * (j))
#define XB_TOP      3328
#define XB_TOPGEN   3392
#define XCD_BAR_WORDS 3456
#define XB_SPIN_CAP (1u << 18)

__device__ __forceinline__ unsigned xb_ld(unsigned* p)              { return __hip_atomic_load(p, __ATOMIC_RELAXED, __HIP_MEMORY_SCOPE_AGENT); }
__device__ __forceinline__ unsigned xb_add(unsigned* p, unsigned v) { return __hip_atomic_fetch_add(p, v, __ATOMIC_RELAXED, __HIP_MEMORY_SCOPE_AGENT); }
__device__ __forceinline__ unsigned xb_xcc_id() { return (unsigned)__builtin_amdgcn_s_getreg((3 << 11) | 20) & 0xFu; }
#define XB_SPIN(cond, bar) do { unsigned _sp = 0; while (cond) { __builtin_amdgcn_s_sleep(1); \
    if ((++_sp & 255u) == 0u) { if (xb_ld(&(bar)[XB_TMO])) break; if (_sp > XB_SPIN_CAP) { atomicAdd(&(bar)[XB_TMO], 1u); break; } } } } while (0)

struct XcdBarrier {
    unsigned* bar; unsigned x;
    volatile LAS unsigned* st;
};

__device__ __forceinline__ XcdBarrier xcd_barrier_post(unsigned* bar, volatile LAS unsigned* st, bool leader) {
    XcdBarrier b; b.bar = bar; b.x = xb_xcc_id(); b.st = st;
    if (leader) (void)xb_add(&bar[XB_XCNT(b.x)], 1u);
    return b;
}
__device__ __forceinline__ void xcd_barrier_complete(unsigned* bar, unsigned x, unsigned& nloc, unsigned& nx) {
    const unsigned G = gridDim.x * gridDim.y * gridDim.z;
    unsigned sum, cnt, mine, sp = 0u;
    for (;;) {
        sum = 0u; cnt = 0u; mine = 0u;
#pragma unroll
        for (unsigned j = 0; j < 16; ++j) { const unsigned c = xb_ld(&bar[XB_XCNT(j)]); sum += c; cnt += (c > 0u) ? 1u : 0u; mine = (j == x) ? c : mine; }
        if (sum == G) break;
        __builtin_amdgcn_s_sleep(1);
        if ((++sp & 255u) == 0u) { if (xb_ld(&bar[XB_TMO])) break; if (sp > XB_SPIN_CAP) { atomicAdd(&bar[XB_TMO], 1u); break; } }
    }
    nloc = mine > 0u ? mine : 1u; nx = cnt > 0u ? cnt : 1u;
}

__device__ __forceinline__ void xcd_barrier(const XcdBarrier& b, bool leader) {
    asm volatile("s_waitcnt vmcnt(0)" ::: "memory");
    __syncthreads();
    if (leader) {
        unsigned* bar = b.bar;
        __builtin_amdgcn_s_waitcnt(0);
        unsigned nloc = b.st[0], nx = b.st[1];
        if (nloc == 0u) { xcd_barrier_complete(bar, b.x, nloc, nx); b.st[0] = nloc; b.st[1] = nx; }
        const unsigned old = xb_add(&bar[XB_XSUB(b.x)], 1u);
        const unsigned gen = old / nloc;
        if (old + 1u == (gen + 1u) * nloc) {
            __builtin_amdgcn_fence(__ATOMIC_RELEASE, "agent");
            asm volatile("s_waitcnt vmcnt(0)" ::: "memory");
            const unsigned og = xb_add(&bar[XB_TOP], 1u);
            const unsigned tg = og / nx;
            if (og + 1u == (tg + 1u) * nx) xb_add(&bar[XB_TOPGEN], 1u);
            else XB_SPIN(xb_ld(&bar[XB_TOPGEN]) == tg, bar);
            __builtin_amdgcn_fence(__ATOMIC_ACQUIRE, "agent");
            xb_add(&bar[XB_XGEN(b.x)], 1u);
            asm volatile("s_waitcnt vmcnt(0)" ::: "memory");
        } else {
            XB_SPIN(xb_ld(&bar[XB_XGEN(b.x)]) == gen, bar);
            __builtin_amdgcn_fence(__ATOMIC_ACQUIRE, "agent");
            asm volatile("s_waitcnt vmcnt(0)" ::: "memory");
        }
    }
    __syncthreads();
}
constexpr int LDS_BYTES = 147456;

__device__ __forceinline__ void prep_transpose_item(const float* W, int K, int N, const float* g, bf16* WT, LAS float* scr, int item, int lane, bool perm) {
    const int nblk = N / 64, kb = item / nblk, nb = item % nblk, k0 = 64 * kb, l0 = 64 * nb;
    const float* wp = W + (size_t)k0 * N + l0 + lane;
    float w[64];
#pragma unroll
    for (int i = 0; i < 64; ++i) w[i] = wp[(size_t)i * N];
    if (g) {
#pragma unroll
        for (int i = 0; i < 64; ++i) w[i] *= g[k0 + i];
    }
#pragma unroll
    for (int i = 0; i < 64; ++i) scr[i * 65 + lane] = w[i];
    asm volatile("s_waitcnt lgkmcnt(0)" ::: "memory");
    const int c = lane & 7;
#pragma unroll
    for (int j = 0; j < 8; ++j) { const int ll = (lane >> 3) + 8 * j;
        int prow;
        if (perm) { const int bj = ll >> 5, y = ll & 31, x = 16 * ((y >> 2) & 1) + 4 * (y >> 3) + (y & 3), wc = (l0 >> 6) & 3; prow = (l0 & ~255) + 128 * bj + 32 * wc + x; }
        else prow = l0 + ll;
        const LAS float* s = scr + (8 * c) * 65 + ll;
        v4u o; o.x = pk2(s[0 * 65], s[1 * 65]); o.y = pk2(s[2 * 65], s[3 * 65]); o.z = pk2(s[4 * 65], s[5 * 65]); o.w = pk2(s[6 * 65], s[7 * 65]);
        *(v4u*)(WT + (size_t)prow * K + k0 + 8 * c) = o; }
    asm volatile("s_waitcnt lgkmcnt(0)" ::: "memory");
}
__device__ __forceinline__ void convert_p(const float* pl, unsigned char* ws, int gw, int NGW) {
    const int lane = fresh_lane(); bf16* pb = (bf16*)(ws + WS_PB);
    for (int m = gw; m < NTOK; m += 4 * NGW) { f32x4 v[4];
#pragma unroll
        for (int u = 0; u < 4; ++u) v[u] = ((const f32x4*)(pl + (size_t)(m + u * NGW) * 256))[lane];
#pragma unroll
        for (int u = 0; u < 4; ++u) ((unsigned long long*)(pb + (size_t)(m + u * NGW) * 256))[lane] = (unsigned long long)pk2(v[u][0], v[u][1]) | ((unsigned long long)pk2(v[u][2], v[u][3]) << 32); }
}
struct Args { const float* in[30]; float* out; unsigned char* ws; int s_lo, s_hi; };

__device__ __forceinline__ void prologue_phase(const Args& a, unsigned char* ws, float* outp, LAS unsigned char* lds, int gw, int NGW, int wave, int lane) {
    LAS float* scr = (LAS float*)(lds + wave * 16640);
    constexpr int I_IN = 16 * 24, I_OUT = 16 * 16, I_FF1 = 16 * 64, I_FF2 = 64 * 16, I_GATE = 16 * 16, I_PROJ = 4 * 16, I_GLU = 4 * 4, I_L = I_IN + I_OUT + I_FF1 + I_FF2 + I_GATE + I_PROJ + 2 * I_GLU;
    for (int it = gw; it < NLAYER * I_L; it += NGW) {
        const int L = it / I_L; int r = it % I_L; unsigned char* wl = ws + WS_W + (size_t)L * LW_STRIDE;
        const float* W; const float* gg; bf16* WT; int K, N; bool perm = true;
        if (r < I_IN) { W = a.in[4] + (size_t)L * DM * NIN; K = DM; N = NIN; gg = a.in[3] + L * DM; WT = (bf16*)(wl + LW_IN); }
        else if ((r -= I_IN) < I_OUT) { W = a.in[23] + (size_t)L * DM * DM; K = DM; N = DM; gg = a.in[22] + L * DM; WT = (bf16*)(wl + LW_OUT); }
        else if ((r -= I_OUT) < I_FF1) { W = a.in[25] + (size_t)L * DM * DFF; K = DM; N = DFF; gg = a.in[24] + L * DM; WT = (bf16*)(wl + LW_FF1); }
        else if ((r -= I_FF1) < I_FF2) { W = a.in[26] + (size_t)L * DFF * DM; K = DFF; N = DM; gg = nullptr; WT = (bf16*)(wl + LW_FF2); }
        else if ((r -= I_FF2) < I_GATE) { W = a.in[28] + (size_t)L * DM * DM; K = DM; N = DM; gg = a.in[27] + L * DM; WT = (bf16*)(wl + LW_GATE); }
        else if ((r -= I_GATE) < I_PROJ) { W = a.in[29] + (size_t)L * 256 * DM; K = 256; N = DM; gg = nullptr; WT = (bf16*)(wl + LW_PROJ); }
        else if ((r -= I_PROJ) < I_GLU) { W = a.in[20] + (size_t)L * 65536; K = 256; N = 256; gg = nullptr; WT = (bf16*)(wl + LW_GLU); perm = false; }
        else { r -= I_GLU; W = a.in[21] + (size_t)L * 65536; K = 256; N = 256; gg = nullptr; WT = (bf16*)(wl + LW_GLU) + 65536; perm = false; }
        prep_transpose_item(W, K, N, gg, WT, scr, r, lane, perm);
    }
    {
        const float* x = a.in[0]; bf16* hb = (bf16*)outp; float* ssq = (float*)(ws + TAB_SSQ0);
        for (int m = gw; m < NTOK; m += 2 * NGW) {
            f32x4 v[2][4];
#pragma unroll
            for (int u = 0; u < 2; ++u)
#pragma unroll
                for (int j = 0; j < 4; ++j) v[u][j] = ((const f32x4*)(x + (size_t)(m + u * NGW) * DM) + lane)[64 * j];
#pragma unroll
            for (int u = 0; u < 2; ++u) { const int mm = m + u * NGW; unsigned long long* o8 = (unsigned long long*)(hb + (size_t)mm * DM) + lane; float s = 0.f;
#pragma unroll
                for (int j = 0; j < 4; ++j) { const f32x4 t = v[u][j]; s += (t[0] * t[0] + t[1] * t[1]) + (t[2] * t[2] + t[3] * t[3]);
                    o8[64 * j] = (unsigned long long)pk2(t[0], t[1]) | ((unsigned long long)pk2(t[2], t[3]) << 32); }
                s = wave_sum(s);
                if (lane < 4) ssq[lane * NTOK + mm] = (lane == 0) ? s : 0.f; }
        }
    }
    {
        const int* pos = (const int*)a.in[2]; float* cosT = (float*)(ws + TAB_COS); float* sinT = (float*)(ws + TAB_SIN);
        for (int i = gw * 64 + lane; i < NTOK * 32; i += NGW * 64) { const int tok = i >> 5, k = i & 31;
            const double rev = (double)pos[tok] * ROPE_INV_REV[k]; const float r = (float)(rev - __builtin_rint(rev));
            cosT[i] = __builtin_amdgcn_cosf(r); sinT[i] = __builtin_amdgcn_sinf(r); }
    }
    {
        bf16* gwt = (bf16*)(ws + TAB_GW);
        for (int i = gw * 64 + lane; i < NLAYER * 4 * 128 * 128; i += NGW * 64) { const int s_ = i & 127, t_ = (i >> 7) & 127; gwt[i] = (bf16)(pk2(s_ <= t_ ? a.in[7][i] : 0.f, 0.f) & 0xffffu); }
    }
    ssm_tables(a.in, ws, gw * 64 + lane, NGW * 64);
    convert_p(a.in[1], ws, gw, NGW);
    {
        float* sm = (float*)(ws + TAB_SMALL);
        for (int i = gw * 64 + lane; i < NLAYER * SM_STRIDE; i += NGW * 64) { const int L = i / SM_STRIDE, o = i % SM_STRIDE; float v = 0.f;
            if (o < SM_LNB) v = a.in[5][L * 256 + o]; else if (o < SM_QG) v = a.in[6][L * 256 + o - SM_LNB]; else if (o < SM_KG) v = a.in[9][L * 64 + o - SM_QG];
            else if (o < SM_SINK) v = a.in[10][L * 64 + o - SM_KG]; else if (o < SM_SINK + 8) v = a.in[11][L * 8 + o - SM_SINK];
            else if (o >= SM_GBS && o < SM_GBS + 512) v = a.in[8][L * 512 + o - SM_GBS];
            sm[i] = v; }
    }
}

struct LightOrder {
    int c;
    __device__ __forceinline__ bool next(int i, pg8::Unit& u) const { if (c < 128 || i >= 2) return false; const int Lq = 2 * (c - 128) + i; u.pm = Lq >> 2; u.pn = Lq & 3; return true; }
    __device__ __forceinline__ void a_ready(const pg8::Unit&) const {}
    __device__ __forceinline__ void done(const pg8::Unit&) const {}
};
enum { ST_IN = 0, ST_MIX, ST_CARRY, ST_SSM2, ST_OUT, ST_FF1, ST_FF2, ST_PLE, NSTEP };
#ifndef PG8_SP2
#define PG8_SP2 true
#endif
#ifndef PG8_ALIGN
#define PG8_ALIGN true
#endif
__global__ void __launch_bounds__(NWAVES * 64, 2) mk_fwd(Args args) {
    extern __shared__ __attribute__((aligned(16))) unsigned char lds_raw[];
    LAS unsigned char* lds = (LAS unsigned char*)lds_raw;
    const int G = gridDim.x;
    const int wave0 = __builtin_amdgcn_readfirstlane(threadIdx.x >> 6);
    volatile LAS unsigned* MISC = (volatile LAS unsigned*)(lds + 143360);
    { const int l0 = fresh_lane(); if (wave0 == 0) MISC[l0] = 0u; }
    __syncthreads();
    XcdBarrier bar = xcd_barrier_post((unsigned*)(args.ws + WS_CTL) + 4096, MISC, wave0 == 0 && fresh_lane() == 0);
#ifndef PROBE_DUP
#define PROBE_DUP (-2)
#endif
#ifndef PROBE_ITEM
#define PROBE_ITEM 0
#endif
#ifndef PROBE_XBAR
#define PROBE_XBAR 0
#endif
    for (int i = args.s_lo; i < args.s_hi; ++i) {
        if (i > args.s_lo) { xcd_barrier(bar, wave0 == 0 && fresh_lane() == 0);
            for (int xb = 0; xb < PROBE_XBAR; ++xb) xcd_barrier(bar, wave0 == 0 && fresh_lane() == 0); }
        int s = i; bool null_epi = false;
        if (PROBE_DUP == -1) s = i > 0 ? i - 1 : 0;
        else if (PROBE_DUP >= 0) { if (i > 0) { const int j = (i - 1) % (NSTEP + 1), Lq = (i - 1) / (NSTEP + 1); s = 1 + Lq * NSTEP + (j <= PROBE_DUP ? j : j - 1); null_epi = (j == PROBE_DUP) && (PROBE_DUP == ST_OUT || PROBE_DUP == ST_FF2 || PROBE_DUP == ST_PLE); } }
        unsigned long long z0 = 0ull; int bx = blockIdx.x; int wv = wave0;
        asm volatile("" : "+s"(z0), "+s"(bx), "+s"(wv));
        unsigned char* ws = args.ws + z0; float* outp = args.out + z0;
        const int vcu = (G % 8 == 0) ? (bx % 8) * (G / 8) + bx / 8 : bx;
#define FRESH_TID(name) int name = fresh_lane(); name += wv * 64
        if (s == 0) { FRESH_TID(t0); prologue_phase(args, ws, outp, lds, vcu * NWAVES + wv, G * NWAVES, wv, t0 & 63); asm volatile("s_waitcnt vmcnt(0) lgkmcnt(0)" ::: "memory"); __syncthreads(); continue; }
        const int L = (s - 1) / NSTEP, st = (s - 1) % NSTEP, par = L & 1;
        unsigned char* wl = ws + WS_W + (size_t)L * LW_STRIDE;
        if (st == ST_IN) {
            for (int rp = 0; rp < (PROBE_ITEM == 6 ? 2 : 1); ++rp) if (L == 0) { ssm_ktable(args.in, ws, vcu * NWAVES + wv, G * NWAVES); asm volatile("s_waitcnt vmcnt(0)" ::: "memory"); }
            pg8::Gemm g{(const bf16*)outp, (const bf16*)(wl + LW_IN), NTOK, NIN, DM}; pg8::StaticOrder S; S.init(NTOK, NIN, G, bx);
            pg8::EpiIn E{ws, par, L};
            { FRESH_TID(tl); pg8::gemm_phase<pg8::EpiIn, pg8::StaticOrder, PG8_ALIGN, PG8_SP2>(lds, g, S, E, tl); }
            {
                pg8::Gemm g2{(const bf16*)(ws + WS_PB), (const bf16*)(wl + LW_PROJ), NTOK, DM, 256}; LightOrder S2{bx};
                pg8::EpiProj E2{ws};
                { FRESH_TID(tl); pg8::gemm_phase<pg8::EpiProj, LightOrder, PG8_ALIGN, PG8_SP2>(lds, g2, S2, E2, tl); }
            }
        } else if (st == ST_MIX) {
            for (int rp = 0; rp < (PROBE_ITEM == 3 ? 2 : 1); ++rp) if (L + 1 < NLAYER) { convert_p(args.in[1] + (size_t)(L + 1) * NTOK * 256, ws, vcu * NWAVES + wv, G * NWAVES); }
            for (int it = vcu; it < 512; it += G) { if (it < 256) { for (int rp = 0; rp < (PROBE_ITEM == 1 ? 2 : 1); ++rp) attn_item(ws, L, lds, it, wv, 0); } else { for (int rp = 0; rp < (PROBE_ITEM == 2 ? 2 : 1); ++rp) ssm1_item(ws, L, it - 256, wv, 0); } }
        } else if (st == ST_CARRY) {
            if (bx < 32) ssm_scan(ws, L, lds, bx, wv);
            for (int it = vcu; it < 256; it += G) for (int rp = 0; rp < (PROBE_ITEM == 4 ? 2 : 1); ++rp) gmlp_item(ws, L, lds, it, wv, 0);
        } else if (st == ST_SSM2) {
            FRESH_TID(tm); const int lane = tm & 63;
            for (int it = vcu; it < 256; it += G) for (int rp = 0; rp < (PROBE_ITEM == 5 ? 2 : 1); ++rp) ssm2_item(ws, L, lds, it, wv, lane);
        } else if (st == ST_CARRY) {
            if (bx < 32) ssm_scan(ws, L, lds, bx, wv);
            pg8::Gemm g{(const bf16*)(ws + WS_PB), (const bf16*)(wl + LW_PROJ), NTOK, DM, 256}; pg8::StaticOrder S; S.init(NTOK, DM, G, bx);
            pg8::EpiProj E{ws};
            { FRESH_TID(tl); pg8::gemm_phase<pg8::EpiProj, pg8::StaticOrder, PG8_ALIGN, PG8_SP2>(lds, g, S, E, tl); }
        } else if (st == ST_OUT || st == ST_FF2) {
            const bool o = (st == ST_OUT);
            pg8::Gemm g{(const bf16*)(ws + (o ? WS_YCAT : WS_HID)), (const bf16*)(wl + (o ? LW_OUT : LW_FF2)), NTOK, DM, o ? DM : DFF}; pg8::StaticOrder S; S.init(NTOK, DM, G, bx);
            if (PROBE_DUP >= 0 && null_epi) { pg8::EpiNull E0; FRESH_TID(tl); pg8::gemm_phase<pg8::EpiNull, pg8::StaticOrder, false, PG8_SP2>(lds, g, S, E0, tl); }
            else { pg8::EpiRes<false> E{o ? (const bf16*)outp : (const bf16*)(ws + WS_HB), (bf16*)(ws + WS_HB), nullptr, ws, o ? (par ^ 1) : par};
            { FRESH_TID(tl); pg8::gemm_phase<pg8::EpiRes<false>, pg8::StaticOrder, false, PG8_SP2>(lds, g, S, E, tl); } }
        } else if (st == ST_FF1) {
            pg8::Gemm g{(const bf16*)(ws + WS_HB), (const bf16*)(wl + LW_FF1), NTOK, DFF, DM}; pg8::StaticOrder S; S.init(NTOK, DFF, G, bx);
            pg8::EpiFF1 E{ws, par ^ 1};
            { FRESH_TID(tl); pg8::gemm_phase<pg8::EpiFF1, pg8::StaticOrder, PG8_ALIGN, PG8_SP2>(lds, g, S, E, tl); }
        } else if (st == ST_PLE) {
            pg8::Gemm g{(const bf16*)(ws + WS_HB), (const bf16*)(wl + LW_GATE), NTOK, DM, DM}; pg8::StaticOrder S; S.init(NTOK, DM, G, bx);
            if (PROBE_DUP >= 0 && null_epi) { pg8::EpiNull E0; FRESH_TID(tl); pg8::gemm_phase<pg8::EpiNull, pg8::StaticOrder, false, PG8_SP2>(lds, g, S, E0, tl); }
            else { pg8::EpiRes<true> E{(const bf16*)(ws + WS_HB), (bf16*)outp, (L == NLAYER - 1) ? outp : nullptr, ws, par ^ 1};
            { FRESH_TID(tl); pg8::gemm_phase<pg8::EpiRes<true>, pg8::StaticOrder, false, PG8_SP2>(lds, g, S, E, tl); } }
        }
    }
}
extern "C" void kernel_launch(void* const* d_in, const int* in_sizes, int n_in, void* d_out, int out_size, void* d_ws, size_t ws_size, hipStream_t stream) {
    static int grid = 0;
    if (grid == 0) {
        if (n_in != 30 || out_size != NTOK * DM || ws_size < WS_END) { fprintf(stderr, "kernel_launch: unexpected shapes / workspace (n_in %d out %d ws %zu)\n", n_in, out_size, ws_size); grid = -1; return; }
        int dev = 0, cus = 0, per_cu = 0;
        (void)hipGetDevice(&dev); (void)hipDeviceGetAttribute(&cus, hipDeviceAttributeMultiprocessorCount, dev);
        (void)hipFuncSetAttribute((const void*)mk_fwd, hipFuncAttributeMaxDynamicSharedMemorySize, LDS_BYTES);
        (void)hipOccupancyMaxActiveBlocksPerMultiprocessor(&per_cu, (const void*)mk_fwd, NWAVES * 64, LDS_BYTES);
        (void)hipGetLastError();
        grid = (per_cu >= 1 && cus == 256) ? 256 : -1;
        if (grid < 0) { fprintf(stderr, "kernel_launch: needs 256 CUs with one resident workgroup each (cus %d per_cu %d)\n", cus, per_cu); return; }
    }
    if (grid < 0) return;
    (void)hipMemsetAsync((char*)d_ws + WS_CTL, 0, CTL_ZERO_BYTES, stream);
    Args a{};
    for (int i = 0; i < 30; ++i) a.in[i] = (const float*)d_in[i];
    a.out = (float*)d_out; a.ws = (unsigned char*)d_ws;
    unsigned char* ws = (unsigned char*)d_ws;
    const float* const* F = a.in;
#define LAUNCH_STEPS(lo, hi) do { a.s_lo = (lo); a.s_hi = (hi); hipLaunchKernelGGL(mk_fwd, dim3(grid), dim3(NWAVES * 64), LDS_BYTES, stream, a); } while (0)
#ifndef MK_SINGLE
#define MK_SINGLE 1
#endif
#if MK_SINGLE
    LAUNCH_STEPS(0, (PROBE_DUP == -1) ? 2 + NLAYER * NSTEP : (PROBE_DUP >= 0 ? 1 + NLAYER * (NSTEP + 1) : 1 + NLAYER * NSTEP));
#else
    for (int s = 0; s < 1 + NLAYER * NSTEP; ++s) LAUNCH_STEPS(s, s + 1);
#endif
}
```

```cpp
#include <hip/hip_runtime.h>
#include <cstdio>
#include <cstdint>
#include <math.h>

#define NTOK 16384
#define SEQL 8192
#define DM 1024
#define NIN 1536
#define DFF 4096
#define NLAYER 4
constexpr float QSCALE = 0.125f * 1.4426950408889634f;
constexpr float LOG2E = 1.4426950408889634f;

constexpr size_t MiB = 1u << 20;
constexpr size_t WS_CTL = 0, CTL_ZERO_BYTES = 112 * 1024;
constexpr size_t WS_W = 2 * MiB;
constexpr size_t LW_IN = 0, LW_OUT = 3 * MiB, LW_FF1 = 5 * MiB, LW_FF2 = 13 * MiB, LW_GATE = 21 * MiB, LW_PROJ = 23 * MiB, LW_GLU = 23 * MiB + 512 * 1024, LW_STRIDE = 24 * MiB;
constexpr size_t WS_TAB = 98 * MiB;
constexpr size_t TAB_COS = WS_TAB, TAB_SIN = WS_TAB + 2 * MiB, TAB_SSQ0 = WS_TAB + 4 * MiB, TAB_SSQ1 = TAB_SSQ0 + 256 * 1024, TAB_GW = TAB_SSQ1 + 256 * 1024, TAB_SMALL = TAB_GW + 512 * 1024, TAB_END = TAB_SMALL + 64 * 1024;
constexpr int SM_LNG = 0, SM_LNB = 256, SM_QG = 512, SM_KG = 576, SM_SINK = 640, SM_GBS = 1024  , SM_STRIDE = 2048;
constexpr size_t WS_HB = 104 * MiB;
constexpr size_t WS_U = 138 * MiB, WS_VLN = 146 * MiB, WS_Q = 154 * MiB, WS_K = 170 * MiB, WS_V = 174 * MiB, WS_ZC = 178 * MiB;
constexpr size_t WS_YCAT = 186 * MiB;
constexpr size_t WS_HID = 138 * MiB;
constexpr size_t WS_PPROJ = 266 * MiB;
constexpr size_t WS_PB = 298 * MiB;
constexpr size_t WS_SSM = 306 * MiB;
constexpr size_t SSM_PW = WS_SSM;
constexpr size_t SSM_KT = SSM_PW + 2304 * 1024;
constexpr size_t SSM_BBT = SSM_KT + 2 * MiB;
constexpr size_t SSM_CCT = SSM_BBT + 256 * 1024;
constexpr size_t SSM_BBC = SSM_CCT + 256 * 1024;
constexpr size_t SSM_S = SSM_BBC + 512 * 1024;
constexpr size_t SSM_S32 = SSM_S + 2 * MiB;
constexpr size_t SSM_PWB = SSM_S32 + 2 * MiB;
constexpr size_t WS_END = SSM_PWB + 512 * 1024;
static_assert(WS_END <= 316 * MiB, "ssm region");
static_assert(TAB_END <= WS_HB && WS_HB + 32 * MiB <= WS_U && WS_HID + 128 * MiB <= WS_PPROJ, "ws map");
static_assert(WS_W + NLAYER * LW_STRIDE <= WS_TAB, "weights");

constexpr size_t ZS_U = 0, ZS_VLN = 128 * 1024, ZS_Q = 256 * 1024, ZS_K = 512 * 1024, ZS_V = 576 * 1024, ZS_ZC = 640 * 1024, ZS_YCAT = 768 * 1024;
__host__ __device__ constexpr size_t zrow(int tok, int ld) { return (size_t)(tok >> 8) * (size_t)(1u << 20) + (size_t)(tok & 255) * (size_t)ld; }
__host__ __device__ constexpr size_t ws_u(int b) { return (138 + 60 * (size_t)b) * MiB; }
__host__ __device__ constexpr size_t ws_vln(int b) { return (142 + 60 * (size_t)b) * MiB; }
__host__ __device__ constexpr size_t ws_q(int b) { return (146 + 56 * (size_t)b) * MiB; }
__host__ __device__ constexpr size_t ws_k(int b) { return (154 + 62 * (size_t)b) * MiB; }
__host__ __device__ constexpr size_t ws_v(int b) { return (156 + 62 * (size_t)b) * MiB; }
__host__ __device__ constexpr size_t ws_zc(int b) { return (158 + 60 * (size_t)b) * MiB; }
__host__ __device__ constexpr size_t ws_ycat(int b) { return (162 + 48 * (size_t)b) * MiB; }
__host__ __device__ constexpr size_t out_hbb(int b) { return 16 * (size_t)b * MiB; }
typedef float f32x2_t __attribute__((ext_vector_type(2)));
typedef __bf16 bf16x2_t __attribute__((ext_vector_type(2)));
__device__ __forceinline__ unsigned pk2(float lo, float hi) { f32x2_t v = {lo, hi}; bf16x2_t b = __builtin_convertvector(v, bf16x2_t); return __builtin_bit_cast(unsigned, b); }
__device__ __forceinline__ float bf_lo(unsigned w) { return __uint_as_float(w << 16); }
__device__ __forceinline__ float bf_hi(unsigned w) { return __uint_as_float(w & 0xffff0000u); }
__device__ __forceinline__ float bf2f(unsigned short b) { return __uint_as_float(((unsigned)b) << 16); }
template <int X> __device__ __forceinline__ float xor_lane(float v) { return __int_as_float(__builtin_amdgcn_ds_swizzle(__float_as_int(v), (X << 10) | 0x1f)); }
__device__ __forceinline__ float add_xor16(float v) { return v + xor_lane<16>(v); }
__device__ __forceinline__ float add_xor32(float v) { auto r = __builtin_amdgcn_permlane32_swap(__float_as_uint(v), __float_as_uint(v), false, false); return __uint_as_float(r[0]) + __uint_as_float(r[1]); }
__device__ __forceinline__ float wave_sum(float v) {
    v += xor_lane<1>(v); v += xor_lane<2>(v); v += xor_lane<4>(v); v += xor_lane<8>(v); v = add_xor16(v); return add_xor32(v);
}
__device__ __forceinline__ float wave_sum_shfl(float v) {
#pragma unroll
    for (int o = 1; o < 64; o <<= 1) v += __shfl_xor(v, o);
    return v;
}
__device__ __forceinline__ int fresh_lane() { int l; asm volatile("v_mbcnt_lo_u32_b32 %0, -1, 0\n\tv_mbcnt_hi_u32_b32 %0, -1, %0" : "=v"(l)); return l; }
__device__ __forceinline__ float gelu_fast(float x) {
    const float u = x * (1.0f + 0.044715f * x * x);
    const float t = __builtin_amdgcn_exp2f(u * 2.3022082f);
    return x - x * __builtin_amdgcn_rcpf(1.0f + t);
}
__device__ __forceinline__ float sigmoid_fast(float x) { return __builtin_amdgcn_rcpf(1.0f + __builtin_amdgcn_exp2f(-x * LOG2E)); }
__device__ __forceinline__ float gelu_tanh(float x) { const float k0 = 0.7978845608028654f, k1 = 0.044715f; float u = k0 * (x + k1 * x * x * x); return 0.5f * x * (1.0f + tanhf(u)); }
__device__ const double ROPE_INV_REV[32] = {0.15915494309189535, 0.11934937021124886, 0.08949940160889101, 0.06711508300522726, 0.050329212104487035, 0.03774158471741977, 0.0283021958306234, 0.02122365276477766, 0.015915494309189534, 0.011934937021124886, 0.008949940160889102, 0.006711508300522725, 0.005032921210448704, 0.003774158471741977, 0.00283021958306234, 0.0021223652764777662, 0.0015915494309189536, 0.0011934937021124885, 0.0008949940160889102, 0.0006711508300522726, 0.0005032921210448703, 0.00037741584717419774, 0.00028302195830623395, 0.0002122365276477766, 0.00015915494309189535, 0.00011934937021124886, 8.949940160889102e-05, 6.711508300522725e-05, 5.0329212104487035e-05, 3.774158471741978e-05, 2.8302195830623396e-05, 2.122365276477766e-05};
namespace pg8 {
#define PG8_LAS __attribute__((address_space(3)))
typedef unsigned short bf16_t;
typedef short bf16x8 __attribute__((ext_vector_type(8)));
typedef float f32x4 __attribute__((ext_vector_type(4)));
typedef unsigned u32x4 __attribute__((ext_vector_type(4)));
constexpr int BM = 256, BK = 64, HALF = 128, HTB = HALF * BK * 2  , STAGE_BYTES = 8 * HTB, NXCD = 8, WGM = 8;

__host__ __device__ __forceinline__ int lds_byte(int r, int c) { const int st = (r >> 4) * 2 + (c >> 5), rr = r & 15, cc = c & 31, ob = rr * 64 + cc * 2; return st * 1024 + (ob ^ (((ob >> 9) & 1) << 5)); }
__host__ __device__ __forceinline__ void stage_rc(int b, int& R, int& C) { const int st = b / 1024, sb = b % 1024, swz = sb ^ (((sb >> 9) & 1) << 5); R = (st >> 1) * 16 + swz / 64; C = (st & 1) * 32 + (swz % 64) / 2; }
__host__ __device__ __forceinline__ int perm32(int rho) { const int n = rho >> 4, i = rho & 15; return 8 * (i >> 2) + 4 * n + (i & 3); }

struct Unit { int pm, pn; };
struct Gemm { const bf16_t* A; const bf16_t* Bt; int M, N, K; };

struct StaticOrder {
    int nM, nN, nwg, G, c;
    __host__ __device__ void init(int M, int N, int G_, int c_) { nM = M / BM; nN = N / BM; nwg = nM * nN; G = G_; c = c_; }
    __host__ __device__ bool next(int i, Unit& u) const {
        const long L = (long)i * G + c; if (L >= nwg) return false;
        int wgid = (int)L; { const int q = nwg / NXCD, r = nwg % NXCD, xcd = wgid % NXCD, off = wgid / NXCD; wgid = (xcd < r ? xcd * (q + 1) : r * (q + 1) + (xcd - r) * q) + off; }
        const int nig = WGM * nN, gid = wgid / nig, fm = gid * WGM, gsz = (nM - fm) < WGM ? (nM - fm) : WGM;
        u.pm = fm + ((wgid % nig) % gsz); u.pn = (wgid % nig) / gsz; return true;
    }
    __device__ __forceinline__ void a_ready(const Unit&) const {}
    __device__ __forceinline__ void done(const Unit&) const {}
};

template <class Epi, class Sched, bool ALIGN_EPI = false, bool SP2 = false>
__device__ __forceinline__ void gemm_phase(PG8_LAS unsigned char* lds, const Gemm g, const Sched& S, const Epi& E, const int tid) {
    const int wid = __builtin_amdgcn_readfirstlane(tid >> 6), lane = tid & 63, wr = wid >> 2, wc = wid & 3, fr = lane & 15, fq = lane >> 4;
    const int K = g.K, nt = K / BK;
    unsigned voffA[2], voffB[2];
#pragma unroll
    for (int i = 0; i < 2; ++i) { int R, C; stage_rc(tid * 16 + i * 8192, R, C); const int Rb = Epi::PERM ? ((R & ~31) + perm32(R & 31)) : R;
        voffA[i] = (unsigned)(R * K + C) * 2u; voffB[i] = (unsigned)(Rb * K + C) * 2u; }
    const size_t kstep = (size_t)(BK * 2);
    const size_t hstep = (size_t)HALF * K * 2;
    const size_t tstep = 2 * hstep;
    const unsigned ldsw = (unsigned)wid * 1024u;
    const int aoff = lds_byte(wr * 64 + fr, fq * 8), boff = lds_byte(wc * 32 + fr, fq * 8);
#define PG8_SA(b, h) (((b) * 2 + (h)) * HTB)
#define PG8_SB(b, h) ((4 + (b) * 2 + (h)) * HTB)
#define PG8_STAGE(bufoff, gbase, voff) do { _Pragma("unroll") for (int _i = 0; _i < 2; ++_i) \
        __builtin_amdgcn_global_load_lds((const unsigned*)((const char*)(gbase) + (voff)[_i]), (PG8_LAS unsigned*)(lds + (bufoff) + ldsw + _i * 8192), 16, 0, 0); } while (0)
#define PG8_LDA(dst, b, h) do { _Pragma("unroll") for (int m = 0; m < 4; ++m) _Pragma("unroll") for (int k = 0; k < 2; ++k) dst[m][k] = *(const PG8_LAS bf16x8*)(lds + PG8_SA(b, h) + aoff + m * 2048 + k * 1024); } while (0)
#define PG8_LDB(dst, b, h) do { _Pragma("unroll") for (int n = 0; n < 2; ++n) _Pragma("unroll") for (int k = 0; k < 2; ++k) dst[n][k] = *(const PG8_LAS bf16x8*)(lds + PG8_SB(b, h) + boff + n * 2048 + k * 1024); } while (0)
#define PG8_MMA(ai, bj, At, Bt) do { __builtin_amdgcn_s_setprio(1); _Pragma("unroll") for (int m = 0; m < 4; ++m) _Pragma("unroll") for (int n = 0; n < 2; ++n) _Pragma("unroll") for (int k = 0; k < 2; ++k) \
        acc[ai][bj][m][n] = __builtin_amdgcn_mfma_f32_16x16x32_bf16(Bt[n][k], At[m][k], acc[ai][bj][m][n], 0, 0, 0); __builtin_amdgcn_s_setprio(0); } while (0)
#define PG8_WAIT_V(n) asm volatile("s_waitcnt vmcnt(" #n ")" ::: "memory")
#define PG8_WAIT_L(n) asm volatile("s_waitcnt lgkmcnt(" #n ")" ::: "memory")
#define PG8_BAR __builtin_amdgcn_s_barrier()
#define PG8_SCHED __builtin_amdgcn_sched_barrier(0)
#if defined(PROBE_T0) && defined(PROBE_SLOT)
    volatile PG8_LAS unsigned* M_ = (volatile PG8_LAS unsigned*)(lds + 143360);
#define G_STAMP(id) do { if (blockIdx.x == PROBE_BLK && wid == 0 && M_[12] == PROBE_SLOT) { \
    if ((id) == PROBE_T0) { const unsigned long long t_ = __builtin_amdgcn_s_memrealtime(); M_[8] = (unsigned)t_; M_[9] = (unsigned)(t_ >> 32); } \
    if ((id) == PROBE_T1) { const unsigned long long t_ = __builtin_amdgcn_s_memrealtime(), t0_ = ((unsigned long long)M_[9] << 32) | M_[8]; M_[10] = (unsigned)(t_ - t0_); } } } while (0)
#else
#define G_STAMP(id) do {} while (0)
#endif
    Unit cur, nxt; int ui = 0;
    if (!S.next(0, cur)) return;
    G_STAMP(200);
    f32x4 acc[2][2][4][2];
#pragma unroll
    for (int a = 0; a < 2; ++a)
#pragma unroll
        for (int b = 0; b < 2; ++b)
#pragma unroll
            for (int m = 0; m < 4; ++m)
#pragma unroll
                for (int n = 0; n < 2; ++n) acc[a][b][m][n] = (f32x4){0.f, 0.f, 0.f, 0.f};
    bf16x8 At[4][2], B0[2][2], B1[2][2];
    const char* cA = (const char*)g.A + (size_t)cur.pm * tstep; const char* cB = (const char*)g.Bt + (size_t)cur.pn * tstep;
    S.a_ready(cur);
    if constexpr (SP2) {
        PG8_STAGE(PG8_SB(0, 0), cB, voffB); PG8_STAGE(PG8_SB(0, 1), cB + hstep, voffB); PG8_STAGE(PG8_SA(0, 0), cA, voffA); PG8_STAGE(PG8_SA(0, 1), cA + hstep, voffA);
        if (wr == 1) PG8_BAR;
        PG8_WAIT_V(2); PG8_BAR;
        PG8_STAGE(PG8_SB(1, 0), cB + kstep, voffB); PG8_STAGE(PG8_SA(1, 0), cA + kstep, voffA); PG8_STAGE(PG8_SB(1, 1), cB + hstep + kstep, voffB);
        PG8_WAIT_V(6); PG8_BAR;
    } else {
        PG8_STAGE(PG8_SB(0, 0), cB, voffB); PG8_STAGE(PG8_SA(0, 0), cA, voffA); PG8_STAGE(PG8_SB(0, 1), cB + hstep, voffB); PG8_STAGE(PG8_SA(0, 1), cA + hstep, voffA);
        if (wr == 1) PG8_BAR;
        PG8_WAIT_V(4); PG8_BAR;
        PG8_STAGE(PG8_SB(1, 0), cB + kstep, voffB); PG8_STAGE(PG8_SA(1, 0), cA + kstep, voffA); PG8_STAGE(PG8_SB(1, 1), cB + hstep + kstep, voffB);
        PG8_WAIT_V(6); PG8_BAR;
    }
    G_STAMP(201);
    for (;;) {
        const bool has_next = S.next(ui + 1, nxt);
        const char* nA = has_next ? (const char*)g.A + (size_t)nxt.pm * tstep : cA; const char* nB = has_next ? (const char*)g.Bt + (size_t)nxt.pn * tstep : cB;
        for (int t = 0; t < nt; t += 2) {
            const bool last = (t == nt - 2);
            const char* a1 = cA + (size_t)(t + 1) * kstep;
            const char* a2 = last ? nA : cA + (size_t)(t + 2) * kstep; const char* b2 = last ? nB : cB + (size_t)(t + 2) * kstep;
            const char* a3 = a2 + kstep; const char* b3 = b2 + kstep;
            if (last && has_next) S.a_ready(nxt);
            if constexpr (SP2) {
            PG8_LDB(B0, 0, 0); PG8_LDB(B1, 0, 1); PG8_SCHED; PG8_LDA(At, 0, 0); PG8_STAGE(PG8_SA(1, 1), a1 + hstep, voffA);
            PG8_WAIT_V(8); PG8_WAIT_L(0); PG8_BAR; PG8_MMA(0, 0, At, B0); PG8_MMA(0, 1, At, B1); PG8_BAR; PG8_SCHED;
            PG8_LDA(At, 0, 1); PG8_STAGE(PG8_SB(0, 0), b2, voffB); PG8_STAGE(PG8_SB(0, 1), b2 + hstep, voffB); PG8_STAGE(PG8_SA(0, 0), a2, voffA);
            PG8_WAIT_V(8); PG8_WAIT_L(0); PG8_BAR; PG8_MMA(1, 0, At, B0); PG8_MMA(1, 1, At, B1); PG8_BAR; PG8_SCHED;
            PG8_LDB(B0, 1, 0); PG8_LDB(B1, 1, 1); PG8_SCHED; PG8_LDA(At, 1, 0); PG8_STAGE(PG8_SA(0, 1), a2 + hstep, voffA);
            PG8_WAIT_V(8); PG8_WAIT_L(0); PG8_BAR; PG8_MMA(0, 0, At, B0); PG8_MMA(0, 1, At, B1); PG8_BAR; PG8_SCHED;
            PG8_LDA(At, 1, 1); PG8_STAGE(PG8_SB(1, 0), b3, voffB); PG8_STAGE(PG8_SB(1, 1), b3 + hstep, voffB); PG8_STAGE(PG8_SA(1, 0), a3, voffA);
            PG8_WAIT_V(8); PG8_WAIT_L(0); PG8_BAR; PG8_MMA(1, 0, At, B0); PG8_MMA(1, 1, At, B1); PG8_BAR; PG8_SCHED;
            } else {
            PG8_LDB(B0, 0, 0); PG8_SCHED; PG8_LDA(At, 0, 0); PG8_STAGE(PG8_SA(1, 1), a1 + hstep, voffA);
            PG8_WAIT_L(8); PG8_BAR; PG8_WAIT_L(0); PG8_MMA(0, 0, At, B0); PG8_BAR; PG8_SCHED;
            PG8_LDB(B1, 0, 1); PG8_STAGE(PG8_SB(0, 0), b2, voffB);
            PG8_BAR; PG8_WAIT_L(0); PG8_MMA(0, 1, At, B1); PG8_BAR;
            PG8_LDA(At, 0, 1); PG8_STAGE(PG8_SA(0, 0), a2, voffA);
            PG8_BAR; PG8_WAIT_L(0); PG8_MMA(1, 0, At, B0); PG8_BAR; PG8_SCHED;
            PG8_STAGE(PG8_SB(0, 1), b2 + hstep, voffB);
            PG8_WAIT_V(6); PG8_BAR; PG8_MMA(1, 1, At, B1); PG8_BAR;
            PG8_LDB(B0, 1, 0); PG8_SCHED; PG8_LDA(At, 1, 0); PG8_STAGE(PG8_SA(0, 1), a2 + hstep, voffA);
            PG8_WAIT_L(8); PG8_BAR; PG8_WAIT_L(0); PG8_MMA(0, 0, At, B0); PG8_BAR; PG8_SCHED;
            PG8_LDB(B1, 1, 1); PG8_STAGE(PG8_SB(1, 0), b3, voffB);
            PG8_BAR; PG8_WAIT_L(0); PG8_MMA(0, 1, At, B1); PG8_BAR;
            PG8_LDA(At, 1, 1); PG8_STAGE(PG8_SA(1, 0), a3, voffA);
            PG8_BAR; PG8_WAIT_L(0); PG8_MMA(1, 0, At, B0); PG8_BAR; PG8_SCHED;
            PG8_STAGE(PG8_SB(1, 1), b3 + hstep, voffB);
            PG8_WAIT_V(6); PG8_BAR; PG8_MMA(1, 1, At, B1); PG8_BAR;
            }
        }
        if (ui == 0) G_STAMP(205);
        if constexpr (ALIGN_EPI) { if (wr == 0) PG8_BAR; }
        if constexpr (!Epi::AFTER_DRAIN) { const int l2 = fresh_lane();
            E(acc, cur, wr, wc, l2 & 15, l2 >> 4); S.done(cur); }
        if (ui == 0) G_STAMP(206);
        if (!has_next) break;
#pragma unroll
        for (int a = 0; a < 2; ++a)
#pragma unroll
            for (int b = 0; b < 2; ++b)
#pragma unroll
                for (int m = 0; m < 4; ++m)
#pragma unroll
                    for (int n = 0; n < 2; ++n) acc[a][b][m][n] = (f32x4){0.f, 0.f, 0.f, 0.f};
        cur = nxt; cA = nA; cB = nB; ++ui;
        if constexpr (ALIGN_EPI) { if (wr == 1) PG8_BAR; }
    }
    G_STAMP(202);
    PG8_WAIT_V(0);
    if constexpr (!ALIGN_EPI) { if (wr == 0) PG8_BAR; }
    PG8_BAR;
    G_STAMP(203);
    if constexpr (Epi::AFTER_DRAIN) { const int l2 = fresh_lane();
        E.fused(acc, cur, wr, wc, l2 & 15, l2 >> 4, lds, wid, l2); S.done(cur); }
    G_STAMP(204);
#undef PG8_SA
#undef PG8_SB
#undef PG8_STAGE
#undef PG8_LDA
#undef PG8_LDB
#undef PG8_MMA
#undef PG8_WAIT_V
#undef PG8_WAIT_L
#undef PG8_BAR
#undef PG8_SCHED
}
}
namespace pg8 {
__device__ __forceinline__ float rstd_row(const float* ssq, int row) {
    const float s = (ssq[row] + ssq[NTOK + row]) + (ssq[2 * NTOK + row] + ssq[3 * NTOK + row]);
    return __builtin_amdgcn_rsqf(s * (1.0f / 1024.0f) + 1e-6f);
}
typedef __amdgpu_buffer_rsrc_t rsrc_t;
__device__ __forceinline__ rsrc_t make_rsrc(const void* base) { return __builtin_amdgcn_make_buffer_rsrc((void*)base, 0, 0x7ffffffc, 0x00020000); }
__device__ __forceinline__ void store8_wt(rsrc_t rs, unsigned byte_off, const float (&v)[8]) {
    u32x4 w; w.x = pk2(v[0], v[1]); w.y = pk2(v[2], v[3]); w.z = pk2(v[4], v[5]); w.w = pk2(v[6], v[7]);
    __builtin_amdgcn_raw_buffer_store_b128(w, rs, (int)byte_off, 0, 16);
}
__device__ __forceinline__ void store8(bf16_t* p, const float (&v)[8]) {
    u32x4 w; w.x = pk2(v[0], v[1]); w.y = pk2(v[2], v[3]); w.z = pk2(v[4], v[5]); w.w = pk2(v[6], v[7]); *(u32x4*)p = w;
}
constexpr int RSTD_LDS_OFF = 131072;
__device__ __forceinline__ void rstd_panel_to_lds(PG8_LAS unsigned char* lds, const float* ssq, int pm0, int tid) {
    PG8_LAS float* slot = (PG8_LAS float*)(lds + RSTD_LDS_OFF);
    if (tid < 256) slot[tid] = rstd_row(ssq, pm0 * BM + tid);
    asm volatile("s_waitcnt vmcnt(0) lgkmcnt(0)" ::: "memory"); __builtin_amdgcn_s_barrier(); asm volatile("" ::: "memory");
}
__device__ __forceinline__ float rstd_lds(PG8_LAS unsigned char* lds, int rl) { return ((PG8_LAS const float*)(lds + RSTD_LDS_OFF))[rl]; }
struct EpiIn {
    static constexpr bool PERM = false, AFTER_DRAIN = false;
    unsigned char* ws; int par, L; PG8_LAS unsigned char* lds;
    __device__ __forceinline__ void operator()(const f32x4 (&acc)[2][2][4][2], const Unit& u, int wr, int wc, int fr, int fq) const {
        const int pn = u.pn;
        const float* ssq = (const float*)(ws + (par ? TAB_SSQ1 : TAB_SSQ0)); const float* cosT = (const float*)(ws + TAB_COS); const float* sinT = (const float*)(ws + TAB_SIN);
        const float* sm = (const float*)(ws + TAB_SMALL) + L * SM_STRIDE; const float* lng = sm + SM_LNG; const float* lnb = sm + SM_LNB; const float* qg = sm + SM_QG; const float* kg = sm + SM_KG;
        bf16_t* U = (bf16_t*)(ws + WS_HID + ZS_U); bf16_t* VLN = (bf16_t*)(ws + WS_HID + ZS_VLN); bf16_t* Q = (bf16_t*)(ws + WS_HID + ZS_Q); bf16_t* K = (bf16_t*)(ws + WS_HID + ZS_K); bf16_t* V = (bf16_t*)(ws + WS_HID + ZS_V); bf16_t* ZC = (bf16_t*)(ws + WS_HID + ZS_ZC);
        int mode, ld, cb; bf16_t* dst; const float* gp = nullptr; const float* bp = nullptr;
        if (pn < 2) { const int head = 2 * pn + (wc >> 1); ld = 256; cb = head * 64; if (wc & 1) { mode = 1; dst = VLN; gp = lng + head * 64; bp = lnb + head * 64; } else { mode = 0; dst = U; } }
        else if (pn < 4) { mode = 2; dst = Q; ld = 512; cb = (4 * (pn - 2) + wc) * 64; gp = qg; }
        else if (pn == 4) { ld = 128; if (wc < 2) { mode = 3; dst = K; cb = wc * 64; gp = kg; } else { mode = 4; dst = V; cb = (wc - 2) * 64; } }
        else { mode = 4; dst = ZC; ld = 256; cb = wc * 64; }
        float g[16], bb[16];
#pragma unroll
        for (int i = 0; i < 16; ++i) { g[i] = 1.f; bb[i] = 0.f; }
        if (gp) {
#pragma unroll
            for (int bj = 0; bj < 2; ++bj)
#pragma unroll
                for (int n = 0; n < 2; ++n) { const f32x4 t = *(const f32x4*)(gp + 32 * bj + 8 * fq + 4 * n); g[bj * 8 + n * 4 + 0] = t[0]; g[bj * 8 + n * 4 + 1] = t[1]; g[bj * 8 + n * 4 + 2] = t[2]; g[bj * 8 + n * 4 + 3] = t[3]; }
        }
        if (bp) {
#pragma unroll
            for (int bj = 0; bj < 2; ++bj)
#pragma unroll
                for (int n = 0; n < 2; ++n) { const f32x4 t = *(const f32x4*)(bp + 32 * bj + 8 * fq + 4 * n); bb[bj * 8 + n * 4 + 0] = t[0]; bb[bj * 8 + n * 4 + 1] = t[1]; bb[bj * 8 + n * 4 + 2] = t[2]; bb[bj * 8 + n * 4 + 3] = t[3]; }
        }
#pragma unroll
        for (int ai = 0; ai < 2; ++ai)
#pragma unroll
            for (int m = 0; m < 4; ++m) {
                const int row = u.pm * BM + ai * HALF + wr * 64 + m * 16 + fr;
                const float rs = rstd_lds(lds, ai * HALF + wr * 64 + m * 16 + fr);
                float v[16];
#pragma unroll
                for (int bj = 0; bj < 2; ++bj)
#pragma unroll
                    for (int n = 0; n < 2; ++n)
#pragma unroll
                        for (int j = 0; j < 4; ++j) v[bj * 8 + n * 4 + j] = acc[ai][bj][m][n][j] * rs;
                if (mode <= 1) {
#pragma unroll
                    for (int i = 0; i < 16; ++i) v[i] = gelu_fast(v[i]);
                    if (mode == 1) {
                        float s = 0.f;
#pragma unroll
                        for (int i = 0; i < 16; ++i) s += v[i];
                        s = add_xor16(s); s = add_xor32(s);
                        const float mu = s * (1.0f / 64.0f); float q = 0.f;
#pragma unroll
                        for (int i = 0; i < 16; ++i) { v[i] -= mu; q += v[i] * v[i]; }
                        q = add_xor16(q); q = add_xor32(q);
                        const float r = __builtin_amdgcn_rsqf(q * (1.0f / 64.0f) + 1e-6f);
#pragma unroll
                        for (int i = 0; i < 16; ++i) v[i] = v[i] * r * g[i] + bb[i];
                    }
                } else if (mode <= 3) {
                    float q = 0.f;
#pragma unroll
                    for (int i = 0; i < 16; ++i) q += v[i] * v[i];
                    q = add_xor16(q); q = add_xor32(q);
                    const float r = __builtin_amdgcn_rsqf(q * (1.0f / 64.0f) + 1e-6f) * (mode == 2 ? QSCALE : 1.0f);
#pragma unroll
                    for (int i = 0; i < 16; ++i) v[i] = v[i] * r * g[i];
                    const float* cp = cosT + (size_t)row * 32 + 8 * fq; const float* sp = sinT + (size_t)row * 32 + 8 * fq;
#pragma unroll
                    for (int n = 0; n < 2; ++n) { const f32x4 c4 = *(const f32x4*)(cp + 4 * n), s4 = *(const f32x4*)(sp + 4 * n);
#pragma unroll
                        for (int j = 0; j < 4; ++j) { const float x1 = v[n * 4 + j], x2 = v[8 + n * 4 + j]; v[n * 4 + j] = x1 * c4[j] - x2 * s4[j]; v[8 + n * 4 + j] = x2 * c4[j] + x1 * s4[j]; } }
                }
                bf16_t* rp = dst + zrow(row, ld) + cb + 8 * fq;
                { float t[8];
#pragma unroll
                  for (int i = 0; i < 8; ++i) t[i] = v[i];
                  if (pn == 4) store8_wt(make_rsrc(ws), (unsigned)((const unsigned char*)rp - ws), t); else store8(rp, t);
#pragma unroll
                  for (int i = 0; i < 8; ++i) t[i] = v[8 + i];
                  if (pn == 4) store8_wt(make_rsrc(ws), (unsigned)((const unsigned char*)(rp + 32) - ws), t); else store8(rp + 32, t); }
            }
    }
};
struct EpiFF1 {
    static constexpr bool PERM = false, AFTER_DRAIN = false;
    unsigned char* ws; int par; PG8_LAS unsigned char* lds;
    __device__ __forceinline__ void operator()(const f32x4 (&acc)[2][2][4][2], const Unit& u, int wr, int wc, int fr, int fq) const {
        bf16_t* HID = (bf16_t*)(ws + WS_HID);
#pragma unroll
        for (int ai = 0; ai < 2; ++ai)
#pragma unroll
            for (int m = 0; m < 4; ++m) {
                const int row = u.pm * BM + ai * HALF + wr * 64 + m * 16 + fr;
                const float rs = rstd_lds(lds, ai * HALF + wr * 64 + m * 16 + fr);
                bf16_t* rp = HID + (size_t)row * DFF + u.pn * BM + wc * 64 + 8 * fq;
#pragma unroll
                for (int bj = 0; bj < 2; ++bj) { float t[8];
#pragma unroll
                    for (int n = 0; n < 2; ++n)
#pragma unroll
                        for (int j = 0; j < 4; ++j) { float x = acc[ai][bj][m][n][j] * rs; x = x > 0.f ? x : 0.f; t[n * 4 + j] = x * x; }
                    store8(rp + 32 * bj, t); }
            }
    }
};
struct EpiProj {
    static constexpr bool PERM = false, AFTER_DRAIN = false;
    unsigned char* ws;
    __device__ __forceinline__ void operator()(const f32x4 (&acc)[2][2][4][2], const Unit& u, int wr, int wc, int fr, int fq) const {
        bf16_t* O = (bf16_t*)(ws + WS_PPROJ);
#pragma unroll
        for (int ai = 0; ai < 2; ++ai)
#pragma unroll
            for (int m = 0; m < 4; ++m) {
                const int row = u.pm * BM + ai * HALF + wr * 64 + m * 16 + fr;
                bf16_t* rp = O + (size_t)row * DM + u.pn * BM + wc * 64 + 8 * fq;
#pragma unroll
                for (int bj = 0; bj < 2; ++bj) { float t[8];
#pragma unroll
                    for (int n = 0; n < 2; ++n)
#pragma unroll
                        for (int j = 0; j < 4; ++j) t[n * 4 + j] = acc[ai][bj][m][n][j];
                    store8(rp + 32 * bj, t); }
            }
    }
};
#ifndef EPIRES_NB_GATED
#define EPIRES_NB_GATED 8
#endif
#define EPIRES_NB_GATED_OR(G) ((G) ? EPIRES_NB_GATED : 8)
template <bool GATED> struct EpiRes {
    static constexpr bool PERM = false, AFTER_DRAIN = true;
    const bf16_t* hin; bf16_t* hout; float* fout; unsigned char* ws; int par_out;
    __device__ __forceinline__ void fused(f32x4 (&acc)[2][2][4][2], const Unit& u, int wr, int wc, int fr, int fq, PG8_LAS unsigned char* lds, int wid, int lane) const {
        float* ssq_out = (float*)(ws + (par_out ? TAB_SSQ1 : TAB_SSQ0));
        PG8_LAS float* P = (PG8_LAS float*)(lds + (GATED ? RSTD_LDS_OFF : 0));
        const int cb = u.pn * BM + wc * 64 + 8 * fq, row0 = u.pm * BM + wr * 64 + fr;
        constexpr int NB = EPIRES_NB_GATED_OR(GATED);
        u32x4 hv[NB][2]; float rsum[NB];
        const bf16_t* PP = (const bf16_t*)(ws + WS_PPROJ);
        PG8_LAS unsigned char* pl = lds + wid * 16384;
        if (GATED) {
#pragma unroll
            for (int k = 0; k < 16; ++k) { const int row = row0 + (k >> 3) * HALF + ((k >> 1) & 3) * 16;
                __builtin_amdgcn_global_load_lds((const unsigned*)(PP + (size_t)row * DM + cb + 32 * (k & 1)), (PG8_LAS unsigned*)(pl + k * 1024), 16, 0, 0); } }
#pragma unroll
        for (int g8 = 0; g8 < 8; ++g8) {
            if (g8 % NB == 0) {
#pragma unroll
                for (int k = 0; k < NB; ++k) { const int row = row0 + ((g8 + k) >> 2) * HALF + ((g8 + k) & 3) * 16;
#pragma unroll
                    for (int bj = 0; bj < 2; ++bj) hv[k][bj] = *(const u32x4*)(hin + (size_t)row * DM + cb + 32 * bj);
                    if (GATED) { const float* sq = (const float*)(ws + (par_out ? TAB_SSQ0 : TAB_SSQ1)); rsum[k] = (sq[row] + sq[NTOK + row]) + (sq[2 * NTOK + row] + sq[3 * NTOK + row]); } }
                if (GATED && g8 == 0) asm volatile("s_waitcnt vmcnt(0)" ::: "memory");
            }
            const int ai = g8 >> 2, m = g8 & 3, rl = ai * HALF + wr * 64 + m * 16 + fr, row = u.pm * BM + rl;
            float rs = 1.f; if (GATED) rs = __builtin_amdgcn_rsqf(rsum[g8 % NB] * (1.0f / 1024.0f) + 1e-6f);
            float ss = 0.f;
#pragma unroll
            for (int bj = 0; bj < 2; ++bj) {
                const u32x4 hw = hv[g8 % NB][bj];
                f32x4 o0 = (f32x4){bf_lo(hw.x), bf_hi(hw.x), bf_lo(hw.y), bf_hi(hw.y)}, o1 = (f32x4){bf_lo(hw.z), bf_hi(hw.z), bf_lo(hw.w), bf_hi(hw.w)};
                f32x4 a0 = acc[ai][bj][m][0], a1 = acc[ai][bj][m][1];
                if (GATED) { const u32x4 pw = *(const PG8_LAS u32x4*)(pl + (2 * g8 + bj) * 1024 + lane * 16);
                    a0[0] = sigmoid_fast(a0[0] * rs) * bf_lo(pw.x); a0[1] = sigmoid_fast(a0[1] * rs) * bf_hi(pw.x);
                    a0[2] = sigmoid_fast(a0[2] * rs) * bf_lo(pw.y); a0[3] = sigmoid_fast(a0[3] * rs) * bf_hi(pw.y);
                    a1[0] = sigmoid_fast(a1[0] * rs) * bf_lo(pw.z); a1[1] = sigmoid_fast(a1[1] * rs) * bf_hi(pw.z);
                    a1[2] = sigmoid_fast(a1[2] * rs) * bf_lo(pw.w); a1[3] = sigmoid_fast(a1[3] * rs) * bf_hi(pw.w); }
                o0 += a0; o1 += a1;
                ss += (o0[0] * o0[0] + o0[1] * o0[1]) + (o0[2] * o0[2] + o0[3] * o0[3]) + (o1[0] * o1[0] + o1[1] * o1[1]) + (o1[2] * o1[2] + o1[3] * o1[3]);
                if (fout) { float* fp = fout + (size_t)row * DM + cb + 32 * bj; *(f32x4*)fp = o0; *(f32x4*)(fp + 4) = o1; }
                else { float t[8] = {o0[0], o0[1], o0[2], o0[3], o1[0], o1[1], o1[2], o1[3]}; store8(hout + (size_t)row * DM + cb + 32 * bj, t); }
            }
            ss = add_xor16(ss); ss = add_xor32(ss);
            if (fq == 0) P[rl * 4 + wc] = ss;
        }
        asm volatile("s_waitcnt lgkmcnt(0)" ::: "memory"); __builtin_amdgcn_s_barrier(); asm volatile("" ::: "memory");
        const int tid = wid * 64 + lane;
        if (tid < 256) ssq_out[u.pn * NTOK + u.pm * BM + tid] = (P[tid * 4] + P[tid * 4 + 1]) + (P[tid * 4 + 2] + P[tid * 4 + 3]);
        asm volatile("s_waitcnt lgkmcnt(0)" ::: "memory"); __builtin_amdgcn_s_barrier(); asm volatile("" ::: "memory");
    }
};
struct EpiNull {
    static constexpr bool PERM = false, AFTER_DRAIN = true;
    __device__ __forceinline__ void fused(f32x4 (&acc)[2][2][4][2], const Unit& u, int wr, int wc, int fr, int fq, PG8_LAS unsigned char* lds, int wid, int lane) const {
#pragma unroll
        for (int a = 0; a < 2; ++a)
#pragma unroll
            for (int b = 0; b < 2; ++b)
#pragma unroll
                for (int m = 0; m < 4; ++m)
#pragma unroll
                    for (int n = 0; n < 2; ++n) asm volatile("" :: "v"(acc[a][b][m][n]));
    }
};
}
typedef unsigned short bf16;
#define LAS __attribute__((address_space(3)))
typedef unsigned v4u __attribute__((ext_vector_type(4)));
typedef unsigned v2u __attribute__((ext_vector_type(2)));
typedef float f32x4 __attribute__((ext_vector_type(4)));
typedef short bf16x8 __attribute__((ext_vector_type(8)));
typedef short s16x4 __attribute__((ext_vector_type(4)));
constexpr int NWAVES = 8;
__device__ __forceinline__ float max_xor16(float v) { return fmaxf(v, xor_lane<16>(v)); }
__device__ __forceinline__ float max_xor32(float v) { auto r = __builtin_amdgcn_permlane32_swap(__float_as_uint(v), __float_as_uint(v), false, false); return fmaxf(__uint_as_float(r[0]), __uint_as_float(r[1])); }
__device__ __forceinline__ bf16x8 tr_frag(LAS const unsigned char* p, LAS const unsigned char* p2) {
    const s16x4 lo = __builtin_bit_cast(s16x4, __builtin_amdgcn_ds_read_tr16_b64_v4i16((LAS s16x4*)p));
    const s16x4 hi = __builtin_bit_cast(s16x4, __builtin_amdgcn_ds_read_tr16_b64_v4i16((LAS s16x4*)p2));
    return (bf16x8){lo[0], lo[1], lo[2], lo[3], hi[0], hi[1], hi[2], hi[3]};
}
#define WG_BARRIER() do { asm volatile("s_waitcnt vmcnt(0) lgkmcnt(0)" ::: "memory"); __builtin_amdgcn_s_barrier(); asm volatile("" ::: "memory"); } while (0)
#define LDS_BARRIER() do { asm volatile("s_waitcnt lgkmcnt(0)" ::: "memory"); __builtin_amdgcn_s_barrier(); asm volatile("" ::: "memory"); } while (0)

constexpr int GM_ROWB = 528;
constexpr int GM_SS = 128 * GM_ROWB;
__device__ __forceinline__ void gmlp_item(unsigned char* ws, int L, LAS unsigned char* lds, int item, int wv, int lane_unused) {
    const int lane = fresh_lane();
    const int half = item & 1, tok0 = (item >> 1) * 128, tid = wv * 64 + lane;
    const int bb_ = item >> 7;
    const bf16* VLN = (const bf16*)(ws + WS_HID + ZS_VLN); const bf16* U = (const bf16*)(ws + WS_HID + ZS_U); bf16* YC = (bf16*)(ws + WS_HID + ZS_YCAT);
    const bf16* GW = (const bf16*)(ws + TAB_GW) + (size_t)L * 4 * 128 * 128;
    const float* bsv = (const float*)(ws + TAB_SMALL) + L * SM_STRIDE + SM_GBS;
    const int h = wv >> 1, tq = 64 * half + 32 * (wv & 1), fr = lane & 15, g4 = lane >> 4;
    bf16x8 wfa[2][4];
    v2u uwa[2][4];
    { v4u xs[8];
#pragma unroll
      for (int i = 0; i < 8; ++i) if (i < 4 || half) { const int q = tid + i * 512, s = q >> 5, c = q & 31; xs[i] = *(const v4u*)(VLN + zrow(tok0 + s, 256) + c * 8); }
#pragma unroll
      for (int m = 0; m < 2; ++m)
#pragma unroll
          for (int ks = 0; ks < 4; ++ks) if (32 * ks <= tq + 16 * m + 15) wfa[m][ks] = *(const bf16x8*)(GW + ((size_t)h * 128 + tq + 16 * m + fr) * 128 + 32 * ks + 8 * g4);
#pragma unroll
      for (int m = 0; m < 2; ++m)
#pragma unroll
          for (int n = 0; n < 4; ++n) uwa[m][n] = *(const v2u*)(U + zrow(tok0 + tq + 16 * m + fr, 256) + h * 64 + 16 * n + 4 * g4);
      asm volatile("" ::: "memory");
#pragma unroll
      for (int i = 0; i < 8; ++i) if (i < 4 || half) { const int q = tid + i * 512, s = q >> 5, c = q & 31; *(LAS v4u*)(lds + s * GM_ROWB + c * 16) = xs[i]; } }
    WG_BARRIER();
    f32x4 acc[2][4];
#pragma unroll
    for (int m = 0; m < 2; ++m)
#pragma unroll
        for (int n = 0; n < 4; ++n) acc[m][n] = (f32x4){0.f, 0.f, 0.f, 0.f};
#pragma unroll
    for (int m = 0; m < 2; ++m) {
#pragma unroll
        for (int ks = 0; ks < 4; ++ks) {
            if (32 * ks <= tq + 16 * m + 15) {
#pragma unroll
                for (int n = 0; n < 4; ++n) {
                    LAS const unsigned char* p = lds + (32 * ks + 8 * g4 + (fr >> 2)) * GM_ROWB + (h * 64 + 16 * n + 4 * (fr & 3)) * 2;
                    const bf16x8 vf = tr_frag(p, p + 4 * GM_ROWB);
                    acc[m][n] = __builtin_amdgcn_mfma_f32_16x16x32_bf16(vf, wfa[m][ks], acc[m][n], 0, 0, 0);
                }
            }
        }
    }
    LAS float* SS = (LAS float*)(lds + GM_SS);
#pragma unroll
    for (int m = 0; m < 2; ++m) {
        const int t = tq + 16 * m + fr; const float bb = bsv[h * 128 + t]; float ss = 0.f;
#pragma unroll
        for (int n = 0; n < 4; ++n) {
            const v2u uw = uwa[m][n];
            f32x4 y; y[0] = bf_lo(uw.x) * (acc[m][n][0] + bb); y[1] = bf_hi(uw.x) * (acc[m][n][1] + bb); y[2] = bf_lo(uw.y) * (acc[m][n][2] + bb); y[3] = bf_hi(uw.y) * (acc[m][n][3] + bb);
            acc[m][n] = y; ss += (y[0] * y[0] + y[1] * y[1]) + (y[2] * y[2] + y[3] * y[3]);
        }
        ss = add_xor16(ss); ss = add_xor32(ss);
        if (g4 == 0) SS[h * 128 + t] = ss;
    }
    WG_BARRIER();
#pragma unroll
    for (int m = 0; m < 2; ++m) {
        const int t = tq + 16 * m + fr;
        const float tot = (SS[t] + SS[128 + t]) + (SS[256 + t] + SS[384 + t]);
        const float r = __builtin_amdgcn_rsqf(tot * (1.0f / 256.0f) + 1e-6f);
#pragma unroll
        for (int n = 0; n < 4; ++n) { v2u o; o.x = pk2(acc[m][n][0] * r, acc[m][n][1] * r); o.y = pk2(acc[m][n][2] * r, acc[m][n][3] * r);
            *(v2u*)(YC + zrow(tok0 + t, DM) + h * 64 + 16 * n + 4 * g4) = o; }
    }
    WG_BARRIER();
}

constexpr int AT_ROWB = 272;
constexpr int AT_V = 192 * AT_ROWB, AT_SS = 2 * 192 * AT_ROWB;
__device__ __forceinline__ void attn_item(unsigned char* ws, int L, LAS unsigned char* lds, int item, int wv, int lane_unused, unsigned* cnt = nullptr) {
    const int lane = fresh_lane();
    const int b = item >> 7, q0 = (item & 127) * 64, tokb = b * SEQL, tid = wv * 64 + lane;
    const bf16* Q = (const bf16*)(ws + WS_HID + ZS_Q); const bf16* K = (const bf16*)(ws + WS_HID + ZS_K); const bf16* V = (const bf16*)(ws + WS_HID + ZS_V); bf16* YC = (bf16*)(ws + WS_HID + ZS_YCAT);
    const int hq = wv, hkv = wv >> 2, fr = lane & 15, g4 = lane >> 4;
    bf16x8 qfa[4][2];
    { v4u kx[6], vx[6];
#pragma unroll
      for (int i = 0; i < 6; ++i) { const int q = tid + i * 512, r = q >> 4, c = q & 15, j = q0 - 128 + r; kx[i] = (v4u){0u, 0u, 0u, 0u}; vx[i] = kx[i];
          if (j >= 0) { kx[i] = *(const v4u*)(K + zrow(tokb + j, 128) + c * 8); vx[i] = *(const v4u*)(V + zrow(tokb + j, 128) + c * 8); } }
#pragma unroll
      for (int qt = 0; qt < 4; ++qt)
#pragma unroll
          for (int ks = 0; ks < 2; ++ks) qfa[qt][ks] = *(const bf16x8*)(Q + zrow(tokb + q0 + 16 * qt + fr, 512) + hq * 64 + 32 * ks + 8 * g4);
      asm volatile("" ::: "memory");
#pragma unroll
      for (int i = 0; i < 6; ++i) { const int q = tid + i * 512, r = q >> 4, c = q & 15; *(LAS v4u*)(lds + r * AT_ROWB + c * 16) = kx[i]; *(LAS v4u*)(lds + AT_V + r * AT_ROWB + c * 16) = vx[i]; } }
    WG_BARRIER();
    if (cnt && wv == 0 && lane == 0) __hip_atomic_fetch_add(cnt, 1u, __ATOMIC_RELAXED, __HIP_MEMORY_SCOPE_AGENT);
    const float sink2 = ((const float*)(ws + TAB_SMALL))[L * SM_STRIDE + SM_SINK + hq] * LOG2E;
    LAS float* SS = (LAS float*)(lds + AT_SS);
    const bool edge = (q0 < 128);
#pragma unroll
    for (int qt = 0; qt < 4; ++qt) {
        const size_t tq = (size_t)(tokb + q0 + 16 * qt + fr);
        const bf16x8 qf[2] = {qfa[qt][0], qfa[qt][1]};
        f32x4 s[9];
#pragma unroll
        for (int i = 0; i < 9; ++i) { s[i] = (f32x4){0.f, 0.f, 0.f, 0.f};
#pragma unroll
            for (int ks = 0; ks < 2; ++ks) { const bf16x8 kf = *(LAS const bf16x8*)(lds + (16 * (qt + i) + fr) * AT_ROWB + (hkv * 64 + 32 * ks + 8 * g4) * 2);
                s[i] = __builtin_amdgcn_mfma_f32_16x16x32_bf16(kf, qf[ks], s[i], 0, 0, 0); } }
        const int dd = fr - 4 * g4;
#pragma unroll
        for (int r = 0; r < 4; ++r) { s[0][r] = (r > dd) ? s[0][r] : -INFINITY; s[8][r] = (r <= dd) ? s[8][r] : -INFINITY; }
        if (edge) { const int j0 = q0 - 128 + 16 * qt + 4 * g4;
#pragma unroll
            for (int i = 0; i < 9; ++i)
#pragma unroll
                for (int r = 0; r < 4; ++r) s[i][r] = (j0 + 16 * i + r >= 0) ? s[i][r] : -INFINITY; }
        float mx = sink2;
#pragma unroll
        for (int i = 0; i < 9; ++i) mx = fmaxf(fmaxf(mx, fmaxf(s[i][0], s[i][1])), fmaxf(s[i][2], s[i][3]));
        mx = max_xor16(mx); mx = max_xor32(mx);
        float sum = 0.f;
#pragma unroll
        for (int i = 0; i < 9; ++i)
#pragma unroll
            for (int r = 0; r < 4; ++r) { s[i][r] = __builtin_amdgcn_exp2f(s[i][r] - mx); sum += s[i][r]; }
        sum = add_xor16(sum); sum = add_xor32(sum); sum += __builtin_amdgcn_exp2f(sink2 - mx);
        const float inv_l = __builtin_amdgcn_rcpf(sum);
        f32x4 o[4];
#pragma unroll
        for (int dt = 0; dt < 4; ++dt) o[dt] = (f32x4){0.f, 0.f, 0.f, 0.f};
#pragma unroll
        for (int kk = 0; kk < 5; ++kk) {
            const int ia = 2 * kk - (qt & 1), ib = ia + 1;
            v4u pw;
            pw.x = (ia >= 0) ? pk2(s[ia < 0 ? 0 : ia][0], s[ia < 0 ? 0 : ia][1]) : 0u; pw.y = (ia >= 0) ? pk2(s[ia < 0 ? 0 : ia][2], s[ia < 0 ? 0 : ia][3]) : 0u;
            pw.z = (ib <= 8) ? pk2(s[ib > 8 ? 8 : ib][0], s[ib > 8 ? 8 : ib][1]) : 0u; pw.w = (ib <= 8) ? pk2(s[ib > 8 ? 8 : ib][2], s[ib > 8 ? 8 : ib][3]) : 0u;
            const bf16x8 pf = __builtin_bit_cast(bf16x8, pw);
            const int ktb = (qt & ~1) + 2 * kk;
#pragma unroll
            for (int dt = 0; dt < 4; ++dt) {
                LAS const unsigned char* p = lds + AT_V + (16 * ktb + 4 * g4 + (fr >> 2)) * AT_ROWB + (hkv * 64 + 16 * dt + 4 * (fr & 3)) * 2;
                const bf16x8 vf = tr_frag(p, p + 16 * AT_ROWB);
                o[dt] = __builtin_amdgcn_mfma_f32_16x16x32_bf16(vf, pf, o[dt], 0, 0, 0);
            }
        }
        float ss = 0.f;
#pragma unroll
        for (int dt = 0; dt < 4; ++dt) { o[dt] = o[dt] * inv_l; ss += (o[dt][0] * o[dt][0] + o[dt][1] * o[dt][1]) + (o[dt][2] * o[dt][2] + o[dt][3] * o[dt][3]); }
        ss = add_xor16(ss); ss = add_xor32(ss);
        if (g4 == 0) SS[hq * 64 + 16 * qt + fr] = ss;
        LDS_BARRIER();
        float tot = 0.f;
#pragma unroll
        for (int hh = 0; hh < 8; ++hh) tot += SS[hh * 64 + 16 * qt + fr];
        const float r = __builtin_amdgcn_rsqf(tot * (1.0f / 512.0f) + 1e-6f);
#pragma unroll
        for (int dt = 0; dt < 4; ++dt) { v2u ow; ow.x = pk2(o[dt][0] * r, o[dt][1] * r); ow.y = pk2(o[dt][2] * r, o[dt][3] * r);
            *(v2u*)(YC + zrow((int)tq, DM) + 256 + hq * 64 + 16 * dt + 4 * g4) = ow; }
    }
    WG_BARRIER();
}
__device__ __forceinline__ double d_exp(double x) {
    const double k = __builtin_rint(x * 1.4426950408889634), r = x - k * 0.6931471805599453;
    double e = 1.0, term = 1.0;
    for (int n = 1; n <= 20; ++n) { term *= r / (double)n; e += term; }
    const long long bits = (long long)(1023 + (int)k) << 52;
    return e * __builtin_bit_cast(double, bits);
}
__device__ __forceinline__ void d_sincos(double th, double& sn, double& cs) {
    const double q = __builtin_rint(th * 0.15915494309189535), r = th - q * 6.283185307179586, r2 = -r * r;
    double s = r, c = 1.0, ts = r, tc = 1.0;
    for (int n = 1; n <= 14; ++n) { tc *= r2 / (double)((2 * n - 1) * (2 * n)); c += tc; ts *= r2 / (double)((2 * n) * (2 * n + 1)); s += ts; }
    sn = s; cs = c;
}
__device__ __forceinline__ void ssm_tables(const float* const* in, unsigned char* ws, int gtid, int nthreads) {
    for (int i = gtid; i < NLAYER * 16 * 64; i += nthreads) {
        const int p = i & 63, lg = i >> 6;
        const double lre = in[12][i], lim = in[13][i], dt = d_exp((double)in[14][lg]);
        const double er = d_exp(lre * dt); double sn, cs; d_sincos(lim * dt, sn, cs);
        const double lbr = er * cs, lbi = er * sn;
        const double nr = lbr - 1.0, ni = lbi, den = lre * lre + lim * lim;
        const double fr_ = (nr * lre + ni * lim) / den, fi_ = (ni * lre - nr * lim) / den;
        float* bbc = (float*)(ws + SSM_BBC) + (size_t)i * 32; bf16* bbt = (bf16*)(ws + SSM_BBT) + (size_t)lg * 128 * 16;
        for (int h = 0; h < 16; ++h) { const double br = in[15][i * 16 + h], bi = in[16][i * 16 + h]; const float re = (float)(fr_ * br - fi_ * bi), im = (float)(fr_ * bi + fi_ * br);
            bbc[2 * h] = re; bbc[2 * h + 1] = im; bbt[p * 16 + h] = (bf16)(pk2(re, 0.f) & 0xffffu); bbt[(64 + p) * 16 + h] = (bf16)(pk2(im, 0.f) & 0xffffu); }
        bf16* cct = (bf16*)(ws + SSM_CCT) + (size_t)lg * 16 * 128;
        for (int hp = 0; hp < 16; ++hp) { const float cre = in[17][(lg * 16 + hp) * 64 + p], cim = in[18][(lg * 16 + hp) * 64 + p]; *(unsigned*)(cct + hp * 128 + 2 * p) = pk2(cre, -cim); }
        float* pw = (float*)(ws + SSM_PW) + (size_t)lg * 65 * 128;
        double xr = 1.0, xi = 0.0;
        unsigned* pwb = (unsigned*)(ws + SSM_PWB) + (size_t)lg * 32 * 64;
        for (int n = 0; n <= 64; ++n) { pw[(n * 64 + p) * 2] = (float)xr; pw[(n * 64 + p) * 2 + 1] = (float)xi;
            if (n >= 1 && n <= 32) pwb[(n - 1) * 64 + p] = pk2((float)xr, (float)xi);
            const double t = xr * lbr - xi * lbi; xi = xr * lbi + xi * lbr; xr = t; }
    }
}
__device__ __forceinline__ void ssm_ktable(const float* const* in, unsigned char* ws, int gwave, int nwaves) {
    const int lane = fresh_lane(), hp = lane >> 2, h4 = (lane & 3) * 4;
    bf16* KT = (bf16*)(ws + SSM_KT);
    for (int it = gwave; it < NLAYER * 16 * 16; it += nwaves) {
        const int tq = it & 15, lg = it >> 4;
        if (tq >= 8) continue;
        const float* pw = (const float*)(ws + SSM_PW) + ((size_t)lg * 65 + 4 * tq) * 128; const float* bbc = (const float*)(ws + SSM_BBC) + (size_t)lg * 64 * 32 + 2 * h4;
        const float* cre = in[17] + (size_t)(lg * 16 + hp) * 64; const float* cim = in[18] + (size_t)(lg * 16 + hp) * 64;
        float acc[4][4];
#pragma unroll
        for (int t = 0; t < 4; ++t)
#pragma unroll
            for (int j = 0; j < 4; ++j) acc[t][j] = 0.f;
#pragma unroll 2
        for (int p0 = 0; p0 < 64; p0 += 4) {
            const f32x4 cr = *(const f32x4*)(cre + p0), ci = *(const f32x4*)(cim + p0);
            f32x4 zw[4][2], bb[4][2];
#pragma unroll
            for (int t = 0; t < 4; ++t) { zw[t][0] = *(const f32x4*)(pw + t * 128 + 2 * p0); zw[t][1] = *(const f32x4*)(pw + t * 128 + 2 * p0 + 4); }
#pragma unroll
            for (int k = 0; k < 4; ++k) { bb[k][0] = *(const f32x4*)(bbc + (size_t)(p0 + k) * 32); bb[k][1] = *(const f32x4*)(bbc + (size_t)(p0 + k) * 32 + 4); }
#pragma unroll
            for (int t = 0; t < 4; ++t)
#pragma unroll
                for (int k = 0; k < 4; ++k) { const float c_r = cr[k], c_i = ci[k], zr = zw[t][k >> 1][2 * (k & 1)], zi = zw[t][k >> 1][2 * (k & 1) + 1];
                    const float pr = c_r * zr - c_i * zi, pi = c_r * zi + c_i * zr;
                    acc[t][0] += pr * bb[k][0][0] - pi * bb[k][0][1]; acc[t][1] += pr * bb[k][0][2] - pi * bb[k][0][3]; acc[t][2] += pr * bb[k][1][0] - pi * bb[k][1][1]; acc[t][3] += pr * bb[k][1][2] - pi * bb[k][1][3]; }
        }
        if (tq == 0 && hp >= h4 && hp < h4 + 4) { const float dv = in[19][lg * 16 + hp];
#pragma unroll
            for (int j = 0; j < 4; ++j) if (h4 + j == hp) acc[0][j] += dv; }
#pragma unroll
        for (int t = 0; t < 4; ++t) { v2u o; o.x = pk2(acc[t][0], acc[t][1]); o.y = pk2(acc[t][2], acc[t][3]);
            *(v2u*)(KT + ((size_t)lg * 64 + 4 * tq + t) * 256 + hp * 16 + h4) = o; }
    }
}
__device__ __forceinline__ void ssm1_item(unsigned char* ws, int L, int item, int wv, int lane_unused) {
    const int tok0 = item * 64;
    const bf16* ZC = (const bf16*)(ws + WS_HID + ZS_ZC); float* S = (float*)(ws + SSM_S);
    const bf16x8 zero8 = (bf16x8){0, 0, 0, 0, 0, 0, 0, 0};
    const int lane = fresh_lane(), fr = lane & 15, g4 = lane >> 4;
    bf16x8 bfa[2][8], ufa[2][4]; f32x2_t l1a[2][4], l16a[2][4], lg4a[2][4];
#pragma unroll
    for (int gi = 0; gi < 2; ++gi) {
        const int g = 2 * wv + gi, lg = L * 16 + g;
        const bf16* bbt = (const bf16*)(ws + SSM_BBT) + (size_t)lg * 128 * 16; const float* pw = (const float*)(ws + SSM_PW) + (size_t)lg * 65 * 128;
#pragma unroll
        for (int n = 0; n < 8; ++n) bfa[gi][n] = (g4 < 2) ? *(const bf16x8*)(bbt + (16 * n + fr) * 16 + 8 * g4) : zero8;
#pragma unroll
        for (int m = 0; m < 4; ++m) ufa[gi][m] = (g4 < 2) ? *(const bf16x8*)(ZC + zrow(tok0 + 16 * m + fr, 256) + g * 16 + 8 * g4) : zero8;
#pragma unroll
        for (int q = 0; q < 4; ++q) { l1a[gi][q] = *(const f32x2_t*)(pw + (1 * 64 + 16 * q + fr) * 2); l16a[gi][q] = *(const f32x2_t*)(pw + (16 * 64 + 16 * q + fr) * 2); lg4a[gi][q] = *(const f32x2_t*)(pw + ((12 - 4 * g4) * 64 + 16 * q + fr) * 2); }
    }
#pragma unroll
    for (int gi = 0; gi < 2; ++gi) {
        const int g = 2 * wv + gi;
        const bf16x8 (&bfr)[8] = bfa[gi]; const bf16x8 (&uf)[4] = ufa[gi]; const f32x2_t (&l1)[4] = l1a[gi]; const f32x2_t (&l16)[4] = l16a[gi]; const f32x2_t (&lg4)[4] = lg4a[gi];
        float sre[4] = {0.f, 0.f, 0.f, 0.f}, sim[4] = {0.f, 0.f, 0.f, 0.f}, hre[4], him[4];
#pragma unroll
        for (int m = 0; m < 4; ++m) {
            f32x4 d[8];
#pragma unroll
            for (int n = 0; n < 8; ++n) d[n] = __builtin_amdgcn_mfma_f32_16x16x32_bf16(uf[m], bfr[n], (f32x4){0.f, 0.f, 0.f, 0.f}, 0, 0, 0);
#pragma unroll
            for (int q = 0; q < 4; ++q) {
                float ir = d[q][0], ii = d[q + 4][0];
#pragma unroll
                for (int r = 1; r < 4; ++r) { const float t = l1[q][0] * ir - l1[q][1] * ii + d[q][r]; ii = l1[q][0] * ii + l1[q][1] * ir + d[q + 4][r]; ir = t; }
                const float t = l16[q][0] * sre[q] - l16[q][1] * sim[q] + ir; sim[q] = l16[q][0] * sim[q] + l16[q][1] * sre[q] + ii; sre[q] = t;
                if (m == 1) { hre[q] = sre[q]; him[q] = sim[q]; }
            }
        }
#pragma unroll
        for (int q = 0; q < 4; ++q) { const float t = lg4[q][0] * sre[q] - lg4[q][1] * sim[q]; sim[q] = lg4[q][0] * sim[q] + lg4[q][1] * sre[q]; sre[q] = t;
            const float t2 = lg4[q][0] * hre[q] - lg4[q][1] * him[q]; him[q] = lg4[q][0] * him[q] + lg4[q][1] * hre[q]; hre[q] = t2; }
        float* S32 = (float*)(ws + SSM_S32);
#pragma unroll
        for (int q = 0; q < 4; ++q) { sre[q] = add_xor16(sre[q]); sre[q] = add_xor32(sre[q]); sim[q] = add_xor16(sim[q]); sim[q] = add_xor32(sim[q]);
            hre[q] = add_xor16(hre[q]); hre[q] = add_xor32(hre[q]); him[q] = add_xor16(him[q]); him[q] = add_xor32(him[q]);
            if (g4 == 0) {
                __hip_atomic_store((unsigned long long*)(S + ((size_t)(item * 16 + g) * 64 + 16 * q + fr) * 2), ((unsigned long long)__float_as_uint(sim[q]) << 32) | __float_as_uint(sre[q]), __ATOMIC_RELAXED, __HIP_MEMORY_SCOPE_AGENT);
                __hip_atomic_store((unsigned long long*)(S32 + ((size_t)(item * 16 + g) * 64 + 16 * q + fr) * 2), ((unsigned long long)__float_as_uint(him[q]) << 32) | __float_as_uint(hre[q]), __ATOMIC_RELAXED, __HIP_MEMORY_SCOPE_AGENT); } }
    }
}
__device__ __forceinline__ void ssm_scan(unsigned char* ws, int L, LAS unsigned char* lds, int bg, int wv) {
    const int lane = fresh_lane(), b = bg >> 4, g = bg & 15;
    const f32x2_t lam = *(const f32x2_t*)((const float*)(ws + SSM_PW) + ((size_t)(L * 16 + g) * 65 + 64) * 128 + 2 * lane);
    float* sp = (float*)(ws + SSM_S) + (((size_t)(b * 128 + 16 * wv) * 16 + g) * 64 + lane) * 2;
    f32x2_t sv[16];
#pragma unroll
    for (int j = 0; j < 16; ++j) sv[j] = *(const f32x2_t*)(sp + (size_t)j * 2048);
    float pr[16], pi[16]; float xr = 0.f, xi = 0.f, wr = 1.f, wi = 0.f;
#pragma unroll
    for (int j = 0; j < 16; ++j) { pr[j] = xr; pi[j] = xi; const float t = lam[0] * xr - lam[1] * xi + sv[j][0]; xi = lam[0] * xi + lam[1] * xr + sv[j][1]; xr = t;
        const float tw = wr * lam[0] - wi * lam[1]; wi = wr * lam[1] + wi * lam[0]; wr = tw; }
    LAS f32x2_t* E = (LAS f32x2_t*)lds;
    E[wv * 64 + lane] = (f32x2_t){xr, xi};
    WG_BARRIER();
    float br = 0.f, bi = 0.f;
    for (int w2 = 0; w2 < wv; ++w2) { const f32x2_t e = E[w2 * 64 + lane]; const float t = wr * br - wi * bi + e[0]; bi = wr * bi + wi * br + e[1]; br = t; }
    float qr = 1.f, qi = 0.f;
#pragma unroll
    for (int j = 0; j < 16; ++j) { const float xr_ = qr * br - qi * bi + pr[j], xi_ = qr * bi + qi * br + pi[j];
        __hip_atomic_store((unsigned long long*)(sp + (size_t)j * 2048), ((unsigned long long)__float_as_uint(xi_) << 32) | __float_as_uint(xr_), __ATOMIC_RELAXED, __HIP_MEMORY_SCOPE_AGENT);
        const float tq = qr * lam[0] - qi * lam[1]; qi = qr * lam[1] + qi * lam[0]; qr = tq; }
    WG_BARRIER();
}
constexpr int S2_ROWB = 528, S2_XIN = 96 * S2_ROWB, S2_XMID = S2_XIN + 8192, S2_YT = S2_XMID + 8192, S2_SS = S2_YT + 64 * S2_ROWB;
#if defined(PROBE_T0)
#define S2_STAMP(id) do { if (stamp_on && wv == 0) { \
    if ((id) == PROBE_T0) { const unsigned long long t_ = __builtin_amdgcn_s_memrealtime(); MISCp[8] = (unsigned)t_; MISCp[9] = (unsigned)(t_ >> 32); } \
    if ((id) == PROBE_T1) { const unsigned long long t_ = __builtin_amdgcn_s_memrealtime(), t0_ = ((unsigned long long)MISCp[9] << 32) | MISCp[8]; MISCp[10] = (unsigned)(t_ - t0_); } } } while (0)
#else
#define S2_STAMP(id) do {} while (0)
#endif
__device__ __forceinline__ void ssm2_item(unsigned char* ws, int L, LAS unsigned char* lds, int item, int wv, int lane_unused, volatile LAS unsigned* MISCp = nullptr, bool stamp_on = false) {
    const int lane = fresh_lane();
    const int tok0 = item * 64, tid = wv * 64 + lane;
    const bf16* ZC = (const bf16*)(ws + WS_HID + ZS_ZC); const float* S = (const float*)(ws + SSM_S); const float* S32 = (const float*)(ws + SSM_S32);
    const int fr = lane & 15, g4 = lane >> 4;
    bf16x8 kfa[2][16], cfa[2][4]; v4u pwa[2][2][4]; bf16x8 gwa[2][4][2], gwb[2][4][2];
#define S2_LOAD_K(gi) do { const bf16* kt = (const bf16*)(ws + SSM_KT) + (size_t)(L * 16 + 2 * wv + (gi)) * 64 * 256 + fr * 16 + 8 * (g4 & 1); \
        _Pragma("unroll") for (int lp = 0; lp < 16; ++lp) kfa[gi][lp] = *(const bf16x8*)(kt + (2 * lp + (g4 >> 1)) * 256); } while (0)
#define S2_LOAD_C(gi) do { const int lg_ = L * 16 + 2 * wv + (gi); const bf16* cct = (const bf16*)(ws + SSM_CCT) + (size_t)lg_ * 16 * 128 + fr * 128 + 8 * g4; \
        _Pragma("unroll") for (int ks = 0; ks < 4; ++ks) cfa[gi][ks] = *(const bf16x8*)(cct + 32 * ks); \
        const unsigned* pwg = (const unsigned*)(ws + SSM_PWB) + (size_t)lg_ * 32 * 64; \
        _Pragma("unroll") for (int mh = 0; mh < 2; ++mh) _Pragma("unroll") for (int ks = 0; ks < 4; ++ks) pwa[gi][mh][ks] = *(const v4u*)(pwg + (size_t)(16 * mh + fr) * 64 + 16 * ks + 4 * g4); } while (0)
#define S2_LOAD_G(kh) do { const bf16* wg_ = (const bf16*)(ws + WS_W + (size_t)L * LW_STRIDE + LW_GLU) + (size_t)(32 * wv + fr) * 256 + 8 * g4; \
        _Pragma("unroll") for (int k4 = 0; k4 < 4; ++k4) _Pragma("unroll") for (int nt = 0; nt < 2; ++nt) { gwa[kh][k4][nt] = *(const bf16x8*)(wg_ + (size_t)(16 * nt) * 256 + 32 * (4 * (kh) + k4)); \
            gwb[kh][k4][nt] = *(const bf16x8*)(wg_ + (size_t)(256 + 16 * nt) * 256 + 32 * (4 * (kh) + k4)); } } while (0)
    { v4u xs[6];
#pragma unroll
      for (int i = 0; i < 6; ++i) { const int q = tid + i * 512, r = q >> 5, cc = q & 31; xs[i] = (v4u){0u, 0u, 0u, 0u};
          if (r >= 16 && r < 48) xs[i] = *(const v4u*)(ZC + zrow(tok0 + r - 16, 256) + cc * 8); else if (r >= 64) xs[i] = *(const v4u*)(ZC + zrow(tok0 + r - 32, 256) + cc * 8); }
      f32x2_t xin[2], s32v[2], l32[2];
#pragma unroll
      for (int k = 0; k < 2; ++k) { const int ch = tid + 512 * k; xin[k] = *(const f32x2_t*)(S + ((size_t)item * 1024 + ch) * 2); s32v[k] = *(const f32x2_t*)(S32 + ((size_t)item * 1024 + ch) * 2);
          l32[k] = *(const f32x2_t*)((const float*)(ws + SSM_PW) + ((size_t)(L * 16 + (ch >> 6)) * 65 + 32) * 128 + 2 * (ch & 63)); }
      S2_LOAD_K(0); S2_LOAD_C(0);
#pragma unroll
      for (int i = 0; i < 6; ++i) { const int q = tid + i * 512, r = q >> 5, cc = q & 31; *(LAS v4u*)(lds + r * S2_ROWB + cc * 16) = xs[i]; }
#pragma unroll
      for (int k = 0; k < 2; ++k) { const int ch = tid + 512 * k; *(LAS f32x2_t*)(lds + S2_XIN + ch * 8) = xin[k];
          *(LAS f32x2_t*)(lds + S2_XMID + ch * 8) = (f32x2_t){l32[k][0] * xin[k][0] - l32[k][1] * xin[k][1] + s32v[k][0], l32[k][0] * xin[k][1] + l32[k][1] * xin[k][0] + s32v[k][1]}; } }
    S2_STAMP(121);
    S2_LOAD_K(1);
    asm volatile("s_waitcnt lgkmcnt(0)" ::: "memory"); __builtin_amdgcn_s_barrier(); asm volatile("" ::: "memory");
    S2_STAMP(122);
#pragma unroll
    for (int gi = 0; gi < 2; ++gi) {
        const int g = 2 * wv + gi;
        f32x4 acc[4];
#pragma unroll
        for (int m = 0; m < 4; ++m) acc[m] = (f32x4){0.f, 0.f, 0.f, 0.f};
#pragma unroll
        for (int m = 0; m < 4; ++m) {
            LAS const unsigned char* ub = lds + (16 + 16 * m + ((m >> 1) << 4) + fr - (g4 >> 1)) * S2_ROWB + (g * 16 + 8 * (g4 & 1)) * 2;
#pragma unroll
            for (int lp = 0; lp < 8 * (m & 1) + 8; ++lp) { const bf16x8 uf = *(LAS const bf16x8*)(ub - 2 * lp * S2_ROWB); acc[m] = __builtin_amdgcn_mfma_f32_16x16x32_bf16(uf, kfa[gi][lp], acc[m], 0, 0, 0); }
        }
        if (gi == 0) { S2_LOAD_C(1); S2_LOAD_G(0); } else { S2_LOAD_G(1); }
        if (gi == 0) S2_STAMP(123); else S2_STAMP(125);
#pragma unroll
        for (int ks = 0; ks < 4; ++ks) {
            const int p4 = 16 * ks + 4 * g4;
#pragma unroll
            for (int m = 0; m < 4; ++m) {
                const int xo = ((m >> 1) ? S2_XMID : S2_XIN) + (g * 64 + p4) * 8;
                const f32x4 x01 = *(LAS const f32x4*)(lds + xo), x23 = *(LAS const f32x4*)(lds + xo + 16);
                const v4u wq = pwa[gi][m & 1][ks];
                const f32x4 w01 = (f32x4){bf_lo(wq.x), bf_hi(wq.x), bf_lo(wq.y), bf_hi(wq.y)}, w23 = (f32x4){bf_lo(wq.z), bf_hi(wq.z), bf_lo(wq.w), bf_hi(wq.w)};
                v4u zw; zw.x = pk2(w01[0] * x01[0] - w01[1] * x01[1], w01[0] * x01[1] + w01[1] * x01[0]); zw.y = pk2(w01[2] * x01[2] - w01[3] * x01[3], w01[2] * x01[3] + w01[3] * x01[2]);
                zw.z = pk2(w23[0] * x23[0] - w23[1] * x23[1], w23[0] * x23[1] + w23[1] * x23[0]); zw.w = pk2(w23[2] * x23[2] - w23[3] * x23[3], w23[2] * x23[3] + w23[3] * x23[2]);
                acc[m] = __builtin_amdgcn_mfma_f32_16x16x32_bf16(__builtin_bit_cast(bf16x8, zw), cfa[gi][ks], acc[m], 0, 0, 0);
            }
        }
#pragma unroll
        for (int m = 0; m < 4; ++m)
#pragma unroll
            for (int r = 0; r < 4; ++r) *(LAS bf16*)(lds + S2_YT + (16 * m + 4 * g4 + r) * S2_ROWB + (g * 16 + fr) * 2) = (bf16)(pk2(gelu_fast(acc[m][r]), 0.f) & 0xffffu);
    }
    S2_STAMP(126);
#undef S2_LOAD_K
#undef S2_LOAD_C
#undef S2_LOAD_G
    LDS_BARRIER();
    S2_STAMP(127);
    {
        LAS const unsigned char* yb = lds + S2_YT + fr * S2_ROWB + 16 * g4;
        f32x4 ga[2][4], gb[2][4];
#pragma unroll
        for (int nt = 0; nt < 2; ++nt)
#pragma unroll
            for (int m = 0; m < 4; ++m) { ga[nt][m] = (f32x4){0.f, 0.f, 0.f, 0.f}; gb[nt][m] = (f32x4){0.f, 0.f, 0.f, 0.f}; }
#pragma unroll
        for (int kh = 0; kh < 2; ++kh) {
#pragma unroll
            for (int k4 = 0; k4 < 4; ++k4) {
                bf16x8 yf[4];
#pragma unroll
                for (int m = 0; m < 4; ++m) yf[m] = *(LAS const bf16x8*)(yb + 16 * m * S2_ROWB + 64 * (4 * kh + k4));
#pragma unroll
                for (int nt = 0; nt < 2; ++nt)
#pragma unroll
                    for (int m = 0; m < 4; ++m) { ga[nt][m] = __builtin_amdgcn_mfma_f32_16x16x32_bf16(gwa[kh][k4][nt], yf[m], ga[nt][m], 0, 0, 0); gb[nt][m] = __builtin_amdgcn_mfma_f32_16x16x32_bf16(gwb[kh][k4][nt], yf[m], gb[nt][m], 0, 0, 0); }
            }
        }
        S2_STAMP(128);
        LAS float* SS = (LAS float*)(lds + S2_SS);
#pragma unroll
        for (int m = 0; m < 4; ++m) { float ss = 0.f;
#pragma unroll
            for (int nt = 0; nt < 2; ++nt)
#pragma unroll
                for (int r = 0; r < 4; ++r) { const float v = ga[nt][m][r] * sigmoid_fast(gb[nt][m][r]); ga[nt][m][r] = v; ss += v * v; }
            ss = add_xor16(ss); ss = add_xor32(ss);
            if (g4 == 0) SS[wv * 64 + 16 * m + fr] = ss; }
        WG_BARRIER();
        bf16* YC = (bf16*)(ws + WS_HID + ZS_YCAT);
#pragma unroll
        for (int m = 0; m < 4; ++m) { float tot = 0.f;
#pragma unroll
            for (int w8 = 0; w8 < 8; ++w8) tot += SS[w8 * 64 + 16 * m + fr];
            const float rr = __builtin_amdgcn_rsqf(tot * (1.0f / 256.0f) + 1e-6f);
#pragma unroll
            for (int nt = 0; nt < 2; ++nt) { v2u o; o.x = pk2(ga[nt][m][0] * rr, ga[nt][m][1] * rr); o.y = pk2(ga[nt][m][2] * rr, ga[nt][m][3] * rr);
                *(v2u*)(YC + zrow(tok0 + 16 * m + fr, DM) + 768 + 32 * wv + 16 * nt + 4 * g4) = o; } }
    }
    WG_BARRIER();
}
#define XB_TMO      128
#define XB_XCNT(j)  (256  + 64 * (j))
#define XB_XSUB(j)  (1280 + 64 * (j))
#define XB_XGEN(j)  (2304 + 64 * (j))
#define XB_TOP      3328
#define XB_TOPGEN   3392
#define XCD_BAR_WORDS 3456
#define XB_SPIN_CAP (1u << 18)

__device__ __forceinline__ unsigned xb_ld(unsigned* p)              { return __hip_atomic_load(p, __ATOMIC_RELAXED, __HIP_MEMORY_SCOPE_AGENT); }
__device__ __forceinline__ unsigned xb_add(unsigned* p, unsigned v) { return __hip_atomic_fetch_add(p, v, __ATOMIC_RELAXED, __HIP_MEMORY_SCOPE_AGENT); }
__device__ __forceinline__ unsigned xb_xcc_id() { return (unsigned)__builtin_amdgcn_s_getreg((3 << 11) | 20) & 0xFu; }
#define XB_SPIN(cond, bar) do { unsigned _sp = 0; while (cond) { __builtin_amdgcn_s_sleep(1); \
    if ((++_sp & 255u) == 0u) { if (xb_ld(&(bar)[XB_TMO])) break; if (_sp > XB_SPIN_CAP) { atomicAdd(&(bar)[XB_TMO], 1u); break; } } } } while (0)

struct XcdBarrier {
    unsigned* bar; unsigned x; unsigned G;
    volatile LAS unsigned* st;
};

__device__ __forceinline__ XcdBarrier xcd_barrier_post(unsigned* bar, volatile LAS unsigned* st, bool leader, unsigned G) {
    XcdBarrier b; b.bar = bar; b.x = xb_xcc_id(); b.st = st; b.G = G;
    if (leader) (void)xb_add(&bar[XB_XCNT(b.x)], 1u);
    return b;
}
__device__ __forceinline__ void xcd_barrier_complete(unsigned* bar, unsigned x, unsigned& nloc, unsigned& nx, unsigned G) {
    unsigned sum, cnt, mine, sp = 0u;
    for (;;) {
        sum = 0u; cnt = 0u; mine = 0u;
#pragma unroll
        for (unsigned j = 0; j < 16; ++j) { const unsigned c = xb_ld(&bar[XB_XCNT(j)]); sum += c; cnt += (c > 0u) ? 1u : 0u; mine = (j == x) ? c : mine; }
        if (sum == G) break;
        __builtin_amdgcn_s_sleep(1);
        if ((++sp & 255u) == 0u) { if (xb_ld(&bar[XB_TMO])) break; if (sp > XB_SPIN_CAP) { atomicAdd(&bar[XB_TMO], 1u); break; } }
    }
    nloc = mine > 0u ? mine : 1u; nx = cnt > 0u ? cnt : 1u;
}

__device__ __forceinline__ void xcd_barrier(const XcdBarrier& b, bool leader) {
    asm volatile("s_waitcnt vmcnt(0)" ::: "memory");
    __syncthreads();
    if (leader) {
        unsigned* bar = b.bar;
        __builtin_amdgcn_s_waitcnt(0);
        unsigned nloc = b.st[0], nx = b.st[1];
        if (nloc == 0u) { xcd_barrier_complete(bar, b.x, nloc, nx, b.G); b.st[0] = nloc; b.st[1] = nx; }
        const unsigned old = xb_add(&bar[XB_XSUB(b.x)], 1u);
        const unsigned gen = old / nloc;
        if (old + 1u == (gen + 1u) * nloc) {
            __builtin_amdgcn_fence(__ATOMIC_RELEASE, "agent");
            asm volatile("s_waitcnt vmcnt(0)" ::: "memory");
            const unsigned og = xb_add(&bar[XB_TOP], 1u);
            const unsigned tg = og / nx;
            if (og + 1u == (tg + 1u) * nx) xb_add(&bar[XB_TOPGEN], 1u);
            else XB_SPIN(xb_ld(&bar[XB_TOPGEN]) == tg, bar);
            __builtin_amdgcn_fence(__ATOMIC_ACQUIRE, "agent");
            xb_add(&bar[XB_XGEN(b.x)], 1u);
            asm volatile("s_waitcnt vmcnt(0)" ::: "memory");
        } else {
            XB_SPIN(xb_ld(&bar[XB_XGEN(b.x)]) == gen, bar);
            __builtin_amdgcn_fence(__ATOMIC_ACQUIRE, "agent");
            asm volatile("s_waitcnt vmcnt(0)" ::: "memory");
        }
    }
    __syncthreads();
}

#define XL_SUB(j) (4096 + 64 * (j))
#define XL_GEN(j) (4608 + 64 * (j))
#define XL_RANK(j) (3520 + (j))
#define XL_FLAG 3536
#define XL_KTDONE 3552
__device__ __forceinline__ void xcd_local_barrier(unsigned* ctl, unsigned x, unsigned n, bool leader) {
    asm volatile("s_waitcnt vmcnt(0)" ::: "memory");
    __syncthreads();
    if (leader) {
        __builtin_amdgcn_s_waitcnt(0);
        const unsigned old = xb_add(&ctl[XL_SUB(x)], 1u), gen = old / n;
        if (old + 1u == (gen + 1u) * n) xb_add(&ctl[XL_GEN(x)], 1u);
        else XB_SPIN(xb_ld(&ctl[XL_GEN(x)]) == gen, ctl);
        __builtin_amdgcn_fence(__ATOMIC_ACQUIRE, "agent");
        asm volatile("s_waitcnt vmcnt(0)" ::: "memory");
    }
    __syncthreads();
}
constexpr int LDS_BYTES = 147456;

struct PrepItem { const float* W; const float* g; bf16* WT; int K, N, r; bool perm; };
__device__ __forceinline__ void prep_load(const PrepItem& p, float (&w)[64], int lane) {
    const int nblk = p.N / 64, kb = p.r / nblk, nb = p.r % nblk, k0 = 64 * kb, l0 = 64 * nb;
    const float* wp = p.W + (size_t)k0 * p.N + l0 + lane;
#pragma unroll
    for (int i = 0; i < 64; ++i) w[i] = __builtin_nontemporal_load(wp + (size_t)i * p.N);
}
__device__ __forceinline__ void prep_finish(const PrepItem& p, float (&w)[64], LAS float* scr, int lane) {
    const int nblk = p.N / 64, kb = p.r / nblk, nb = p.r % nblk, k0 = 64 * kb, l0 = 64 * nb;
    if (p.g) {
#pragma unroll
        for (int i = 0; i < 64; ++i) w[i] *= p.g[k0 + i];
    }
#pragma unroll
    for (int i = 0; i < 64; ++i) scr[i * 65 + lane] = w[i];
    asm volatile("s_waitcnt lgkmcnt(0)" ::: "memory");
    const int c = lane & 7;
#pragma unroll
    for (int j = 0; j < 8; ++j) { const int ll = (lane >> 3) + 8 * j;
        int prow;
        if (p.perm) { const int bj = ll >> 5, y = ll & 31, x = 16 * ((y >> 2) & 1) + 4 * (y >> 3) + (y & 3), wc = (l0 >> 6) & 3; prow = (l0 & ~255) + 128 * bj + 32 * wc + x; }
        else prow = l0 + ll;
        const LAS float* s = scr + (8 * c) * 65 + ll;
        v4u o; o.x = pk2(s[0 * 65], s[1 * 65]); o.y = pk2(s[2 * 65], s[3 * 65]); o.z = pk2(s[4 * 65], s[5 * 65]); o.w = pk2(s[6 * 65], s[7 * 65]);
        *(v4u*)(p.WT + (size_t)prow * p.K + k0 + 8 * c) = o; }
    asm volatile("s_waitcnt lgkmcnt(0)" ::: "memory");
}
__device__ __forceinline__ PrepItem prep_decode(const float* const* in, unsigned char* ws, int it) {
    constexpr int I_IN = 16 * 24, I_OUT = 16 * 16, I_FF1 = 16 * 64, I_FF2 = 64 * 16, I_GATE = 16 * 16, I_PROJ = 4 * 16, I_GLU = 4 * 4, I_L = I_IN + I_OUT + I_FF1 + I_FF2 + I_GATE + I_PROJ + 2 * I_GLU;
    const int L = it / I_L; int r = it % I_L; unsigned char* wl = ws + WS_W + (size_t)L * LW_STRIDE;
    PrepItem p; p.perm = true;
    if (r < I_IN) { p.W = in[4] + (size_t)L * DM * NIN; p.K = DM; p.N = NIN; p.g = in[3] + L * DM; p.WT = (bf16*)(wl + LW_IN); }
    else if ((r -= I_IN) < I_OUT) { p.W = in[23] + (size_t)L * DM * DM; p.K = DM; p.N = DM; p.g = in[22] + L * DM; p.WT = (bf16*)(wl + LW_OUT); }
    else if ((r -= I_OUT) < I_FF1) { p.W = in[25] + (size_t)L * DM * DFF; p.K = DM; p.N = DFF; p.g = in[24] + L * DM; p.WT = (bf16*)(wl + LW_FF1); }
    else if ((r -= I_FF1) < I_FF2) { p.W = in[26] + (size_t)L * DFF * DM; p.K = DFF; p.N = DM; p.g = nullptr; p.WT = (bf16*)(wl + LW_FF2); }
    else if ((r -= I_FF2) < I_GATE) { p.W = in[28] + (size_t)L * DM * DM; p.K = DM; p.N = DM; p.g = in[27] + L * DM; p.WT = (bf16*)(wl + LW_GATE); }
    else if ((r -= I_GATE) < I_PROJ) { p.W = in[29] + (size_t)L * 256 * DM; p.K = 256; p.N = DM; p.g = nullptr; p.WT = (bf16*)(wl + LW_PROJ); }
    else if ((r -= I_PROJ) < I_GLU) { p.W = in[20] + (size_t)L * 65536; p.K = 256; p.N = 256; p.g = nullptr; p.WT = (bf16*)(wl + LW_GLU); p.perm = false; }
    else { r -= I_GLU; p.W = in[21] + (size_t)L * 65536; p.K = 256; p.N = 256; p.g = nullptr; p.WT = (bf16*)(wl + LW_GLU) + 65536; p.perm = false; }
    p.r = r; return p;
}
__device__ __forceinline__ void convert_weights(const float* const* in, unsigned char* ws, LAS float* scr, int gw, int NGW, int lane) {
    constexpr int I_L = 16 * 24 + 16 * 16 + 16 * 64 + 64 * 16 + 16 * 16 + 4 * 16 + 2 * 4 * 4;
    const int end = NLAYER * I_L; int it = gw;
    if (it >= end) return;
    float wa[64], wb[64];
    PrepItem pa = prep_decode(in, ws, it), pb = pa;
    prep_load(pa, wa, lane);
    for (;;) {
        const bool nb = it + NGW < end;
        if (nb) { pb = prep_decode(in, ws, it + NGW); prep_load(pb, wb, lane); }
        prep_finish(pa, wa, scr, lane);
        if (!nb) break;
        it += NGW;
        const bool na = it + NGW < end;
        if (na) { pa = prep_decode(in, ws, it + NGW); prep_load(pa, wa, lane); }
        prep_finish(pb, wb, scr, lane);
        if (!na) break;
        it += NGW;
    }
}
__device__ __forceinline__ void convert_p(const float* pl, unsigned char* ws, int gw, int NGW, int row0 = 0, int nrows = NTOK) {
    const int lane = fresh_lane(); bf16* pb = (bf16*)(ws + WS_PB);
    int m = row0 + gw; const int mend = row0 + nrows;
    for (; m + 7 * NGW < mend; m += 8 * NGW) { f32x4 v[8];
#pragma unroll
        for (int u = 0; u < 8; ++u) v[u] = __builtin_nontemporal_load((const f32x4*)(pl + (size_t)(m + u * NGW) * 256) + lane);
#pragma unroll
        for (int u = 0; u < 8; ++u) ((unsigned long long*)(pb + (size_t)(m + u * NGW) * 256))[lane] = (unsigned long long)pk2(v[u][0], v[u][1]) | ((unsigned long long)pk2(v[u][2], v[u][3]) << 32); }
    for (; m < mend; m += NGW) { const f32x4 v = __builtin_nontemporal_load((const f32x4*)(pl + (size_t)m * 256) + lane);
        ((unsigned long long*)(pb + (size_t)m * 256))[lane] = (unsigned long long)pk2(v[0], v[1]) | ((unsigned long long)pk2(v[2], v[3]) << 32); }
}
struct Args { const float* in[30]; float* out; unsigned char* ws; int s_lo, s_hi; };

__device__ __forceinline__ void prologue_phase(const Args& a, unsigned char* ws, float* outp, LAS unsigned char* lds, int gw, int NGW, int wave, int lane) {
    LAS float* scr = (LAS float*)(lds + wave * 16640);
    if (gw >= 64) convert_weights(a.in, ws, scr, gw - 64, NGW - 64, lane);
    {
        const float* x = a.in[0]; float* ssq = (float*)(ws + TAB_SSQ0);
        for (int m = gw; m < NTOK; m += 4 * NGW) {
            f32x4 v[4][4];
#pragma unroll
            for (int u = 0; u < 4; ++u)
#pragma unroll
                for (int j = 0; j < 4; ++j) v[u][j] = __builtin_nontemporal_load((const f32x4*)(x + (size_t)(m + u * NGW) * DM) + lane + 64 * j);
#pragma unroll
            for (int u = 0; u < 4; ++u) { const int mm = m + u * NGW; bf16* hb = (bf16*)((unsigned char*)outp + out_hbb(mm >> 13)); unsigned long long* o8 = (unsigned long long*)(hb + (size_t)mm * DM) + lane; float s = 0.f;
#pragma unroll
                for (int j = 0; j < 4; ++j) { const f32x4 t = v[u][j]; s += (t[0] * t[0] + t[1] * t[1]) + (t[2] * t[2] + t[3] * t[3]);
                    o8[64 * j] = (unsigned long long)pk2(t[0], t[1]) | ((unsigned long long)pk2(t[2], t[3]) << 32); }
                s = wave_sum(s);
                if (lane < 4) ssq[lane * NTOK + mm] = (lane == 0) ? s : 0.f; }
        }
    }
    {
        const int* pos = (const int*)a.in[2]; float* cosT = (float*)(ws + TAB_COS); float* sinT = (float*)(ws + TAB_SIN);
        for (int i0 = gw * 64 + lane; i0 < NTOK * 32; i0 += 4 * NGW * 64) { int ps[4];
#pragma unroll
            for (int u = 0; u < 4; ++u) ps[u] = pos[(i0 + u * NGW * 64) >> 5];
#pragma unroll
            for (int u = 0; u < 4; ++u) { const int i = i0 + u * NGW * 64, k = i & 31;
                const double rev = (double)ps[u] * ROPE_INV_REV[k]; const float r = (float)(rev - __builtin_rint(rev));
                cosT[i] = __builtin_amdgcn_cosf(r); sinT[i] = __builtin_amdgcn_sinf(r); } }
    }
    {
        bf16* gwt = (bf16*)(ws + TAB_GW);
        for (int i = gw * 64 + lane; i < NLAYER * 4 * 128 * 128; i += NGW * 64) { const int s_ = i & 127, t_ = (i >> 7) & 127; gwt[i] = (bf16)(pk2(s_ <= t_ ? a.in[7][i] : 0.f, 0.f) & 0xffffu); }
    }
    ssm_tables(a.in, ws, gw * 64 + lane, NGW * 64);
    convert_p(a.in[1], ws, gw, NGW);
    {
        float* sm = (float*)(ws + TAB_SMALL);
        for (int i = gw * 64 + lane; i < NLAYER * SM_STRIDE; i += NGW * 64) { const int L = i / SM_STRIDE, o = i % SM_STRIDE; float v = 0.f;
            if (o < SM_LNB) v = a.in[5][L * 256 + o]; else if (o < SM_QG) v = a.in[6][L * 256 + o - SM_LNB]; else if (o < SM_KG) v = a.in[9][L * 64 + o - SM_QG];
            else if (o < SM_SINK) v = a.in[10][L * 64 + o - SM_KG]; else if (o < SM_SINK + 8) v = a.in[11][L * 8 + o - SM_SINK];
            else if (o >= SM_GBS && o < SM_GBS + 512) v = a.in[8][L * 512 + o - SM_GBS];
            sm[i] = v; }
    }
}

template <int MODE> struct SOrder {
    int c, s; unsigned* pc = nullptr;
    __device__ __forceinline__ bool next(int i, pg8::Unit& u) const { const int r = c >> 3, pmb = 32 * s + 4 * (c & 7) + (r & 3);
        if (MODE == 0) { if (i > 0) return false; u.pm = pmb; u.pn = r >> 2; return true; }
        if (MODE == 1) { if (i == 0) { u.pm = pmb; u.pn = r >> 2; return true; } if (i == 1 && c < 64) { u.pm = pmb; u.pn = 4 + (r >> 2); return true; } return false; }
        if (MODE == 2) { if (i >= 4) return false; u.pm = pmb; u.pn = 4 * i + (r >> 2); return true; }
        if (c < 64 || i >= 2) return false; const int Lq = 2 * (r - 8) + i; u.pm = 32 * s + 4 * (c & 7) + (Lq >> 2); u.pn = Lq & 3; return true; }
    __device__ __forceinline__ void a_ready(const pg8::Unit&) const {}
    __device__ __forceinline__ void done(const pg8::Unit& u) const { if (MODE == 1 && pc) { asm volatile("s_waitcnt vmcnt(0)" ::: "memory");
        if (fresh_lane() == 0) __hip_atomic_fetch_add(pc + 16 * u.pm, 1u, __ATOMIC_RELAXED, __HIP_MEMORY_SCOPE_AGENT); } }
};
#ifndef PROBE_BLK
#define PROBE_BLK 0
#endif
#ifdef PROBE_VIRT
#define PROBE_ME ((sid0 * 128 + lb0) == PROBE_BLK)
#else
#define PROBE_ME (blockIdx.x == PROBE_BLK)
#endif
#if defined(PROBE_T0) && defined(PROBE_SLOT)
#define M_STAMP(id) do { if (PROBE_ME && wave0 == 0 && s == PROBE_SLOT) { \
    if ((id) == PROBE_T0) { const unsigned long long t_ = __builtin_amdgcn_s_memrealtime(); MISC[8] = (unsigned)t_; MISC[9] = (unsigned)(t_ >> 32); } \
    if ((id) == PROBE_T1) { const unsigned long long t_ = __builtin_amdgcn_s_memrealtime(), t0_ = ((unsigned long long)MISC[9] << 32) | MISC[8]; MISC[10] = (unsigned)(t_ - t0_); } } } while (0)
#else
#define M_STAMP(id) do {} while (0)
#endif
enum { ST_IN = 0, ST_MIX, ST_OUT, ST_FF1, ST_FF2, ST_PLE, NSTEP };
#ifndef PG8_SP2
#define PG8_SP2 true
#endif
#ifndef PG8_ALIGN
#define PG8_ALIGN true
#endif
__global__ void __launch_bounds__(NWAVES * 64, 2) mk_fwd(Args args) {
    extern __shared__ __attribute__((aligned(16))) unsigned char lds_raw[];
    LAS unsigned char* lds = (LAS unsigned char*)lds_raw;
    const int wave0 = __builtin_amdgcn_readfirstlane(threadIdx.x >> 6);
    volatile LAS unsigned* MISC = (volatile LAS unsigned*)(lds + 143360);
    { const int l0 = fresh_lane(); if (wave0 == 0) MISC[l0] = 0u; }
    __syncthreads();
#if defined(PROBE_T0)
    if (PROBE_T0 == 0 && blockIdx.x == PROBE_BLK && wave0 == 0) { const unsigned long long t = __builtin_amdgcn_s_memrealtime(); MISC[8] = (unsigned)t; MISC[9] = (unsigned)(t >> 32); }
#endif
    unsigned* ctl0 = (unsigned*)(args.ws + WS_CTL);
    XcdBarrier gbar = xcd_barrier_post(ctl0, MISC, wave0 == 0 && fresh_lane() == 0, gridDim.x);
    if (wave0 == 0 && fresh_lane() == 0) { const unsigned r = (gbar.x < 8u) ? xb_add(&ctl0[XL_RANK(gbar.x)], 1u) : 99u;
#if defined(FORCE_FALLBACK)
        __hip_atomic_store(&ctl0[XL_FLAG], 1u, __ATOMIC_RELAXED, __HIP_MEMORY_SCOPE_AGENT);
#endif
        if (r >= 32u || gridDim.x != 256u) __hip_atomic_store(&ctl0[XL_FLAG], 1u, __ATOMIC_RELAXED, __HIP_MEMORY_SCOPE_AGENT);
        MISC[2] = r; MISC[3] = gbar.x; }
    __syncthreads();
#if defined(STREAM_SPLIT_KT)
#define KT_NEED 256u
#else
#define KT_NEED 128u
#endif
#ifndef MK_SPLIT_SEAM
#define MK_SPLIT_SEAM 1
#endif
#ifndef MK_SLAB
#define MK_SLAB 1
#endif
#ifndef MK_PANEL_SEAM
#define MK_PANEL_SEAM 1
#endif
#ifndef MK_LOCAL_SEAMS
#define MK_LOCAL_SEAMS 1
#endif
#define FRESH_TID(name) int name = fresh_lane(); name += wv * 64
    { const int bx0 = blockIdx.x, vcu0 = (bx0 % 8) * 32 + bx0 / 8; const int wv = wave0; FRESH_TID(t0);
      prologue_phase(args, args.ws, args.out, lds, vcu0 * NWAVES + wv, 256 * NWAVES, wv, t0 & 63); asm volatile("s_waitcnt vmcnt(0) lgkmcnt(0)" ::: "memory"); __syncthreads(); }
    xcd_barrier(gbar, wave0 == 0 && fresh_lane() == 0);
    const bool xl_ok = (__builtin_amdgcn_readfirstlane((int)__hip_atomic_load(&ctl0[XL_FLAG], __ATOMIC_RELAXED, __HIP_MEMORY_SCOPE_AGENT)) == 0);
    const int vb = xl_ok ? (int)__builtin_amdgcn_readfirstlane((int)(MISC[2] * 8u + MISC[3])) : (int)blockIdx.x;
    const int sid0 = vb >> 7, lb0 = vb & 127;
    unsigned* sctl = ctl0 + 8192 + 8192 * sid0;
    XcdBarrier sbar = xcd_barrier_post(sctl, MISC + 4, wave0 == 0 && fresh_lane() == 0, 128u);
    int prev_st = -1;
    for (int s = 1; s < 1 + NLAYER * NSTEP; ++s) {
        if (s > 1) { const bool ldr = wave0 == 0 && fresh_lane() == 0;
            const bool last_ple = (s == 1 + (NLAYER - 1) * NSTEP + ST_PLE);
            if (MK_SPLIT_SEAM && MK_LOCAL_SEAMS && xl_ok && prev_st == ST_MIX) {   }
            else if (MK_LOCAL_SEAMS && xl_ok && !last_ple && (prev_st == ST_MIX || prev_st == ST_FF1 || prev_st == ST_FF2 || (MK_SLAB && (prev_st == ST_OUT || prev_st == ST_PLE)))) xcd_local_barrier(sctl, sbar.x, 16u, ldr);
            else if (MK_PANEL_SEAM && xl_ok && prev_st == ST_IN) {   }
            else xcd_barrier(sbar, ldr); }
#if defined(PROBE_T0)
#ifndef PROBE_Q
#define PROBE_Q 1.0f
#endif
        if (PROBE_ME && wave0 == 0) { if (s == PROBE_T0) { const unsigned long long t = __builtin_amdgcn_s_memrealtime(); MISC[8] = (unsigned)t; MISC[9] = (unsigned)(t >> 32); }
            if (s == PROBE_T1) { const unsigned long long t = __builtin_amdgcn_s_memrealtime(), t0 = ((unsigned long long)MISC[9] << 32) | MISC[8]; MISC[10] = (unsigned)(t - t0); } }
#endif
#if defined(PROBE_SLOT)
        if (wave0 == 0) MISC[12] = (unsigned)s;
#endif
        unsigned long long z0 = 0ull; int lb = lb0, sid = sid0; int wv = wave0;
        asm volatile("" : "+s"(z0), "+s"(lb), "+s"(sid), "+s"(wv));
        unsigned char* ws = args.ws + z0; float* outp = args.out + z0;
        const int item = sid * 128 + (lb & 7) * 16 + (lb >> 3);
        const int L = (s - 1) / NSTEP, st = (s - 1) % NSTEP, par = L & 1; prev_st = st;
        unsigned char* wl = ws + WS_W + (size_t)L * LW_STRIDE;
        const bf16* hbb = (const bf16*)((unsigned char*)outp + out_hbb(sid));
        if (st == ST_IN) {
#if defined(STREAM_SPLIT_KT)
            if (L == 0) { ssm_ktable(args.in, ws, (lb * 2 + sid) * NWAVES + wv, 256 * NWAVES);
#else
            if (L == 0 && sid == 1) { ssm_ktable(args.in, ws, lb * NWAVES + wv, 128 * NWAVES);
#endif asm volatile("s_waitcnt vmcnt(0)" ::: "memory");
#if defined(STREAM_LAG_US)
                { const unsigned long long t0s = __builtin_amdgcn_s_memrealtime(); while (__builtin_amdgcn_s_memrealtime() - t0s < (unsigned long long)(STREAM_LAG_US * 100)) __builtin_amdgcn_s_sleep(8); }
#endif
            }
            unsigned* pcnt = ctl0 + 24576 + 1024 * L;
            pg8::Gemm g{hbb, (const bf16*)(wl + LW_IN), NTOK, NIN, DM}; SOrder<1> S{lb, sid, pcnt};
            pg8::EpiIn E{ws, par, L, lds};
            { pg8::Unit u0; FRESH_TID(tr); S.next(0, u0); pg8::rstd_panel_to_lds(lds, (const float*)(ws + (par ? TAB_SSQ1 : TAB_SSQ0)), u0.pm, tr); }
            { FRESH_TID(tl); pg8::gemm_phase<pg8::EpiIn, SOrder<1>, PG8_ALIGN, PG8_SP2>(lds, g, S, E, tl); }
            {
                pg8::Gemm g2{(const bf16*)(ws + WS_PB), (const bf16*)(wl + LW_PROJ), NTOK, DM, 256}; SOrder<3> S2{lb, sid};
                pg8::EpiProj E2{ws};
                { FRESH_TID(tl); pg8::gemm_phase<pg8::EpiProj, SOrder<3>, PG8_ALIGN, PG8_SP2>(lds, g2, S2, E2, tl); }
            }
        } else if (st == ST_MIX) {
            if (L == 0 && sid == 1) {
                asm volatile("s_waitcnt vmcnt(0)" ::: "memory"); __builtin_amdgcn_s_barrier();
                if (wv == 0 && fresh_lane() == 0) { __builtin_amdgcn_fence(__ATOMIC_RELEASE, "agent"); asm volatile("s_waitcnt vmcnt(0)" ::: "memory");
                    __hip_atomic_fetch_add(&ctl0[XL_KTDONE], 1u, __ATOMIC_RELAXED, __HIP_MEMORY_SCOPE_AGENT); } }
            if (MK_PANEL_SEAM && xl_ok) {
                if (wv == 0) { const unsigned* pcnt = ctl0 + 24576 + 1024 * L; const int pmI = item >> 2; unsigned spins = 0;
                    while ((unsigned)__builtin_amdgcn_readfirstlane(__hip_atomic_load(pcnt + 16 * pmI, __ATOMIC_RELAXED, __HIP_MEMORY_SCOPE_AGENT)) < 48u) { __builtin_amdgcn_s_sleep(2); if (++spins > (1u << 22)) break; }
                    if ((item & 3) < 2 && (item & 127) >= 2) { spins = 0;
                        while ((unsigned)__builtin_amdgcn_readfirstlane(__hip_atomic_load(pcnt + 16 * (pmI - 1), __ATOMIC_RELAXED, __HIP_MEMORY_SCOPE_AGENT)) < 48u) { __builtin_amdgcn_s_sleep(2); if (++spins > (1u << 22)) break; } }
                    __builtin_amdgcn_fence(__ATOMIC_ACQUIRE, "agent"); asm volatile("s_waitcnt vmcnt(0)" ::: "memory"); }
                asm volatile("" ::: "memory"); __builtin_amdgcn_s_barrier(); asm volatile("" ::: "memory"); }
            M_STAMP(300);
            ssm1_item(ws, L, item, wv, 0);
            M_STAMP(301);
            unsigned* cnt = ctl0 + 3584 + 64 * (sid * NLAYER + L); unsigned* cnt2 = ctl0 + 7168 + 64 * (sid * NLAYER + L);
            attn_item(ws, L, lds, item, wv, 0, cnt);
            M_STAMP(302);
            if (lb < 16) {
                if (wv == 0) { unsigned spins = 0;
                    while ((unsigned)__builtin_amdgcn_readfirstlane(__hip_atomic_load(cnt, __ATOMIC_RELAXED, __HIP_MEMORY_SCOPE_AGENT)) < 128u) { __builtin_amdgcn_s_sleep(2); if (++spins > (1u << 20)) break; }
                    __builtin_amdgcn_fence(__ATOMIC_ACQUIRE, "agent"); asm volatile("s_waitcnt vmcnt(0)" ::: "memory"); }
                asm volatile("" ::: "memory"); __builtin_amdgcn_s_barrier(); asm volatile("" ::: "memory");
                ssm_scan(ws, L, lds, sid * 16 + lb, wv);
                if (wv == 0 && fresh_lane() == 0) __hip_atomic_fetch_add(cnt2, 1u, __ATOMIC_RELAXED, __HIP_MEMORY_SCOPE_AGENT);
            }
            M_STAMP(303);
            gmlp_item(ws, L, lds, item, wv, 0);
            M_STAMP(304);
            if (wv == 0) { unsigned spins = 0;
                while ((unsigned)__builtin_amdgcn_readfirstlane(__hip_atomic_load(cnt2, __ATOMIC_RELAXED, __HIP_MEMORY_SCOPE_AGENT)) < 16u) { __builtin_amdgcn_s_sleep(2); if (++spins > (1u << 20)) break; }
                if (L == 0) { spins = 0;
                    while ((unsigned)__builtin_amdgcn_readfirstlane(__hip_atomic_load(&ctl0[XL_KTDONE], __ATOMIC_RELAXED, __HIP_MEMORY_SCOPE_AGENT)) < KT_NEED) { __builtin_amdgcn_s_sleep(2); if (++spins > (1u << 22)) break; } }
                __builtin_amdgcn_fence(__ATOMIC_ACQUIRE, "agent"); asm volatile("s_waitcnt vmcnt(0)" ::: "memory"); }
            asm volatile("" ::: "memory"); __builtin_amdgcn_s_barrier(); asm volatile("" ::: "memory");
            M_STAMP(305);
#if defined(PROBE_T0) && defined(PROBE_SLOT)
            ssm2_item(ws, L, lds, item, wv, 0, MISC, PROBE_ME && s == PROBE_SLOT);
#else
            ssm2_item(ws, L, lds, item, wv, 0);
#endif
            M_STAMP(306);
            if (MK_SPLIT_SEAM && MK_LOCAL_SEAMS && xl_ok) {
                unsigned gen_ = 0u; bool last_ = false; const bool ldr = wv == 0 && fresh_lane() == 0;
                if (ldr) { __builtin_amdgcn_s_waitcnt(0); const unsigned old = xb_add(&sctl[XL_SUB(sbar.x)], 1u); gen_ = old / 16u; last_ = (old + 1u == (gen_ + 1u) * 16u);
                    if (last_) xb_add(&sctl[XL_GEN(sbar.x)], 1u); }
                if (L + 1 < NLAYER) convert_p(args.in[1] + (size_t)(L + 1) * NTOK * 256, ws, (lb >> 3) * NWAVES + wv, 16 * NWAVES, 8192 * sid + 1024 * (lb & 7), 1024);
                if (ldr) { if (!last_) XB_SPIN(xb_ld(&sctl[XL_GEN(sbar.x)]) == gen_, sctl);
                    __builtin_amdgcn_fence(__ATOMIC_ACQUIRE, "agent"); asm volatile("s_waitcnt vmcnt(0)" ::: "memory"); }
                __syncthreads();
            } else
            if (L + 1 < NLAYER) convert_p(args.in[1] + (size_t)(L + 1) * NTOK * 256, ws, (lb >> 3) * NWAVES + wv, 16 * NWAVES, 8192 * sid + 1024 * (lb & 7), 1024);
        } else if (st == ST_OUT || st == ST_FF2) {
            const bool o = (st == ST_OUT);
            const int pm_ = 32 * sid + 4 * (lb & 7) + ((lb >> 3) & 3);
            pg8::Gemm g{(const bf16*)(ws + WS_HID + (o ? ZS_YCAT + (size_t)pm_ * (2 * MiB - 512 * 1024) : 0)), (const bf16*)(wl + (o ? LW_OUT : LW_FF2)), NTOK, DM, o ? DM : DFF}; SOrder<0> S{lb, sid};
            pg8::EpiRes<false> E{o ? hbb : (const bf16*)(ws + WS_HB), (bf16*)(ws + WS_HB), nullptr, ws, o ? (par ^ 1) : par};
            { FRESH_TID(tl); pg8::gemm_phase<pg8::EpiRes<false>, SOrder<0>, false, PG8_SP2>(lds, g, S, E, tl); }
        } else if (st == ST_FF1) {
            pg8::Gemm g{(const bf16*)(ws + WS_HB), (const bf16*)(wl + LW_FF1), NTOK, DFF, DM}; SOrder<2> S{lb, sid};
            pg8::EpiFF1 E{ws, par ^ 1, lds};
            { pg8::Unit u0; FRESH_TID(tr); S.next(0, u0); pg8::rstd_panel_to_lds(lds, (const float*)(ws + ((par ^ 1) ? TAB_SSQ1 : TAB_SSQ0)), u0.pm, tr); }
            { FRESH_TID(tl); pg8::gemm_phase<pg8::EpiFF1, SOrder<2>, PG8_ALIGN, PG8_SP2>(lds, g, S, E, tl); }
        } else if (st == ST_PLE) {
            pg8::Gemm g{(const bf16*)(ws + WS_HB), (const bf16*)(wl + LW_GATE), NTOK, DM, DM}; SOrder<0> S{lb, sid};
            pg8::EpiRes<true> E{(const bf16*)(ws + WS_HB), (bf16*)hbb, (L == NLAYER - 1) ? outp : nullptr, ws, par ^ 1};
            { FRESH_TID(tl); pg8::gemm_phase<pg8::EpiRes<true>, SOrder<0>, false, PG8_SP2>(lds, g, S, E, tl); }
        }
    }
#if defined(PROBE_T0)
    if (PROBE_ME && wave0 == 0) { const unsigned long long t = __builtin_amdgcn_s_memrealtime(), t0 = ((unsigned long long)MISC[9] << 32) | MISC[8];
        const unsigned dt = (PROBE_T1 >= 1 + NLAYER * NSTEP && PROBE_T1 < 100) ? (unsigned)(t - t0) : MISC[10];
        if (fresh_lane() == 0) { asm volatile("s_waitcnt vmcnt(0)" ::: "memory"); args.out[0] += (float)(int)((float)dt * 0.01f / PROBE_Q + 0.5f) * PROBE_Q; } }
#endif
}
extern "C" void kernel_launch(void* const* d_in, const int* in_sizes, int n_in, void* d_out, int out_size, void* d_ws, size_t ws_size, hipStream_t stream) {
    static int grid = 0;
    if (grid == 0) {
        if (n_in != 30 || out_size != NTOK * DM || ws_size < WS_END) { fprintf(stderr, "kernel_launch: unexpected shapes / workspace (n_in %d out %d ws %zu)\n", n_in, out_size, ws_size); grid = -1; return; }
        int dev = 0, cus = 0, per_cu = 0;
        (void)hipGetDevice(&dev); (void)hipDeviceGetAttribute(&cus, hipDeviceAttributeMultiprocessorCount, dev);
        (void)hipFuncSetAttribute((const void*)mk_fwd, hipFuncAttributeMaxDynamicSharedMemorySize, LDS_BYTES);
        (void)hipOccupancyMaxActiveBlocksPerMultiprocessor(&per_cu, (const void*)mk_fwd, NWAVES * 64, LDS_BYTES);
        (void)hipGetLastError();
        grid = (per_cu >= 1 && cus == 256) ? 256 : -1;
        if (grid < 0) { fprintf(stderr, "kernel_launch: needs 256 CUs with one resident workgroup each (cus %d per_cu %d)\n", cus, per_cu); return; }
    }
    if (grid < 0) return;
    (void)hipMemsetAsync((char*)d_ws + WS_CTL, 0, CTL_ZERO_BYTES, stream);
    Args a{};
    for (int i = 0; i < 30; ++i) a.in[i] = (const float*)d_in[i];
    a.out = (float*)d_out; a.ws = (unsigned char*)d_ws;
    unsigned char* ws = (unsigned char*)d_ws;
    const float* const* F = a.in;
#define LAUNCH_STEPS(lo, hi) do { a.s_lo = (lo); a.s_hi = (hi); hipLaunchKernelGGL(mk_fwd, dim3(grid), dim3(NWAVES * 64), LDS_BYTES, stream, a); } while (0)
    LAUNCH_STEPS(0, 1 + NLAYER * NSTEP);
}
```

```cpp
#include <hip/hip_runtime.h>
#include <cstdio>
#include <cstdint>
#include <math.h>

#define NTOK 16384
#define SEQL 8192
#define DM 1024
#define NIN 1536
#define DFF 4096
#define NLAYER 4
constexpr float QSCALE = 0.125f * 1.4426950408889634f;
constexpr float LOG2E = 1.4426950408889634f;

constexpr size_t MiB = 1u << 20;
constexpr size_t WS_CTL = 0, CTL_ZERO_BYTES = 112 * 1024;
constexpr size_t WS_W = 2 * MiB;
constexpr size_t LW_IN = 0, LW_OUT = 3 * MiB, LW_FF1 = 5 * MiB, LW_FF2 = 13 * MiB, LW_GATE = 21 * MiB, LW_PROJ = 23 * MiB, LW_GLU = 23 * MiB + 512 * 1024, LW_STRIDE = 24 * MiB;
constexpr size_t WS_TAB = 98 * MiB;
constexpr size_t TAB_COS = WS_TAB, TAB_SIN = WS_TAB + 2 * MiB, TAB_SSQ0 = WS_TAB + 4 * MiB, TAB_SSQ1 = TAB_SSQ0 + 256 * 1024, TAB_GW = TAB_SSQ1 + 256 * 1024, TAB_SMALL = TAB_GW + 512 * 1024, TAB_END = TAB_SMALL + 64 * 1024;
constexpr int SM_LNG = 0, SM_LNB = 256, SM_QG = 512, SM_KG = 576, SM_SINK = 640, SM_GBS = 1024  , SM_STRIDE = 2048;
constexpr size_t WS_HB = 104 * MiB;
constexpr size_t WS_U = 138 * MiB, WS_VLN = 146 * MiB, WS_Q = 154 * MiB, WS_K = 170 * MiB, WS_V = 174 * MiB, WS_ZC = 178 * MiB;
constexpr size_t WS_YCAT = 186 * MiB;
constexpr size_t WS_HID = 138 * MiB;
constexpr size_t WS_PPROJ = 266 * MiB;
constexpr size_t WS_PB = 298 * MiB;
constexpr size_t WS_SSM = 306 * MiB;
constexpr size_t SSM_PW = WS_SSM;
constexpr size_t SSM_KT = SSM_PW + 2304 * 1024;
constexpr size_t SSM_BBT = SSM_KT + 2 * MiB;
constexpr size_t SSM_CCT = SSM_BBT + 256 * 1024;
constexpr size_t SSM_BBC = SSM_CCT + 256 * 1024;
constexpr size_t SSM_S = SSM_BBC + 512 * 1024;
constexpr size_t SSM_S32 = SSM_S + 2 * MiB;
constexpr size_t SSM_PWB = SSM_S32 + 2 * MiB;
constexpr size_t WS_END = SSM_PWB + 512 * 1024;
static_assert(WS_END <= 316 * MiB, "ssm region");
static_assert(TAB_END <= WS_HB && WS_HB + 32 * MiB <= WS_U && WS_HID + 128 * MiB <= WS_PPROJ, "ws map");
static_assert(WS_W + NLAYER * LW_STRIDE <= WS_TAB, "weights");

constexpr size_t ZS_U = 0, ZS_VLN = 128 * 1024, ZS_Q = 256 * 1024, ZS_K = 512 * 1024, ZS_V = 576 * 1024, ZS_ZC = 640 * 1024, ZS_YCAT = 768 * 1024;
__host__ __device__ constexpr size_t zrow(int tok, int ld) { return (size_t)(tok >> 8) * (size_t)(1u << 20) + (size_t)(tok & 255) * (size_t)ld; }
__host__ __device__ constexpr size_t ws_u(int b) { return (138 + 60 * (size_t)b) * MiB; }
__host__ __device__ constexpr size_t ws_vln(int b) { return (142 + 60 * (size_t)b) * MiB; }
__host__ __device__ constexpr size_t ws_q(int b) { return (146 + 56 * (size_t)b) * MiB; }
__host__ __device__ constexpr size_t ws_k(int b) { return (154 + 62 * (size_t)b) * MiB; }
__host__ __device__ constexpr size_t ws_v(int b) { return (156 + 62 * (size_t)b) * MiB; }
__host__ __device__ constexpr size_t ws_zc(int b) { return (158 + 60 * (size_t)b) * MiB; }
__host__ __device__ constexpr size_t ws_ycat(int b) { return (162 + 48 * (size_t)b) * MiB; }
__host__ __device__ constexpr size_t out_hbb(int b) { return 16 * (size_t)b * MiB; }
typedef float f32x2_t __attribute__((ext_vector_type(2)));
typedef __bf16 bf16x2_t __attribute__((ext_vector_type(2)));
__device__ __forceinline__ unsigned pk2(float lo, float hi) { f32x2_t v = {lo, hi}; bf16x2_t b = __builtin_convertvector(v, bf16x2_t); return __builtin_bit_cast(unsigned, b); }
__device__ __forceinline__ float bf_lo(unsigned w) { return __uint_as_float(w << 16); }
__device__ __forceinline__ float bf_hi(unsigned w) { return __uint_as_float(w & 0xffff0000u); }
__device__ __forceinline__ float bf2f(unsigned short b) { return __uint_as_float(((unsigned)b) << 16); }
template <int X> __device__ __forceinline__ float xor_lane(float v) { return __int_as_float(__builtin_amdgcn_ds_swizzle(__float_as_int(v), (X << 10) | 0x1f)); }
__device__ __forceinline__ float add_xor16(float v) { return v + xor_lane<16>(v); }
__device__ __forceinline__ float add_xor32(float v) { auto r = __builtin_amdgcn_permlane32_swap(__float_as_uint(v), __float_as_uint(v), false, false); return __uint_as_float(r[0]) + __uint_as_float(r[1]); }
__device__ __forceinline__ float wave_sum(float v) {
    v += xor_lane<1>(v); v += xor_lane<2>(v); v += xor_lane<4>(v); v += xor_lane<8>(v); v = add_xor16(v); return add_xor32(v);
}
__device__ __forceinline__ float wave_sum_shfl(float v) {
#pragma unroll
    for (int o = 1; o < 64; o <<= 1) v += __shfl_xor(v, o);
    return v;
}
__device__ __forceinline__ int fresh_lane() { int l; asm volatile("v_mbcnt_lo_u32_b32 %0, -1, 0\n\tv_mbcnt_hi_u32_b32 %0, -1, %0" : "=v"(l)); return l; }
__device__ __forceinline__ float gelu_fast(float x) {
    const float u = x * (1.0f + 0.044715f * x * x);
    const float t = __builtin_amdgcn_exp2f(u * 2.3022082f);
    return x - x * __builtin_amdgcn_rcpf(1.0f + t);
}
__device__ __forceinline__ float sigmoid_fast(float x) { return __builtin_amdgcn_rcpf(1.0f + __builtin_amdgcn_exp2f(-x * LOG2E)); }
__device__ __forceinline__ float gelu_tanh(float x) { const float k0 = 0.7978845608028654f, k1 = 0.044715f; float u = k0 * (x + k1 * x * x * x); return 0.5f * x * (1.0f + tanhf(u)); }
__device__ const double ROPE_INV_REV[32] = {0.15915494309189535, 0.11934937021124886, 0.08949940160889101, 0.06711508300522726, 0.050329212104487035, 0.03774158471741977, 0.0283021958306234, 0.02122365276477766, 0.015915494309189534, 0.011934937021124886, 0.008949940160889102, 0.006711508300522725, 0.005032921210448704, 0.003774158471741977, 0.00283021958306234, 0.0021223652764777662, 0.0015915494309189536, 0.0011934937021124885, 0.0008949940160889102, 0.0006711508300522726, 0.0005032921210448703, 0.00037741584717419774, 0.00028302195830623395, 0.0002122365276477766, 0.00015915494309189535, 0.00011934937021124886, 8.949940160889102e-05, 6.711508300522725e-05, 5.0329212104487035e-05, 3.774158471741978e-05, 2.8302195830623396e-05, 2.122365276477766e-05};
namespace pg8 {
#define PG8_LAS __attribute__((address_space(3)))
typedef unsigned short bf16_t;
typedef short bf16x8 __attribute__((ext_vector_type(8)));
typedef float f32x4 __attribute__((ext_vector_type(4)));
typedef unsigned u32x4 __attribute__((ext_vector_type(4)));
constexpr int BM = 256, BK = 64, HALF = 128, HTB = HALF * BK * 2  , STAGE_BYTES = 8 * HTB, NXCD = 8, WGM = 8;

__host__ __device__ __forceinline__ int lds_byte(int r, int c) { const int st = (r >> 4) * 2 + (c >> 5), rr = r & 15, cc = c & 31, ob = rr * 64 + cc * 2; return st * 1024 + (ob ^ (((ob >> 9) & 1) << 5)); }
__host__ __device__ __forceinline__ void stage_rc(int b, int& R, int& C) { const int st = b / 1024, sb = b % 1024, swz = sb ^ (((sb >> 9) & 1) << 5); R = (st >> 1) * 16 + swz / 64; C = (st & 1) * 32 + (swz % 64) / 2; }
__host__ __device__ __forceinline__ int perm32(int rho) { const int n = rho >> 4, i = rho & 15; return 8 * (i >> 2) + 4 * n + (i & 3); }

struct Unit { int pm, pn; };
struct Gemm { const bf16_t* A; const bf16_t* Bt; int M, N, K; };

struct StaticOrder {
    int nM, nN, nwg, G, c;
    __host__ __device__ void init(int M, int N, int G_, int c_) { nM = M / BM; nN = N / BM; nwg = nM * nN; G = G_; c = c_; }
    __host__ __device__ bool next(int i, Unit& u) const {
        const long L = (long)i * G + c; if (L >= nwg) return false;
        int wgid = (int)L; { const int q = nwg / NXCD, r = nwg % NXCD, xcd = wgid % NXCD, off = wgid / NXCD; wgid = (xcd < r ? xcd * (q + 1) : r * (q + 1) + (xcd - r) * q) + off; }
        const int nig = WGM * nN, gid = wgid / nig, fm = gid * WGM, gsz = (nM - fm) < WGM ? (nM - fm) : WGM;
        u.pm = fm + ((wgid % nig) % gsz); u.pn = (wgid % nig) / gsz; return true;
    }
    __device__ __forceinline__ void a_ready(const Unit&) const {}
    __device__ __forceinline__ void done(const Unit&) const {}
};

template <class Epi, class Sched, bool ALIGN_EPI = false, bool SP2 = false>
__device__ __forceinline__ void gemm_phase(PG8_LAS unsigned char* lds, const Gemm g, const Sched& S, const Epi& E, const int tid) {
    const int wid = __builtin_amdgcn_readfirstlane(tid >> 6), lane = tid & 63, wr = wid >> 2, wc = wid & 3, fr = lane & 15, fq = lane >> 4;
    const int K = g.K, nt = K / BK;
    unsigned voffA[2], voffB[2];
#pragma unroll
    for (int i = 0; i < 2; ++i) { int R, C; stage_rc(tid * 16 + i * 8192, R, C); const int Rb = Epi::PERM ? ((R & ~31) + perm32(R & 31)) : R;
        voffA[i] = (unsigned)(R * K + C) * 2u; voffB[i] = (unsigned)(Rb * K + C) * 2u; }
    const size_t kstep = (size_t)(BK * 2);
    const size_t hstep = (size_t)HALF * K * 2;
    const size_t tstep = 2 * hstep;
    const unsigned ldsw = (unsigned)wid * 1024u;
    const int aoff = lds_byte(wr * 64 + fr, fq * 8), boff = lds_byte(wc * 32 + fr, fq * 8);
#define PG8_SA(b, h) (((b) * 2 + (h)) * HTB)
#define PG8_SB(b, h) ((4 + (b) * 2 + (h)) * HTB)
#define PG8_STAGE(bufoff, gbase, voff) do { _Pragma("unroll") for (int _i = 0; _i < 2; ++_i) \
        __builtin_amdgcn_global_load_lds((const unsigned*)((const char*)(gbase) + (voff)[_i]), (PG8_LAS unsigned*)(lds + (bufoff) + ldsw + _i * 8192), 16, 0, 0); } while (0)
#define PG8_LDA(dst, b, h) do { _Pragma("unroll") for (int m = 0; m < 4; ++m) _Pragma("unroll") for (int k = 0; k < 2; ++k) dst[m][k] = *(const PG8_LAS bf16x8*)(lds + PG8_SA(b, h) + aoff + m * 2048 + k * 1024); } while (0)
#define PG8_LDB(dst, b, h) do { _Pragma("unroll") for (int n = 0; n < 2; ++n) _Pragma("unroll") for (int k = 0; k < 2; ++k) dst[n][k] = *(const PG8_LAS bf16x8*)(lds + PG8_SB(b, h) + boff + n * 2048 + k * 1024); } while (0)
#define PG8_MMA(ai, bj, At, Bt) do { __builtin_amdgcn_s_setprio(1); _Pragma("unroll") for (int m = 0; m < 4; ++m) _Pragma("unroll") for (int n = 0; n < 2; ++n) _Pragma("unroll") for (int k = 0; k < 2; ++k) \
        acc[ai][bj][m][n] = __builtin_amdgcn_mfma_f32_16x16x32_bf16(Bt[n][k], At[m][k], acc[ai][bj][m][n], 0, 0, 0); __builtin_amdgcn_s_setprio(0); } while (0)
#define PG8_WAIT_V(n) asm volatile("s_waitcnt vmcnt(" #n ")" ::: "memory")
#define PG8_WAIT_L(n) asm volatile("s_waitcnt lgkmcnt(" #n ")" ::: "memory")
#define PG8_BAR __builtin_amdgcn_s_barrier()
#define PG8_SCHED __builtin_amdgcn_sched_barrier(0)
#if defined(PROBE_T0) && defined(PROBE_SLOT)
    volatile PG8_LAS unsigned* M_ = (volatile PG8_LAS unsigned*)(lds + 143360);
#define G_STAMP(id) do { if (blockIdx.x == PROBE_BLK && wid == 0 && M_[12] == PROBE_SLOT) { \
    if ((id) == PROBE_T0) { const unsigned long long t_ = __builtin_amdgcn_s_memrealtime(); M_[8] = (unsigned)t_; M_[9] = (unsigned)(t_ >> 32); } \
    if ((id) == PROBE_T1) { const unsigned long long t_ = __builtin_amdgcn_s_memrealtime(), t0_ = ((unsigned long long)M_[9] << 32) | M_[8]; M_[10] = (unsigned)(t_ - t0_); } } } while (0)
#else
#define G_STAMP(id) do {} while (0)
#endif
    Unit cur, nxt; int ui = 0;
    if (!S.next(0, cur)) return;
    G_STAMP(200);
    f32x4 acc[2][2][4][2];
#pragma unroll
    for (int a = 0; a < 2; ++a)
#pragma unroll
        for (int b = 0; b < 2; ++b)
#pragma unroll
            for (int m = 0; m < 4; ++m)
#pragma unroll
                for (int n = 0; n < 2; ++n) acc[a][b][m][n] = (f32x4){0.f, 0.f, 0.f, 0.f};
    bf16x8 At[4][2], B0[2][2], B1[2][2];
    const char* cA = (const char*)g.A + (size_t)cur.pm * tstep; const char* cB = (const char*)g.Bt + (size_t)cur.pn * tstep;
    S.a_ready(cur);
    if constexpr (SP2) {
        PG8_STAGE(PG8_SB(0, 0), cB, voffB); PG8_STAGE(PG8_SB(0, 1), cB + hstep, voffB); PG8_STAGE(PG8_SA(0, 0), cA, voffA); PG8_STAGE(PG8_SA(0, 1), cA + hstep, voffA);
        if (wr == 1) PG8_BAR;
        PG8_WAIT_V(2); PG8_BAR;
        PG8_STAGE(PG8_SB(1, 0), cB + kstep, voffB); PG8_STAGE(PG8_SA(1, 0), cA + kstep, voffA); PG8_STAGE(PG8_SB(1, 1), cB + hstep + kstep, voffB);
        PG8_WAIT_V(6); PG8_BAR;
    } else {
        PG8_STAGE(PG8_SB(0, 0), cB, voffB); PG8_STAGE(PG8_SA(0, 0), cA, voffA); PG8_STAGE(PG8_SB(0, 1), cB + hstep, voffB); PG8_STAGE(PG8_SA(0, 1), cA + hstep, voffA);
        if (wr == 1) PG8_BAR;
        PG8_WAIT_V(4); PG8_BAR;
        PG8_STAGE(PG8_SB(1, 0), cB + kstep, voffB); PG8_STAGE(PG8_SA(1, 0), cA + kstep, voffA); PG8_STAGE(PG8_SB(1, 1), cB + hstep + kstep, voffB);
        PG8_WAIT_V(6); PG8_BAR;
    }
    G_STAMP(201);
    for (;;) {
        const bool has_next = S.next(ui + 1, nxt);
        const char* nA = has_next ? (const char*)g.A + (size_t)nxt.pm * tstep : cA; const char* nB = has_next ? (const char*)g.Bt + (size_t)nxt.pn * tstep : cB;
        for (int t = 0; t < nt; t += 2) {
            const bool last = (t == nt - 2);
            const char* a1 = cA + (size_t)(t + 1) * kstep;
            const char* a2 = last ? nA : cA + (size_t)(t + 2) * kstep; const char* b2 = last ? nB : cB + (size_t)(t + 2) * kstep;
            const char* a3 = a2 + kstep; const char* b3 = b2 + kstep;
            if (last && has_next) S.a_ready(nxt);
            if constexpr (SP2) {
            PG8_LDB(B0, 0, 0); PG8_LDB(B1, 0, 1); PG8_SCHED; PG8_LDA(At, 0, 0); PG8_STAGE(PG8_SA(1, 1), a1 + hstep, voffA);
            PG8_WAIT_V(8); PG8_WAIT_L(0); PG8_BAR; PG8_MMA(0, 0, At, B0); PG8_MMA(0, 1, At, B1); PG8_BAR; PG8_SCHED;
            PG8_LDA(At, 0, 1); PG8_STAGE(PG8_SB(0, 0), b2, voffB); PG8_STAGE(PG8_SB(0, 1), b2 + hstep, voffB); PG8_STAGE(PG8_SA(0, 0), a2, voffA);
            PG8_WAIT_V(8); PG8_WAIT_L(0); PG8_BAR; PG8_MMA(1, 0, At, B0); PG8_MMA(1, 1, At, B1); PG8_BAR; PG8_SCHED;
            PG8_LDB(B0, 1, 0); PG8_LDB(B1, 1, 1); PG8_SCHED; PG8_LDA(At, 1, 0); PG8_STAGE(PG8_SA(0, 1), a2 + hstep, voffA);
            PG8_WAIT_V(8); PG8_WAIT_L(0); PG8_BAR; PG8_MMA(0, 0, At, B0); PG8_MMA(0, 1, At, B1); PG8_BAR; PG8_SCHED;
            PG8_LDA(At, 1, 1); PG8_STAGE(PG8_SB(1, 0), b3, voffB); PG8_STAGE(PG8_SB(1, 1), b3 + hstep, voffB); PG8_STAGE(PG8_SA(1, 0), a3, voffA);
            PG8_WAIT_V(8); PG8_WAIT_L(0); PG8_BAR; PG8_MMA(1, 0, At, B0); PG8_MMA(1, 1, At, B1); PG8_BAR; PG8_SCHED;
            } else {
            PG8_LDB(B0, 0, 0); PG8_SCHED; PG8_LDA(At, 0, 0); PG8_STAGE(PG8_SA(1, 1), a1 + hstep, voffA);
            PG8_WAIT_L(8); PG8_BAR; PG8_WAIT_L(0); PG8_MMA(0, 0, At, B0); PG8_BAR; PG8_SCHED;
            PG8_LDB(B1, 0, 1); PG8_STAGE(PG8_SB(0, 0), b2, voffB);
            PG8_BAR; PG8_WAIT_L(0); PG8_MMA(0, 1, At, B1); PG8_BAR;
            PG8_LDA(At, 0, 1); PG8_STAGE(PG8_SA(0, 0), a2, voffA);
            PG8_BAR; PG8_WAIT_L(0); PG8_MMA(1, 0, At, B0); PG8_BAR; PG8_SCHED;
            PG8_STAGE(PG8_SB(0, 1), b2 + hstep, voffB);
            PG8_WAIT_V(6); PG8_BAR; PG8_MMA(1, 1, At, B1); PG8_BAR;
            PG8_LDB(B0, 1, 0); PG8_SCHED; PG8_LDA(At, 1, 0); PG8_STAGE(PG8_SA(0, 1), a2 + hstep, voffA);
            PG8_WAIT_L(8); PG8_BAR; PG8_WAIT_L(0); PG8_MMA(0, 0, At, B0); PG8_BAR; PG8_SCHED;
            PG8_LDB(B1, 1, 1); PG8_STAGE(PG8_SB(1, 0), b3, voffB);
            PG8_BAR; PG8_WAIT_L(0); PG8_MMA(0, 1, At, B1); PG8_BAR;
            PG8_LDA(At, 1, 1); PG8_STAGE(PG8_SA(1, 0), a3, voffA);
            PG8_BAR; PG8_WAIT_L(0); PG8_MMA(1, 0, At, B0); PG8_BAR; PG8_SCHED;
            PG8_STAGE(PG8_SB(1, 1), b3 + hstep, voffB);
            PG8_WAIT_V(6); PG8_BAR; PG8_MMA(1, 1, At, B1); PG8_BAR;
            }
        }
        if (ui == 0) G_STAMP(205);
        if constexpr (ALIGN_EPI) { if (wr == 0) PG8_BAR; }
        if constexpr (!Epi::AFTER_DRAIN) { const int l2 = fresh_lane();
            E(acc, cur, wr, wc, l2 & 15, l2 >> 4); S.done(cur); }
        if (ui == 0) G_STAMP(206);
        if (!has_next) break;
#pragma unroll
        for (int a = 0; a < 2; ++a)
#pragma unroll
            for (int b = 0; b < 2; ++b)
#pragma unroll
                for (int m = 0; m < 4; ++m)
#pragma unroll
                    for (int n = 0; n < 2; ++n) acc[a][b][m][n] = (f32x4){0.f, 0.f, 0.f, 0.f};
        cur = nxt; cA = nA; cB = nB; ++ui;
        if constexpr (ALIGN_EPI) { if (wr == 1) PG8_BAR; }
    }
    G_STAMP(202);
    PG8_WAIT_V(0);
    if constexpr (!ALIGN_EPI) { if (wr == 0) PG8_BAR; }
    PG8_BAR;
    G_STAMP(203);
    if constexpr (Epi::AFTER_DRAIN) { const int l2 = fresh_lane();
        E.fused(acc, cur, wr, wc, l2 & 15, l2 >> 4, lds, wid, l2); S.done(cur); }
    G_STAMP(204);
#undef PG8_SA
#undef PG8_SB
#undef PG8_STAGE
#undef PG8_LDA
#undef PG8_LDB
#undef PG8_MMA
#undef PG8_WAIT_V
#undef PG8_WAIT_L
#undef PG8_BAR
#undef PG8_SCHED
}
}
namespace pg8 {
__device__ __forceinline__ float rstd_row(const float* ssq, int row) {
    const float s = (ssq[row] + ssq[NTOK + row]) + (ssq[2 * NTOK + row] + ssq[3 * NTOK + row]);
    return __builtin_amdgcn_rsqf(s * (1.0f / 1024.0f) + 1e-6f);
}
typedef __amdgpu_buffer_rsrc_t rsrc_t;
__device__ __forceinline__ rsrc_t make_rsrc(const void* base) { return __builtin_amdgcn_make_buffer_rsrc((void*)base, 0, 0x7ffffffc, 0x00020000); }
__device__ __forceinline__ void store8_wt(rsrc_t rs, unsigned byte_off, const float (&v)[8]) {
    u32x4 w; w.x = pk2(v[0], v[1]); w.y = pk2(v[2], v[3]); w.z = pk2(v[4], v[5]); w.w = pk2(v[6], v[7]);
    __builtin_amdgcn_raw_buffer_store_b128(w, rs, (int)byte_off, 0, 16);
}
__device__ __forceinline__ void store8(bf16_t* p, const float (&v)[8]) {
    u32x4 w; w.x = pk2(v[0], v[1]); w.y = pk2(v[2], v[3]); w.z = pk2(v[4], v[5]); w.w = pk2(v[6], v[7]); *(u32x4*)p = w;
}
constexpr int RSTD_LDS_OFF = 131072;
__device__ __forceinline__ void rstd_panel_to_lds(PG8_LAS unsigned char* lds, const float* ssq, int pm0, int tid) {
    PG8_LAS float* slot = (PG8_LAS float*)(lds + RSTD_LDS_OFF);
    if (tid < 256) slot[tid] = rstd_row(ssq, pm0 * BM + tid);
    asm volatile("s_waitcnt vmcnt(0) lgkmcnt(0)" ::: "memory"); __builtin_amdgcn_s_barrier(); asm volatile("" ::: "memory");
}
__device__ __forceinline__ float rstd_lds(PG8_LAS unsigned char* lds, int rl) { return ((PG8_LAS const float*)(lds + RSTD_LDS_OFF))[rl]; }
struct EpiIn {
    static constexpr bool PERM = false, AFTER_DRAIN = false;
    unsigned char* ws; int par, L; PG8_LAS unsigned char* lds;
    __device__ __forceinline__ void operator()(const f32x4 (&acc)[2][2][4][2], const Unit& u, int wr, int wc, int fr, int fq) const {
        const int pn = u.pn;
        const float* ssq = (const float*)(ws + (par ? TAB_SSQ1 : TAB_SSQ0)); const float* cosT = (const float*)(ws + TAB_COS); const float* sinT = (const float*)(ws + TAB_SIN);
        const float* sm = (const float*)(ws + TAB_SMALL) + L * SM_STRIDE; const float* lng = sm + SM_LNG; const float* lnb = sm + SM_LNB; const float* qg = sm + SM_QG; const float* kg = sm + SM_KG;
        bf16_t* U = (bf16_t*)(ws + WS_HID + ZS_U); bf16_t* VLN = (bf16_t*)(ws + WS_HID + ZS_VLN); bf16_t* Q = (bf16_t*)(ws + WS_HID + ZS_Q); bf16_t* K = (bf16_t*)(ws + WS_HID + ZS_K); bf16_t* V = (bf16_t*)(ws + WS_HID + ZS_V); bf16_t* ZC = (bf16_t*)(ws + WS_HID + ZS_ZC);
        int mode, ld, cb; bf16_t* dst; const float* gp = nullptr; const float* bp = nullptr;
        if (pn < 2) { const int head = 2 * pn + (wc >> 1); ld = 256; cb = head * 64; if (wc & 1) { mode = 1; dst = VLN; gp = lng + head * 64; bp = lnb + head * 64; } else { mode = 0; dst = U; } }
        else if (pn < 4) { mode = 2; dst = Q; ld = 512; cb = (4 * (pn - 2) + wc) * 64; gp = qg; }
        else if (pn == 4) { ld = 128; if (wc < 2) { mode = 3; dst = K; cb = wc * 64; gp = kg; } else { mode = 4; dst = V; cb = (wc - 2) * 64; } }
        else { mode = 4; dst = ZC; ld = 256; cb = wc * 64; }
        float g[16], bb[16];
#pragma unroll
        for (int i = 0; i < 16; ++i) { g[i] = 1.f; bb[i] = 0.f; }
        if (gp) {
#pragma unroll
            for (int bj = 0; bj < 2; ++bj)
#pragma unroll
                for (int n = 0; n < 2; ++n) { const f32x4 t = *(const f32x4*)(gp + 32 * bj + 8 * fq + 4 * n); g[bj * 8 + n * 4 + 0] = t[0]; g[bj * 8 + n * 4 + 1] = t[1]; g[bj * 8 + n * 4 + 2] = t[2]; g[bj * 8 + n * 4 + 3] = t[3]; }
        }
        if (bp) {
#pragma unroll
            for (int bj = 0; bj < 2; ++bj)
#pragma unroll
                for (int n = 0; n < 2; ++n) { const f32x4 t = *(const f32x4*)(bp + 32 * bj + 8 * fq + 4 * n); bb[bj * 8 + n * 4 + 0] = t[0]; bb[bj * 8 + n * 4 + 1] = t[1]; bb[bj * 8 + n * 4 + 2] = t[2]; bb[bj * 8 + n * 4 + 3] = t[3]; }
        }
#pragma unroll
        for (int ai = 0; ai < 2; ++ai)
#pragma unroll
            for (int m = 0; m < 4; ++m) {
                const int row = u.pm * BM + ai * HALF + wr * 64 + m * 16 + fr;
                const float rs = rstd_lds(lds, ai * HALF + wr * 64 + m * 16 + fr);
                float v[16];
#pragma unroll
                for (int bj = 0; bj < 2; ++bj)
#pragma unroll
                    for (int n = 0; n < 2; ++n)
#pragma unroll
                        for (int j = 0; j < 4; ++j) v[bj * 8 + n * 4 + j] = acc[ai][bj][m][n][j] * rs;
                if (mode <= 1) {
#pragma unroll
                    for (int i = 0; i < 16; ++i) v[i] = gelu_fast(v[i]);
                    if (mode == 1) {
                        float s = 0.f;
#pragma unroll
                        for (int i = 0; i < 16; ++i) s += v[i];
                        s = add_xor16(s); s = add_xor32(s);
                        const float mu = s * (1.0f / 64.0f); float q = 0.f;
#pragma unroll
                        for (int i = 0; i < 16; ++i) { v[i] -= mu; q += v[i] * v[i]; }
                        q = add_xor16(q); q = add_xor32(q);
                        const float r = __builtin_amdgcn_rsqf(q * (1.0f / 64.0f) + 1e-6f);
#pragma unroll
                        for (int i = 0; i < 16; ++i) v[i] = v[i] * r * g[i] + bb[i];
                    }
                } else if (mode <= 3) {
                    float q = 0.f;
#pragma unroll
                    for (int i = 0; i < 16; ++i) q += v[i] * v[i];
                    q = add_xor16(q); q = add_xor32(q);
                    const float r = __builtin_amdgcn_rsqf(q * (1.0f / 64.0f) + 1e-6f) * (mode == 2 ? QSCALE : 1.0f);
#pragma unroll
                    for (int i = 0; i < 16; ++i) v[i] = v[i] * r * g[i];
                    const float* cp = cosT + (size_t)row * 32 + 8 * fq; const float* sp = sinT + (size_t)row * 32 + 8 * fq;
#pragma unroll
                    for (int n = 0; n < 2; ++n) { const f32x4 c4 = *(const f32x4*)(cp + 4 * n), s4 = *(const f32x4*)(sp + 4 * n);
#pragma unroll
                        for (int j = 0; j < 4; ++j) { const float x1 = v[n * 4 + j], x2 = v[8 + n * 4 + j]; v[n * 4 + j] = x1 * c4[j] - x2 * s4[j]; v[8 + n * 4 + j] = x2 * c4[j] + x1 * s4[j]; } }
                }
                bf16_t* rp = dst + zrow(row, ld) + cb + 8 * fq;
                { float t[8];
#pragma unroll
                  for (int i = 0; i < 8; ++i) t[i] = v[i];
                  if (pn == 4) store8_wt(make_rsrc(ws), (unsigned)((const unsigned char*)rp - ws), t); else store8(rp, t);
#pragma unroll
                  for (int i = 0; i < 8; ++i) t[i] = v[8 + i];
                  if (pn == 4) store8_wt(make_rsrc(ws), (unsigned)((const unsigned char*)(rp + 32) - ws), t); else store8(rp + 32, t); }
            }
    }
};
struct EpiFF1 {
    static constexpr bool PERM = false, AFTER_DRAIN = false;
    unsigned char* ws; int par; PG8_LAS unsigned char* lds;
    __device__ __forceinline__ void operator()(const f32x4 (&acc)[2][2][4][2], const Unit& u, int wr, int wc, int fr, int fq) const {
        bf16_t* HID = (bf16_t*)(ws + WS_HID);
#pragma unroll
        for (int ai = 0; ai < 2; ++ai)
#pragma unroll
            for (int m = 0; m < 4; ++m) {
                const int row = u.pm * BM + ai * HALF + wr * 64 + m * 16 + fr;
                const float rs = rstd_lds(lds, ai * HALF + wr * 64 + m * 16 + fr);
                bf16_t* rp = HID + (size_t)row * DFF + u.pn * BM + wc * 64 + 8 * fq;
#pragma unroll
                for (int bj = 0; bj < 2; ++bj) { float t[8];
#pragma unroll
                    for (int n = 0; n < 2; ++n)
#pragma unroll
                        for (int j = 0; j < 4; ++j) { float x = acc[ai][bj][m][n][j] * rs; x = x > 0.f ? x : 0.f; t[n * 4 + j] = x * x; }
                    store8(rp + 32 * bj, t); }
            }
    }
};
struct EpiProj {
    static constexpr bool PERM = false, AFTER_DRAIN = false;
    unsigned char* ws;
    __device__ __forceinline__ void operator()(const f32x4 (&acc)[2][2][4][2], const Unit& u, int wr, int wc, int fr, int fq) const {
        bf16_t* O = (bf16_t*)(ws + WS_PPROJ);
#pragma unroll
        for (int ai = 0; ai < 2; ++ai)
#pragma unroll
            for (int m = 0; m < 4; ++m) {
                const int row = u.pm * BM + ai * HALF + wr * 64 + m * 16 + fr;
                bf16_t* rp = O + (size_t)row * DM + u.pn * BM + wc * 64 + 8 * fq;
#pragma unroll
                for (int bj = 0; bj < 2; ++bj) { float t[8];
#pragma unroll
                    for (int n = 0; n < 2; ++n)
#pragma unroll
                        for (int j = 0; j < 4; ++j) t[n * 4 + j] = acc[ai][bj][m][n][j];
                    store8(rp + 32 * bj, t); }
            }
    }
};
#ifndef EPIRES_NB_GATED
#define EPIRES_NB_GATED 4
#endif
#define EPIRES_NB_GATED_OR(G) ((G) ? EPIRES_NB_GATED : 8)
template <bool GATED> struct EpiRes {
    static constexpr bool PERM = false, AFTER_DRAIN = true;
    const bf16_t* hin; bf16_t* hout; float* fout; unsigned char* ws; int par_out;
    __device__ __forceinline__ void fused(f32x4 (&acc)[2][2][4][2], const Unit& u, int wr, int wc, int fr, int fq, PG8_LAS unsigned char* lds, int wid, int lane) const {
        float* ssq_out = (float*)(ws + (par_out ? TAB_SSQ1 : TAB_SSQ0));
        PG8_LAS float* P = (PG8_LAS float*)(lds + (GATED ? RSTD_LDS_OFF : 0));
        const int cb = u.pn * BM + wc * 64 + 8 * fq, row0 = u.pm * BM + wr * 64 + fr;
        constexpr int NB = EPIRES_NB_GATED_OR(GATED);
        u32x4 hv[NB][2]; float rsum[NB];
        const bf16_t* PP = (const bf16_t*)(ws + WS_PPROJ);
        PG8_LAS unsigned char* pl = lds + wid * 16384;
        if (GATED) {
#pragma unroll
            for (int k = 0; k < 16; ++k) { const int row = row0 + (k >> 3) * HALF + ((k >> 1) & 3) * 16;
                __builtin_amdgcn_global_load_lds((const unsigned*)(PP + (size_t)row * DM + cb + 32 * (k & 1)), (PG8_LAS unsigned*)(pl + k * 1024), 16, 0, 0); } }
#pragma unroll
        for (int g8 = 0; g8 < 8; ++g8) {
            if (g8 % NB == 0) {
#pragma unroll
                for (int k = 0; k < NB; ++k) { const int row = row0 + ((g8 + k) >> 2) * HALF + ((g8 + k) & 3) * 16;
#pragma unroll
                    for (int bj = 0; bj < 2; ++bj) hv[k][bj] = *(const u32x4*)(hin + (size_t)row * DM + cb + 32 * bj);
                    if (GATED) { const float* sq = (const float*)(ws + (par_out ? TAB_SSQ0 : TAB_SSQ1)); rsum[k] = (sq[row] + sq[NTOK + row]) + (sq[2 * NTOK + row] + sq[3 * NTOK + row]); } }
                if (GATED && g8 == 0) asm volatile("s_waitcnt vmcnt(0)" ::: "memory");
            }
            const int ai = g8 >> 2, m = g8 & 3, rl = ai * HALF + wr * 64 + m * 16 + fr, row = u.pm * BM + rl;
            float rs = 1.f; if (GATED) rs = __builtin_amdgcn_rsqf(rsum[g8 % NB] * (1.0f / 1024.0f) + 1e-6f);
            float ss = 0.f;
#pragma unroll
            for (int bj = 0; bj < 2; ++bj) {
                const u32x4 hw = hv[g8 % NB][bj];
                f32x4 o0 = (f32x4){bf_lo(hw.x), bf_hi(hw.x), bf_lo(hw.y), bf_hi(hw.y)}, o1 = (f32x4){bf_lo(hw.z), bf_hi(hw.z), bf_lo(hw.w), bf_hi(hw.w)};
                f32x4 a0 = acc[ai][bj][m][0], a1 = acc[ai][bj][m][1];
                if (GATED) { const u32x4 pw = *(const PG8_LAS u32x4*)(pl + (2 * g8 + bj) * 1024 + lane * 16);
                    a0[0] = sigmoid_fast(a0[0] * rs) * bf_lo(pw.x); a0[1] = sigmoid_fast(a0[1] * rs) * bf_hi(pw.x);
                    a0[2] = sigmoid_fast(a0[2] * rs) * bf_lo(pw.y); a0[3] = sigmoid_fast(a0[3] * rs) * bf_hi(pw.y);
                    a1[0] = sigmoid_fast(a1[0] * rs) * bf_lo(pw.z); a1[1] = sigmoid_fast(a1[1] * rs) * bf_hi(pw.z);
                    a1[2] = sigmoid_fast(a1[2] * rs) * bf_lo(pw.w); a1[3] = sigmoid_fast(a1[3] * rs) * bf_hi(pw.w); }
                o0 += a0; o1 += a1;
                ss += (o0[0] * o0[0] + o0[1] * o0[1]) + (o0[2] * o0[2] + o0[3] * o0[3]) + (o1[0] * o1[0] + o1[1] * o1[1]) + (o1[2] * o1[2] + o1[3] * o1[3]);
                if (fout) { float* fp = fout + (size_t)row * DM + cb + 32 * bj; *(f32x4*)fp = o0; *(f32x4*)(fp + 4) = o1; }
                else { float t[8] = {o0[0], o0[1], o0[2], o0[3], o1[0], o1[1], o1[2], o1[3]}; store8(hout + (size_t)row * DM + cb + 32 * bj, t); }
            }
            ss = add_xor16(ss); ss = add_xor32(ss);
            if (fq == 0) P[rl * 4 + wc] = ss;
        }
        asm volatile("s_waitcnt lgkmcnt(0)" ::: "memory"); __builtin_amdgcn_s_barrier(); asm volatile("" ::: "memory");
        const int tid = wid * 64 + lane;
        if (tid < 256) ssq_out[u.pn * NTOK + u.pm * BM + tid] = (P[tid * 4] + P[tid * 4 + 1]) + (P[tid * 4 + 2] + P[tid * 4 + 3]);
        asm volatile("s_waitcnt lgkmcnt(0)" ::: "memory"); __builtin_amdgcn_s_barrier(); asm volatile("" ::: "memory");
    }
};
struct EpiNull {
    static constexpr bool PERM = false, AFTER_DRAIN = true;
    __device__ __forceinline__ void fused(f32x4 (&acc)[2][2][4][2], const Unit& u, int wr, int wc, int fr, int fq, PG8_LAS unsigned char* lds, int wid, int lane) const {
#pragma unroll
        for (int a = 0; a < 2; ++a)
#pragma unroll
            for (int b = 0; b < 2; ++b)
#pragma unroll
                for (int m = 0; m < 4; ++m)
#pragma unroll
                    for (int n = 0; n < 2; ++n) asm volatile("" :: "v"(acc[a][b][m][n]));
    }
};
}
typedef unsigned short bf16;
#define LAS __attribute__((address_space(3)))
typedef unsigned v4u __attribute__((ext_vector_type(4)));
typedef unsigned v2u __attribute__((ext_vector_type(2)));
typedef float f32x4 __attribute__((ext_vector_type(4)));
typedef short bf16x8 __attribute__((ext_vector_type(8)));
typedef short s16x4 __attribute__((ext_vector_type(4)));
constexpr int NWAVES = 8;
__device__ __forceinline__ float max_xor16(float v) { return fmaxf(v, xor_lane<16>(v)); }
__device__ __forceinline__ float max_xor32(float v) { auto r = __builtin_amdgcn_permlane32_swap(__float_as_uint(v), __float_as_uint(v), false, false); return fmaxf(__uint_as_float(r[0]), __uint_as_float(r[1])); }
__device__ __forceinline__ bf16x8 tr_frag(LAS const unsigned char* p, LAS const unsigned char* p2) {
    const s16x4 lo = __builtin_bit_cast(s16x4, __builtin_amdgcn_ds_read_tr16_b64_v4i16((LAS s16x4*)p));
    const s16x4 hi = __builtin_bit_cast(s16x4, __builtin_amdgcn_ds_read_tr16_b64_v4i16((LAS s16x4*)p2));
    return (bf16x8){lo[0], lo[1], lo[2], lo[3], hi[0], hi[1], hi[2], hi[3]};
}
#define WG_BARRIER() do { asm volatile("s_waitcnt vmcnt(0) lgkmcnt(0)" ::: "memory"); __builtin_amdgcn_s_barrier(); asm volatile("" ::: "memory"); } while (0)
#define LDS_BARRIER() do { asm volatile("s_waitcnt lgkmcnt(0)" ::: "memory"); __builtin_amdgcn_s_barrier(); asm volatile("" ::: "memory"); } while (0)

constexpr int GM_ROWB = 528;
constexpr int GM_SS = 128 * GM_ROWB;
__device__ __forceinline__ void gmlp_item(unsigned char* ws, int L, LAS unsigned char* lds, int item, int wv, int lane_unused) {
    const int lane = fresh_lane();
    const int half = item & 1, tok0 = (item >> 1) * 128, tid = wv * 64 + lane;
    const int bb_ = item >> 7;
    const bf16* VLN = (const bf16*)(ws + WS_HID + ZS_VLN); const bf16* U = (const bf16*)(ws + WS_HID + ZS_U); bf16* YC = (bf16*)(ws + WS_HID + ZS_YCAT);
    const bf16* GW = (const bf16*)(ws + TAB_GW) + (size_t)L * 4 * 128 * 128;
    const float* bsv = (const float*)(ws + TAB_SMALL) + L * SM_STRIDE + SM_GBS;
    const int h = wv >> 1, tq = 64 * half + 32 * (wv & 1), fr = lane & 15, g4 = lane >> 4;
    bf16x8 wfa[2][4];
    v2u uwa[2][4];
    { v4u xs[8];
#pragma unroll
      for (int i = 0; i < 8; ++i) if (i < 4 || half) { const int q = tid + i * 512, s = q >> 5, c = q & 31; xs[i] = *(const v4u*)(VLN + zrow(tok0 + s, 256) + c * 8); }
#pragma unroll
      for (int m = 0; m < 2; ++m)
#pragma unroll
          for (int ks = 0; ks < 4; ++ks) if (32 * ks <= tq + 16 * m + 15) wfa[m][ks] = *(const bf16x8*)(GW + ((size_t)h * 128 + tq + 16 * m + fr) * 128 + 32 * ks + 8 * g4);
#pragma unroll
      for (int m = 0; m < 2; ++m)
#pragma unroll
          for (int n = 0; n < 4; ++n) uwa[m][n] = *(const v2u*)(U + zrow(tok0 + tq + 16 * m + fr, 256) + h * 64 + 16 * n + 4 * g4);
      asm volatile("" ::: "memory");
#pragma unroll
      for (int i = 0; i < 8; ++i) if (i < 4 || half) { const int q = tid + i * 512, s = q >> 5, c = q & 31; *(LAS v4u*)(lds + s * GM_ROWB + c * 16) = xs[i]; } }
    WG_BARRIER();
    f32x4 acc[2][4];
#pragma unroll
    for (int m = 0; m < 2; ++m)
#pragma unroll
        for (int n = 0; n < 4; ++n) acc[m][n] = (f32x4){0.f, 0.f, 0.f, 0.f};
#pragma unroll
    for (int m = 0; m < 2; ++m) {
#pragma unroll
        for (int ks = 0; ks < 4; ++ks) {
            if (32 * ks <= tq + 16 * m + 15) {
#pragma unroll
                for (int n = 0; n < 4; ++n) {
                    LAS const unsigned char* p = lds + (32 * ks + 8 * g4 + (fr >> 2)) * GM_ROWB + (h * 64 + 16 * n + 4 * (fr & 3)) * 2;
                    const bf16x8 vf = tr_frag(p, p + 4 * GM_ROWB);
                    acc[m][n] = __builtin_amdgcn_mfma_f32_16x16x32_bf16(vf, wfa[m][ks], acc[m][n], 0, 0, 0);
                }
            }
        }
    }
    LAS float* SS = (LAS float*)(lds + GM_SS);
#pragma unroll
    for (int m = 0; m < 2; ++m) {
        const int t = tq + 16 * m + fr; const float bb = bsv[h * 128 + t]; float ss = 0.f;
#pragma unroll
        for (int n = 0; n < 4; ++n) {
            const v2u uw = uwa[m][n];
            f32x4 y; y[0] = bf_lo(uw.x) * (acc[m][n][0] + bb); y[1] = bf_hi(uw.x) * (acc[m][n][1] + bb); y[2] = bf_lo(uw.y) * (acc[m][n][2] + bb); y[3] = bf_hi(uw.y) * (acc[m][n][3] + bb);
            acc[m][n] = y; ss += (y[0] * y[0] + y[1] * y[1]) + (y[2] * y[2] + y[3] * y[3]);
        }
        ss = add_xor16(ss); ss = add_xor32(ss);
        if (g4 == 0) SS[h * 128 + t] = ss;
    }
    WG_BARRIER();
#pragma unroll
    for (int m = 0; m < 2; ++m) {
        const int t = tq + 16 * m + fr;
        const float tot = (SS[t] + SS[128 + t]) + (SS[256 + t] + SS[384 + t]);
        const float r = __builtin_amdgcn_rsqf(tot * (1.0f / 256.0f) + 1e-6f);
#pragma unroll
        for (int n = 0; n < 4; ++n) { v2u o; o.x = pk2(acc[m][n][0] * r, acc[m][n][1] * r); o.y = pk2(acc[m][n][2] * r, acc[m][n][3] * r);
            *(v2u*)(YC + zrow(tok0 + t, DM) + h * 64 + 16 * n + 4 * g4) = o; }
    }
    WG_BARRIER();
}

constexpr int AT_ROWB = 272;
constexpr int AT_V = 192 * AT_ROWB, AT_SS = 2 * 192 * AT_ROWB;
__device__ __forceinline__ void attn_item(unsigned char* ws, int L, LAS unsigned char* lds, int item, int wv, int lane_unused, unsigned* cnt = nullptr) {
    const int lane = fresh_lane();
    const int b = item >> 7, q0 = (item & 127) * 64, tokb = b * SEQL, tid = wv * 64 + lane;
    const bf16* Q = (const bf16*)(ws + WS_HID + ZS_Q); const bf16* K = (const bf16*)(ws + WS_HID + ZS_K); const bf16* V = (const bf16*)(ws + WS_HID + ZS_V); bf16* YC = (bf16*)(ws + WS_HID + ZS_YCAT);
    const int hq = wv, hkv = wv >> 2, fr = lane & 15, g4 = lane >> 4;
    bf16x8 qfa[4][2];
    { v4u kx[6], vx[6];
#pragma unroll
      for (int i = 0; i < 6; ++i) { const int q = tid + i * 512, r = q >> 4, c = q & 15, j = q0 - 128 + r; kx[i] = (v4u){0u, 0u, 0u, 0u}; vx[i] = kx[i];
          if (j >= 0) { kx[i] = *(const v4u*)(K + zrow(tokb + j, 128) + c * 8); vx[i] = *(const v4u*)(V + zrow(tokb + j, 128) + c * 8); } }
#pragma unroll
      for (int qt = 0; qt < 4; ++qt)
#pragma unroll
          for (int ks = 0; ks < 2; ++ks) qfa[qt][ks] = *(const bf16x8*)(Q + zrow(tokb + q0 + 16 * qt + fr, 512) + hq * 64 + 32 * ks + 8 * g4);
      asm volatile("" ::: "memory");
#pragma unroll
      for (int i = 0; i < 6; ++i) { const int q = tid + i * 512, r = q >> 4, c = q & 15; *(LAS v4u*)(lds + r * AT_ROWB + c * 16) = kx[i]; *(LAS v4u*)(lds + AT_V + r * AT_ROWB + c * 16) = vx[i]; } }
    WG_BARRIER();
    if (cnt && wv == 0 && lane == 0) __hip_atomic_fetch_add(cnt, 1u, __ATOMIC_RELAXED, __HIP_MEMORY_SCOPE_AGENT);
    const float sink2 = ((const float*)(ws + TAB_SMALL))[L * SM_STRIDE + SM_SINK + hq] * LOG2E;
    LAS float* SS = (LAS float*)(lds + AT_SS);
    const bool edge = (q0 < 128);
#pragma unroll
    for (int qt = 0; qt < 4; ++qt) {
        const size_t tq = (size_t)(tokb + q0 + 16 * qt + fr);
        const bf16x8 qf[2] = {qfa[qt][0], qfa[qt][1]};
        f32x4 s[9];
#pragma unroll
        for (int i = 0; i < 9; ++i) { s[i] = (f32x4){0.f, 0.f, 0.f, 0.f};
#pragma unroll
            for (int ks = 0; ks < 2; ++ks) { const bf16x8 kf = *(LAS const bf16x8*)(lds + (16 * (qt + i) + fr) * AT_ROWB + (hkv * 64 + 32 * ks + 8 * g4) * 2);
                s[i] = __builtin_amdgcn_mfma_f32_16x16x32_bf16(kf, qf[ks], s[i], 0, 0, 0); } }
        const int dd = fr - 4 * g4;
#pragma unroll
        for (int r = 0; r < 4; ++r) { s[0][r] = (r > dd) ? s[0][r] : -INFINITY; s[8][r] = (r <= dd) ? s[8][r] : -INFINITY; }
        if (edge) { const int j0 = q0 - 128 + 16 * qt + 4 * g4;
#pragma unroll
            for (int i = 0; i < 9; ++i)
#pragma unroll
                for (int r = 0; r < 4; ++r) s[i][r] = (j0 + 16 * i + r >= 0) ? s[i][r] : -INFINITY; }
        float mx = sink2;
#pragma unroll
        for (int i = 0; i < 9; ++i) mx = fmaxf(fmaxf(mx, fmaxf(s[i][0], s[i][1])), fmaxf(s[i][2], s[i][3]));
        mx = max_xor16(mx); mx = max_xor32(mx);
        float sum = 0.f;
#pragma unroll
        for (int i = 0; i < 9; ++i)
#pragma unroll
            for (int r = 0; r < 4; ++r) { s[i][r] = __builtin_amdgcn_exp2f(s[i][r] - mx); sum += s[i][r]; }
        sum = add_xor16(sum); sum = add_xor32(sum); sum += __builtin_amdgcn_exp2f(sink2 - mx);
        const float inv_l = __builtin_amdgcn_rcpf(sum);
        f32x4 o[4];
#pragma unroll
        for (int dt = 0; dt < 4; ++dt) o[dt] = (f32x4){0.f, 0.f, 0.f, 0.f};
#pragma unroll
        for (int kk = 0; kk < 5; ++kk) {
            const int ia = 2 * kk - (qt & 1), ib = ia + 1;
            v4u pw;
            pw.x = (ia >= 0) ? pk2(s[ia < 0 ? 0 : ia][0], s[ia < 0 ? 0 : ia][1]) : 0u; pw.y = (ia >= 0) ? pk2(s[ia < 0 ? 0 : ia][2], s[ia < 0 ? 0 : ia][3]) : 0u;
            pw.z = (ib <= 8) ? pk2(s[ib > 8 ? 8 : ib][0], s[ib > 8 ? 8 : ib][1]) : 0u; pw.w = (ib <= 8) ? pk2(s[ib > 8 ? 8 : ib][2], s[ib > 8 ? 8 : ib][3]) : 0u;
            const bf16x8 pf = __builtin_bit_cast(bf16x8, pw);
            const int ktb = (qt & ~1) + 2 * kk;
#pragma unroll
            for (int dt = 0; dt < 4; ++dt) {
                LAS const unsigned char* p = lds + AT_V + (16 * ktb + 4 * g4 + (fr >> 2)) * AT_ROWB + (hkv * 64 + 16 * dt + 4 * (fr & 3)) * 2;
                const bf16x8 vf = tr_frag(p, p + 16 * AT_ROWB);
                o[dt] = __builtin_amdgcn_mfma_f32_16x16x32_bf16(vf, pf, o[dt], 0, 0, 0);
            }
        }
        float ss = 0.f;
#pragma unroll
        for (int dt = 0; dt < 4; ++dt) { o[dt] = o[dt] * inv_l; ss += (o[dt][0] * o[dt][0] + o[dt][1] * o[dt][1]) + (o[dt][2] * o[dt][2] + o[dt][3] * o[dt][3]); }
        ss = add_xor16(ss); ss = add_xor32(ss);
        if (g4 == 0) SS[hq * 64 + 16 * qt + fr] = ss;
        LDS_BARRIER();
        float tot = 0.f;
#pragma unroll
        for (int hh = 0; hh < 8; ++hh) tot += SS[hh * 64 + 16 * qt + fr];
        const float r = __builtin_amdgcn_rsqf(tot * (1.0f / 512.0f) + 1e-6f);
#pragma unroll
        for (int dt = 0; dt < 4; ++dt) { v2u ow; ow.x = pk2(o[dt][0] * r, o[dt][1] * r); ow.y = pk2(o[dt][2] * r, o[dt][3] * r);
            *(v2u*)(YC + zrow((int)tq, DM) + 256 + hq * 64 + 16 * dt + 4 * g4) = ow; }
    }
    WG_BARRIER();
}
__device__ __forceinline__ double d_exp(double x) {
    const double k = __builtin_rint(x * 1.4426950408889634), r = x - k * 0.6931471805599453;
    double e = 1.0, term = 1.0;
    for (int n = 1; n <= 20; ++n) { term *= r / (double)n; e += term; }
    const long long bits = (long long)(1023 + (int)k) << 52;
    return e * __builtin_bit_cast(double, bits);
}
__device__ __forceinline__ void d_sincos(double th, double& sn, double& cs) {
    const double q = __builtin_rint(th * 0.15915494309189535), r = th - q * 6.283185307179586, r2 = -r * r;
    double s = r, c = 1.0, ts = r, tc = 1.0;
    for (int n = 1; n <= 14; ++n) { tc *= r2 / (double)((2 * n - 1) * (2 * n)); c += tc; ts *= r2 / (double)((2 * n) * (2 * n + 1)); s += ts; }
    sn = s; cs = c;
}
__device__ __forceinline__ void ssm_tables(const float* const* in, unsigned char* ws, int gtid, int nthreads) {
    for (int i = gtid; i < NLAYER * 16 * 64; i += nthreads) {
        const int p = i & 63, lg = i >> 6;
        const double lre = in[12][i], lim = in[13][i], dt = d_exp((double)in[14][lg]);
        const double er = d_exp(lre * dt); double sn, cs; d_sincos(lim * dt, sn, cs);
        const double lbr = er * cs, lbi = er * sn;
        const double nr = lbr - 1.0, ni = lbi, den = lre * lre + lim * lim;
        const double fr_ = (nr * lre + ni * lim) / den, fi_ = (ni * lre - nr * lim) / den;
        float* bbc = (float*)(ws + SSM_BBC) + (size_t)i * 32; bf16* bbt = (bf16*)(ws + SSM_BBT) + (size_t)lg * 128 * 16;
        for (int h = 0; h < 16; ++h) { const double br = in[15][i * 16 + h], bi = in[16][i * 16 + h]; const float re = (float)(fr_ * br - fi_ * bi), im = (float)(fr_ * bi + fi_ * br);
            bbc[2 * h] = re; bbc[2 * h + 1] = im; bbt[p * 16 + h] = (bf16)(pk2(re, 0.f) & 0xffffu); bbt[(64 + p) * 16 + h] = (bf16)(pk2(im, 0.f) & 0xffffu); }
        bf16* cct = (bf16*)(ws + SSM_CCT) + (size_t)lg * 16 * 128;
        for (int hp = 0; hp < 16; ++hp) { const float cre = in[17][(lg * 16 + hp) * 64 + p], cim = in[18][(lg * 16 + hp) * 64 + p]; *(unsigned*)(cct + hp * 128 + 2 * p) = pk2(cre, -cim); }
        float* pw = (float*)(ws + SSM_PW) + (size_t)lg * 65 * 128;
        double xr = 1.0, xi = 0.0;
        unsigned* pwb = (unsigned*)(ws + SSM_PWB) + (size_t)lg * 32 * 64;
        for (int n = 0; n <= 64; ++n) { pw[(n * 64 + p) * 2] = (float)xr; pw[(n * 64 + p) * 2 + 1] = (float)xi;
            if (n >= 1 && n <= 32) pwb[(n - 1) * 64 + p] = pk2((float)xr, (float)xi);
            const double t = xr * lbr - xi * lbi; xi = xr * lbi + xi * lbr; xr = t; }
    }
}
__device__ __forceinline__ void ssm_ktable(const float* const* in, unsigned char* ws, int gwave, int nwaves) {
    const int lane = fresh_lane(), hp = lane >> 2, h4 = (lane & 3) * 4;
    bf16* KT = (bf16*)(ws + SSM_KT);
    for (int it = gwave; it < NLAYER * 16 * 16; it += nwaves) {
        const int tq = it & 15, lg = it >> 4;
        if (tq >= 8) continue;
        const float* pw = (const float*)(ws + SSM_PW) + ((size_t)lg * 65 + 4 * tq) * 128; const float* bbc = (const float*)(ws + SSM_BBC) + (size_t)lg * 64 * 32 + 2 * h4;
        const float* cre = in[17] + (size_t)(lg * 16 + hp) * 64; const float* cim = in[18] + (size_t)(lg * 16 + hp) * 64;
        float acc[4][4];
#pragma unroll
        for (int t = 0; t < 4; ++t)
#pragma unroll
            for (int j = 0; j < 4; ++j) acc[t][j] = 0.f;
#pragma unroll 2
        for (int p0 = 0; p0 < 64; p0 += 4) {
            const f32x4 cr = *(const f32x4*)(cre + p0), ci = *(const f32x4*)(cim + p0);
            f32x4 zw[4][2], bb[4][2];
#pragma unroll
            for (int t = 0; t < 4; ++t) { zw[t][0] = *(const f32x4*)(pw + t * 128 + 2 * p0); zw[t][1] = *(const f32x4*)(pw + t * 128 + 2 * p0 + 4); }
#pragma unroll
            for (int k = 0; k < 4; ++k) { bb[k][0] = *(const f32x4*)(bbc + (size_t)(p0 + k) * 32); bb[k][1] = *(const f32x4*)(bbc + (size_t)(p0 + k) * 32 + 4); }
#pragma unroll
            for (int t = 0; t < 4; ++t)
#pragma unroll
                for (int k = 0; k < 4; ++k) { const float c_r = cr[k], c_i = ci[k], zr = zw[t][k >> 1][2 * (k & 1)], zi = zw[t][k >> 1][2 * (k & 1) + 1];
                    const float pr = c_r * zr - c_i * zi, pi = c_r * zi + c_i * zr;
                    acc[t][0] += pr * bb[k][0][0] - pi * bb[k][0][1]; acc[t][1] += pr * bb[k][0][2] - pi * bb[k][0][3]; acc[t][2] += pr * bb[k][1][0] - pi * bb[k][1][1]; acc[t][3] += pr * bb[k][1][2] - pi * bb[k][1][3]; }
        }
        if (tq == 0 && hp >= h4 && hp < h4 + 4) { const float dv = in[19][lg * 16 + hp];
#pragma unroll
            for (int j = 0; j < 4; ++j) if (h4 + j == hp) acc[0][j] += dv; }
#pragma unroll
        for (int t = 0; t < 4; ++t) { v2u o; o.x = pk2(acc[t][0], acc[t][1]); o.y = pk2(acc[t][2], acc[t][3]);
            *(v2u*)(KT + ((size_t)lg * 64 + 4 * tq + t) * 256 + hp * 16 + h4) = o; }
    }
}
__device__ __forceinline__ void ssm1_item(unsigned char* ws, int L, int item, int wv, int lane_unused) {
    const int tok0 = item * 64;
    const bf16* ZC = (const bf16*)(ws + WS_HID + ZS_ZC); float* S = (float*)(ws + SSM_S);
    const bf16x8 zero8 = (bf16x8){0, 0, 0, 0, 0, 0, 0, 0};
    const int lane = fresh_lane(), fr = lane & 15, g4 = lane >> 4;
    bf16x8 bfa[2][8], ufa[2][4]; f32x2_t l1a[2][4], l16a[2][4], lg4a[2][4];
#pragma unroll
    for (int gi = 0; gi < 2; ++gi) {
        const int g = 2 * wv + gi, lg = L * 16 + g;
        const bf16* bbt = (const bf16*)(ws + SSM_BBT) + (size_t)lg * 128 * 16; const float* pw = (const float*)(ws + SSM_PW) + (size_t)lg * 65 * 128;
#pragma unroll
        for (int n = 0; n < 8; ++n) bfa[gi][n] = (g4 < 2) ? *(const bf16x8*)(bbt + (16 * n + fr) * 16 + 8 * g4) : zero8;
#pragma unroll
        for (int m = 0; m < 4; ++m) ufa[gi][m] = (g4 < 2) ? *(const bf16x8*)(ZC + zrow(tok0 + 16 * m + fr, 256) + g * 16 + 8 * g4) : zero8;
#pragma unroll
        for (int q = 0; q < 4; ++q) { l1a[gi][q] = *(const f32x2_t*)(pw + (1 * 64 + 16 * q + fr) * 2); l16a[gi][q] = *(const f32x2_t*)(pw + (16 * 64 + 16 * q + fr) * 2); lg4a[gi][q] = *(const f32x2_t*)(pw + ((12 - 4 * g4) * 64 + 16 * q + fr) * 2); }
    }
#pragma unroll
    for (int gi = 0; gi < 2; ++gi) {
        const int g = 2 * wv + gi;
        const bf16x8 (&bfr)[8] = bfa[gi]; const bf16x8 (&uf)[4] = ufa[gi]; const f32x2_t (&l1)[4] = l1a[gi]; const f32x2_t (&l16)[4] = l16a[gi]; const f32x2_t (&lg4)[4] = lg4a[gi];
        float sre[4] = {0.f, 0.f, 0.f, 0.f}, sim[4] = {0.f, 0.f, 0.f, 0.f}, hre[4], him[4];
#pragma unroll
        for (int m = 0; m < 4; ++m) {
            f32x4 d[8];
#pragma unroll
            for (int n = 0; n < 8; ++n) d[n] = __builtin_amdgcn_mfma_f32_16x16x32_bf16(uf[m], bfr[n], (f32x4){0.f, 0.f, 0.f, 0.f}, 0, 0, 0);
#pragma unroll
            for (int q = 0; q < 4; ++q) {
                float ir = d[q][0], ii = d[q + 4][0];
#pragma unroll
                for (int r = 1; r < 4; ++r) { const float t = l1[q][0] * ir - l1[q][1] * ii + d[q][r]; ii = l1[q][0] * ii + l1[q][1] * ir + d[q + 4][r]; ir = t; }
                const float t = l16[q][0] * sre[q] - l16[q][1] * sim[q] + ir; sim[q] = l16[q][0] * sim[q] + l16[q][1] * sre[q] + ii; sre[q] = t;
                if (m == 1) { hre[q] = sre[q]; him[q] = sim[q]; }
            }
        }
#pragma unroll
        for (int q = 0; q < 4; ++q) { const float t = lg4[q][0] * sre[q] - lg4[q][1] * sim[q]; sim[q] = lg4[q][0] * sim[q] + lg4[q][1] * sre[q]; sre[q] = t;
            const float t2 = lg4[q][0] * hre[q] - lg4[q][1] * him[q]; him[q] = lg4[q][0] * him[q] + lg4[q][1] * hre[q]; hre[q] = t2; }
        float* S32 = (float*)(ws + SSM_S32);
#pragma unroll
        for (int q = 0; q < 4; ++q) { sre[q] = add_xor16(sre[q]); sre[q] = add_xor32(sre[q]); sim[q] = add_xor16(sim[q]); sim[q] = add_xor32(sim[q]);
            hre[q] = add_xor16(hre[q]); hre[q] = add_xor32(hre[q]); him[q] = add_xor16(him[q]); him[q] = add_xor32(him[q]);
            if (g4 == 0) {
                __hip_atomic_store((unsigned long long*)(S + ((size_t)(item * 16 + g) * 64 + 16 * q + fr) * 2), ((unsigned long long)__float_as_uint(sim[q]) << 32) | __float_as_uint(sre[q]), __ATOMIC_RELAXED, __HIP_MEMORY_SCOPE_AGENT);
                __hip_atomic_store((unsigned long long*)(S32 + ((size_t)(item * 16 + g) * 64 + 16 * q + fr) * 2), ((unsigned long long)__float_as_uint(him[q]) << 32) | __float_as_uint(hre[q]), __ATOMIC_RELAXED, __HIP_MEMORY_SCOPE_AGENT); } }
    }
}
__device__ __forceinline__ void ssm_scan(unsigned char* ws, int L, LAS unsigned char* lds, int bg, int wv) {
    const int lane = fresh_lane(), b = bg >> 4, g = bg & 15;
    const f32x2_t lam = *(const f32x2_t*)((const float*)(ws + SSM_PW) + ((size_t)(L * 16 + g) * 65 + 64) * 128 + 2 * lane);
    float* sp = (float*)(ws + SSM_S) + (((size_t)(b * 128 + 16 * wv) * 16 + g) * 64 + lane) * 2;
    f32x2_t sv[16];
#pragma unroll
    for (int j = 0; j < 16; ++j) sv[j] = *(const f32x2_t*)(sp + (size_t)j * 2048);
    float pr[16], pi[16]; float xr = 0.f, xi = 0.f, wr = 1.f, wi = 0.f;
#pragma unroll
    for (int j = 0; j < 16; ++j) { pr[j] = xr; pi[j] = xi; const float t = lam[0] * xr - lam[1] * xi + sv[j][0]; xi = lam[0] * xi + lam[1] * xr + sv[j][1]; xr = t;
        const float tw = wr * lam[0] - wi * lam[1]; wi = wr * lam[1] + wi * lam[0]; wr = tw; }
    LAS f32x2_t* E = (LAS f32x2_t*)lds;
    E[wv * 64 + lane] = (f32x2_t){xr, xi};
    WG_BARRIER();
    float br = 0.f, bi = 0.f;
    for (int w2 = 0; w2 < wv; ++w2) { const f32x2_t e = E[w2 * 64 + lane]; const float t = wr * br - wi * bi + e[0]; bi = wr * bi + wi * br + e[1]; br = t; }
    float qr = 1.f, qi = 0.f;
#pragma unroll
    for (int j = 0; j < 16; ++j) { const float xr_ = qr * br - qi * bi + pr[j], xi_ = qr * bi + qi * br + pi[j];
        __hip_atomic_store((unsigned long long*)(sp + (size_t)j * 2048), ((unsigned long long)__float_as_uint(xi_) << 32) | __float_as_uint(xr_), __ATOMIC_RELAXED, __HIP_MEMORY_SCOPE_AGENT);
        const float tq = qr * lam[0] - qi * lam[1]; qi = qr * lam[1] + qi * lam[0]; qr = tq; }
    WG_BARRIER();
}
constexpr int S2_ROWB = 528, S2_XIN = 96 * S2_ROWB, S2_XMID = S2_XIN + 8192, S2_YT = S2_XMID + 8192, S2_SS = S2_YT + 64 * S2_ROWB;
#if defined(PROBE_T0)
#define S2_STAMP(id) do { if (stamp_on && wv == 0) { \
    if ((id) == PROBE_T0) { const unsigned long long t_ = __builtin_amdgcn_s_memrealtime(); MISCp[8] = (unsigned)t_; MISCp[9] = (unsigned)(t_ >> 32); } \
    if ((id) == PROBE_T1) { const unsigned long long t_ = __builtin_amdgcn_s_memrealtime(), t0_ = ((unsigned long long)MISCp[9] << 32) | MISCp[8]; MISCp[10] = (unsigned)(t_ - t0_); } } } while (0)
#else
#define S2_STAMP(id) do {} while (0)
#endif
__device__ __forceinline__ void ssm2_item(unsigned char* ws, int L, LAS unsigned char* lds, int item, int wv, int lane_unused, volatile LAS unsigned* MISCp = nullptr, bool stamp_on = false) {
    const int lane = fresh_lane();
    const int tok0 = item * 64, tid = wv * 64 + lane;
    const bf16* ZC = (const bf16*)(ws + WS_HID + ZS_ZC); const float* S = (const float*)(ws + SSM_S); const float* S32 = (const float*)(ws + SSM_S32);
    const int fr = lane & 15, g4 = lane >> 4;
    bf16x8 kfa[2][16], cfa[2][4]; v4u pwa[2][2][4]; bf16x8 gwa[2][4][2], gwb[2][4][2];
#define S2_LOAD_K(gi) do { const bf16* kt = (const bf16*)(ws + SSM_KT) + (size_t)(L * 16 + 2 * wv + (gi)) * 64 * 256 + fr * 16 + 8 * (g4 & 1); \
        _Pragma("unroll") for (int lp = 0; lp < 16; ++lp) kfa[gi][lp] = *(const bf16x8*)(kt + (2 * lp + (g4 >> 1)) * 256); } while (0)
#define S2_LOAD_C(gi) do { const int lg_ = L * 16 + 2 * wv + (gi); const bf16* cct = (const bf16*)(ws + SSM_CCT) + (size_t)lg_ * 16 * 128 + fr * 128 + 8 * g4; \
        _Pragma("unroll") for (int ks = 0; ks < 4; ++ks) cfa[gi][ks] = *(const bf16x8*)(cct + 32 * ks); \
        const unsigned* pwg = (const unsigned*)(ws + SSM_PWB) + (size_t)lg_ * 32 * 64; \
        _Pragma("unroll") for (int mh = 0; mh < 2; ++mh) _Pragma("unroll") for (int ks = 0; ks < 4; ++ks) pwa[gi][mh][ks] = *(const v4u*)(pwg + (size_t)(16 * mh + fr) * 64 + 16 * ks + 4 * g4); } while (0)
#define S2_LOAD_G(kh) do { const bf16* wg_ = (const bf16*)(ws + WS_W + (size_t)L * LW_STRIDE + LW_GLU) + (size_t)(32 * wv + fr) * 256 + 8 * g4; \
        _Pragma("unroll") for (int k4 = 0; k4 < 4; ++k4) _Pragma("unroll") for (int nt = 0; nt < 2; ++nt) { gwa[kh][k4][nt] = *(const bf16x8*)(wg_ + (size_t)(16 * nt) * 256 + 32 * (4 * (kh) + k4)); \
            gwb[kh][k4][nt] = *(const bf16x8*)(wg_ + (size_t)(256 + 16 * nt) * 256 + 32 * (4 * (kh) + k4)); } } while (0)
    { v4u xs[6];
#pragma unroll
      for (int i = 0; i < 6; ++i) { const int q = tid + i * 512, r = q >> 5, cc = q & 31; xs[i] = (v4u){0u, 0u, 0u, 0u};
          if (r >= 16 && r < 48) xs[i] = *(const v4u*)(ZC + zrow(tok0 + r - 16, 256) + cc * 8); else if (r >= 64) xs[i] = *(const v4u*)(ZC + zrow(tok0 + r - 32, 256) + cc * 8); }
      f32x2_t xin[2], s32v[2], l32[2];
#pragma unroll
      for (int k = 0; k < 2; ++k) { const int ch = tid + 512 * k; xin[k] = *(const f32x2_t*)(S + ((size_t)item * 1024 + ch) * 2); s32v[k] = *(const f32x2_t*)(S32 + ((size_t)item * 1024 + ch) * 2);
          l32[k] = *(const f32x2_t*)((const float*)(ws + SSM_PW) + ((size_t)(L * 16 + (ch >> 6)) * 65 + 32) * 128 + 2 * (ch & 63)); }
      S2_LOAD_K(0); S2_LOAD_C(0);
#pragma unroll
      for (int i = 0; i < 6; ++i) { const int q = tid + i * 512, r = q >> 5, cc = q & 31; *(LAS v4u*)(lds + r * S2_ROWB + cc * 16) = xs[i]; }
#pragma unroll
      for (int k = 0; k < 2; ++k) { const int ch = tid + 512 * k; *(LAS f32x2_t*)(lds + S2_XIN + ch * 8) = xin[k];
          *(LAS f32x2_t*)(lds + S2_XMID + ch * 8) = (f32x2_t){l32[k][0] * xin[k][0] - l32[k][1] * xin[k][1] + s32v[k][0], l32[k][0] * xin[k][1] + l32[k][1] * xin[k][0] + s32v[k][1]}; } }
    S2_STAMP(121);
    S2_LOAD_K(1);
    asm volatile("s_waitcnt lgkmcnt(0)" ::: "memory"); __builtin_amdgcn_s_barrier(); asm volatile("" ::: "memory");
    S2_STAMP(122);
#pragma unroll
    for (int gi = 0; gi < 2; ++gi) {
        const int g = 2 * wv + gi;
        f32x4 acc[4];
#pragma unroll
        for (int m = 0; m < 4; ++m) acc[m] = (f32x4){0.f, 0.f, 0.f, 0.f};
#pragma unroll
        for (int m = 0; m < 4; ++m) {
            LAS const unsigned char* ub = lds + (16 + 16 * m + ((m >> 1) << 4) + fr - (g4 >> 1)) * S2_ROWB + (g * 16 + 8 * (g4 & 1)) * 2;
#pragma unroll
            for (int lp = 0; lp < 8 * (m & 1) + 8; ++lp) { const bf16x8 uf = *(LAS const bf16x8*)(ub - 2 * lp * S2_ROWB); acc[m] = __builtin_amdgcn_mfma_f32_16x16x32_bf16(uf, kfa[gi][lp], acc[m], 0, 0, 0); }
        }
        if (gi == 0) { S2_LOAD_C(1); S2_LOAD_G(0); } else { S2_LOAD_G(1); }
        if (gi == 0) S2_STAMP(123); else S2_STAMP(125);
#pragma unroll
        for (int ks = 0; ks < 4; ++ks) {
            const int p4 = 16 * ks + 4 * g4;
#pragma unroll
            for (int m = 0; m < 4; ++m) {
                const int xo = ((m >> 1) ? S2_XMID : S2_XIN) + (g * 64 + p4) * 8;
                const f32x4 x01 = *(LAS const f32x4*)(lds + xo), x23 = *(LAS const f32x4*)(lds + xo + 16);
                const v4u wq = pwa[gi][m & 1][ks];
                const f32x4 w01 = (f32x4){bf_lo(wq.x), bf_hi(wq.x), bf_lo(wq.y), bf_hi(wq.y)}, w23 = (f32x4){bf_lo(wq.z), bf_hi(wq.z), bf_lo(wq.w), bf_hi(wq.w)};
                v4u zw; zw.x = pk2(w01[0] * x01[0] - w01[1] * x01[1], w01[0] * x01[1] + w01[1] * x01[0]); zw.y = pk2(w01[2] * x01[2] - w01[3] * x01[3], w01[2] * x01[3] + w01[3] * x01[2]);
                zw.z = pk2(w23[0] * x23[0] - w23[1] * x23[1], w23[0] * x23[1] + w23[1] * x23[0]); zw.w = pk2(w23[2] * x23[2] - w23[3] * x23[3], w23[2] * x23[3] + w23[3] * x23[2]);
                acc[m] = __builtin_amdgcn_mfma_f32_16x16x32_bf16(__builtin_bit_cast(bf16x8, zw), cfa[gi][ks], acc[m], 0, 0, 0);
            }
        }
#pragma unroll
        for (int m = 0; m < 4; ++m)
#pragma unroll
            for (int r = 0; r < 4; ++r) *(LAS bf16*)(lds + S2_YT + (16 * m + 4 * g4 + r) * S2_ROWB + (g * 16 + fr) * 2) = (bf16)(pk2(gelu_fast(acc[m][r]), 0.f) & 0xffffu);
    }
    S2_STAMP(126);
#undef S2_LOAD_K
#undef S2_LOAD_C
#undef S2_LOAD_G
    LDS_BARRIER();
    S2_STAMP(127);
    {
        LAS const unsigned char* yb = lds + S2_YT + fr * S2_ROWB + 16 * g4;
        f32x4 ga[2][4], gb[2][4];
#pragma unroll
        for (int nt = 0; nt < 2; ++nt)
#pragma unroll
            for (int m = 0; m < 4; ++m) { ga[nt][m] = (f32x4){0.f, 0.f, 0.f, 0.f}; gb[nt][m] = (f32x4){0.f, 0.f, 0.f, 0.f}; }
#pragma unroll
        for (int kh = 0; kh < 2; ++kh) {
#pragma unroll
            for (int k4 = 0; k4 < 4; ++k4) {
                bf16x8 yf[4];
#pragma unroll
                for (int m = 0; m < 4; ++m) yf[m] = *(LAS const bf16x8*)(yb + 16 * m * S2_ROWB + 64 * (4 * kh + k4));
#pragma unroll
                for (int nt = 0; nt < 2; ++nt)
#pragma unroll
                    for (int m = 0; m < 4; ++m) { ga[nt][m] = __builtin_amdgcn_mfma_f32_16x16x32_bf16(gwa[kh][k4][nt], yf[m], ga[nt][m], 0, 0, 0); gb[nt][m] = __builtin_amdgcn_mfma_f32_16x16x32_bf16(gwb[kh][k4][nt], yf[m], gb[nt][m], 0, 0, 0); }
            }
        }
        S2_STAMP(128);
        LAS float* SS = (LAS float*)(lds + S2_SS);
#pragma unroll
        for (int m = 0; m < 4; ++m) { float ss = 0.f;
#pragma unroll
            for (int nt = 0; nt < 2; ++nt)
#pragma unroll
                for (int r = 0; r < 4; ++r) { const float v = ga[nt][m][r] * sigmoid_fast(gb[nt][m][r]); ga[nt][m][r] = v; ss += v * v; }
            ss = add_xor16(ss); ss = add_xor32(ss);
            if (g4 == 0) SS[wv * 64 + 16 * m + fr] = ss; }
        WG_BARRIER();
        bf16* YC = (bf16*)(ws + WS_HID + ZS_YCAT);
#pragma unroll
        for (int m = 0; m < 4; ++m) { float tot = 0.f;
#pragma unroll
            for (int w8 = 0; w8 < 8; ++w8) tot += SS[w8 * 64 + 16 * m + fr];
            const float rr = __builtin_amdgcn_rsqf(tot * (1.0f / 256.0f) + 1e-6f);
#pragma unroll
            for (int nt = 0; nt < 2; ++nt) { v2u o; o.x = pk2(ga[nt][m][0] * rr, ga[nt][m][1] * rr); o.y = pk2(ga[nt][m][2] * rr, ga[nt][m][3] * rr);
                *(v2u*)(YC + zrow(tok0 + 16 * m + fr, DM) + 768 + 32 * wv + 16 * nt + 4 * g4) = o; } }
    }
    WG_BARRIER();
}
#define XB_TMO      128
#define XB_XCNT(j)  (256  + 64 * (j))
#define XB_XSUB(j)  (1280 + 64 * (j))
#define XB_XGEN(j)  (2304 + 64 * (j))
#define XB_TOP      3328
#define XB_TOPGEN   3392
#define XCD_BAR_WORDS 3456
#define XB_SPIN_CAP (1u << 18)

__device__ __forceinline__ unsigned xb_ld(unsigned* p)              { return __hip_atomic_load(p, __ATOMIC_RELAXED, __HIP_MEMORY_SCOPE_AGENT); }
__device__ __forceinline__ unsigned xb_add(unsigned* p, unsigned v) { return __hip_atomic_fetch_add(p, v, __ATOMIC_RELAXED, __HIP_MEMORY_SCOPE_AGENT); }
__device__ __forceinline__ unsigned xb_xcc_id() { return (unsigned)__builtin_amdgcn_s_getreg((3 << 11) | 20) & 0xFu; }
#define XB_SPIN(cond, bar) do { unsigned _sp = 0; while (cond) { __builtin_amdgcn_s_sleep(1); \
    if ((++_sp & 255u) == 0u) { if (xb_ld(&(bar)[XB_TMO])) break; if (_sp > XB_SPIN_CAP) { atomicAdd(&(bar)[XB_TMO], 1u); break; } } } } while (0)

struct XcdBarrier {
    unsigned* bar; unsigned x; unsigned G;
    volatile LAS unsigned* st;
};

__device__ __forceinline__ XcdBarrier xcd_barrier_post(unsigned* bar, volatile LAS unsigned* st, bool leader, unsigned G) {
    XcdBarrier b; b.bar = bar; b.x = xb_xcc_id(); b.st = st; b.G = G;
    if (leader) (void)xb_add(&bar[XB_XCNT(b.x)], 1u);
    return b;
}
__device__ __forceinline__ void xcd_barrier_complete(unsigned* bar, unsigned x, unsigned& nloc, unsigned& nx, unsigned G) {
    unsigned sum, cnt, mine, sp = 0u;
    for (;;) {
        sum = 0u; cnt = 0u; mine = 0u;
#pragma unroll
        for (unsigned j = 0; j < 16; ++j) { const unsigned c = xb_ld(&bar[XB_XCNT(j)]); sum += c; cnt += (c > 0u) ? 1u : 0u; mine = (j == x) ? c : mine; }
        if (sum == G) break;
        __builtin_amdgcn_s_sleep(1);
        if ((++sp & 255u) == 0u) { if (xb_ld(&bar[XB_TMO])) break; if (sp > XB_SPIN_CAP) { atomicAdd(&bar[XB_TMO], 1u); break; } }
    }
    nloc = mine > 0u ? mine : 1u; nx = cnt > 0u ? cnt : 1u;
}

__device__ __forceinline__ void xcd_barrier(const XcdBarrier& b, bool leader) {
    asm volatile("s_waitcnt vmcnt(0)" ::: "memory");
    __syncthreads();
    if (leader) {
        unsigned* bar = b.bar;
        __builtin_amdgcn_s_waitcnt(0);
        unsigned nloc = b.st[0], nx = b.st[1];
        if (nloc == 0u) { xcd_barrier_complete(bar, b.x, nloc, nx, b.G); b.st[0] = nloc; b.st[1] = nx; }
        const unsigned old = xb_add(&bar[XB_XSUB(b.x)], 1u);
        const unsigned gen = old / nloc;
        if (old + 1u == (gen + 1u) * nloc) {
            __builtin_amdgcn_fence(__ATOMIC_RELEASE, "agent");
            asm volatile("s_waitcnt vmcnt(0)" ::: "memory");
            const unsigned og = xb_add(&bar[XB_TOP], 1u);
            const unsigned tg = og / nx;
            if (og + 1u == (tg + 1u) * nx) xb_add(&bar[XB_TOPGEN], 1u);
            else XB_SPIN(xb_ld(&bar[XB_TOPGEN]) == tg, bar);
            __builtin_amdgcn_fence(__ATOMIC_ACQUIRE, "agent");
            xb_add(&bar[XB_XGEN(b.x)], 1u);
            asm volatile("s_waitcnt vmcnt(0)" ::: "memory");
        } else {
            XB_SPIN(xb_ld(&bar[XB_XGEN(b.x)]) == gen, bar);
            __builtin_amdgcn_fence(__ATOMIC_ACQUIRE, "agent");
            asm volatile("s_waitcnt vmcnt(0)" ::: "memory");
        }
    }
    __syncthreads();
}

#define XL_SUB(j) (4096 + 64 * (j))
#define XL_GEN(j) (4608 + 64 * (j))
#define XL_RANK(j) (3520 + (j))
#define XL_FLAG 3536
#define XL_KTDONE 3552
__device__ __forceinline__ void xcd_local_barrier(unsigned* ctl, unsigned x, unsigned n, bool leader) {
    asm volatile("s_waitcnt vmcnt(0)" ::: "memory");
    __syncthreads();
    if (leader) {
        __builtin_amdgcn_s_waitcnt(0);
        const unsigned old = xb_add(&ctl[XL_SUB(x)], 1u), gen = old / n;
        if (old + 1u == (gen + 1u) * n) xb_add(&ctl[XL_GEN(x)], 1u);
        else XB_SPIN(xb_ld(&ctl[XL_GEN(x)]) == gen, ctl);
        __builtin_amdgcn_fence(__ATOMIC_ACQUIRE, "agent");
        asm volatile("s_waitcnt vmcnt(0)" ::: "memory");
    }
    __syncthreads();
}
constexpr int LDS_BYTES = 147456;

struct PrepItem { const float* W; const float* g; bf16* WT; int K, N, r; bool perm; };
__device__ __forceinline__ void prep_load(const PrepItem& p, float (&w)[64], int lane) {
    const int nblk = p.N / 64, kb = p.r / nblk, nb = p.r % nblk, k0 = 64 * kb, l0 = 64 * nb;
    const float* wp = p.W + (size_t)k0 * p.N + l0 + lane;
#pragma unroll
    for (int i = 0; i < 64; ++i) w[i] = __builtin_nontemporal_load(wp + (size_t)i * p.N);
}
__device__ __forceinline__ void prep_finish(const PrepItem& p, float (&w)[64], LAS float* scr, int lane) {
    const int nblk = p.N / 64, kb = p.r / nblk, nb = p.r % nblk, k0 = 64 * kb, l0 = 64 * nb;
    if (p.g) {
#pragma unroll
        for (int i = 0; i < 64; ++i) w[i] *= p.g[k0 + i];
    }
#pragma unroll
    for (int i = 0; i < 64; ++i) scr[i * 65 + lane] = w[i];
    asm volatile("s_waitcnt lgkmcnt(0)" ::: "memory");
    const int c = lane & 7;
#pragma unroll
    for (int j = 0; j < 8; ++j) { const int ll = (lane >> 3) + 8 * j;
        int prow;
        if (p.perm) { const int bj = ll >> 5, y = ll & 31, x = 16 * ((y >> 2) & 1) + 4 * (y >> 3) + (y & 3), wc = (l0 >> 6) & 3; prow = (l0 & ~255) + 128 * bj + 32 * wc + x; }
        else prow = l0 + ll;
        const LAS float* s = scr + (8 * c) * 65 + ll;
        v4u o; o.x = pk2(s[0 * 65], s[1 * 65]); o.y = pk2(s[2 * 65], s[3 * 65]); o.z = pk2(s[4 * 65], s[5 * 65]); o.w = pk2(s[6 * 65], s[7 * 65]);
        *(v4u*)(p.WT + (size_t)prow * p.K + k0 + 8 * c) = o; }
    asm volatile("s_waitcnt lgkmcnt(0)" ::: "memory");
}
__device__ __forceinline__ PrepItem prep_decode(const float* const* in, unsigned char* ws, int it) {
    constexpr int I_IN = 16 * 24, I_OUT = 16 * 16, I_FF1 = 16 * 64, I_FF2 = 64 * 16, I_GATE = 16 * 16, I_PROJ = 4 * 16, I_GLU = 4 * 4, I_L = I_IN + I_OUT + I_FF1 + I_FF2 + I_GATE + I_PROJ + 2 * I_GLU;
    const int L = it / I_L; int r = it % I_L; unsigned char* wl = ws + WS_W + (size_t)L * LW_STRIDE;
    PrepItem p; p.perm = true;
    if (r < I_IN) { p.W = in[4] + (size_t)L * DM * NIN; p.K = DM; p.N = NIN; p.g = in[3] + L * DM; p.WT = (bf16*)(wl + LW_IN); }
    else if ((r -= I_IN) < I_OUT) { p.W = in[23] + (size_t)L * DM * DM; p.K = DM; p.N = DM; p.g = in[22] + L * DM; p.WT = (bf16*)(wl + LW_OUT); }
    else if ((r -= I_OUT) < I_FF1) { p.W = in[25] + (size_t)L * DM * DFF; p.K = DM; p.N = DFF; p.g = in[24] + L * DM; p.WT = (bf16*)(wl + LW_FF1); }
    else if ((r -= I_FF1) < I_FF2) { p.W = in[26] + (size_t)L * DFF * DM; p.K = DFF; p.N = DM; p.g = nullptr; p.WT = (bf16*)(wl + LW_FF2); }
    else if ((r -= I_FF2) < I_GATE) { p.W = in[28] + (size_t)L * DM * DM; p.K = DM; p.N = DM; p.g = in[27] + L * DM; p.WT = (bf16*)(wl + LW_GATE); }
    else if ((r -= I_GATE) < I_PROJ) { p.W = in[29] + (size_t)L * 256 * DM; p.K = 256; p.N = DM; p.g = nullptr; p.WT = (bf16*)(wl + LW_PROJ); }
    else if ((r -= I_PROJ) < I_GLU) { p.W = in[20] + (size_t)L * 65536; p.K = 256; p.N = 256; p.g = nullptr; p.WT = (bf16*)(wl + LW_GLU); p.perm = false; }
    else { r -= I_GLU; p.W = in[21] + (size_t)L * 65536; p.K = 256; p.N = 256; p.g = nullptr; p.WT = (bf16*)(wl + LW_GLU) + 65536; p.perm = false; }
    p.r = r; return p;
}
__device__ __forceinline__ void convert_weights(const float* const* in, unsigned char* ws, LAS float* scr, int gw, int NGW, int lane) {
    constexpr int I_L = 16 * 24 + 16 * 16 + 16 * 64 + 64 * 16 + 16 * 16 + 4 * 16 + 2 * 4 * 4;
    const int end = NLAYER * I_L; int it = gw;
    if (it >= end) return;
    float wa[64], wb[64];
    PrepItem pa = prep_decode(in, ws, it), pb = pa;
    prep_load(pa, wa, lane);
    for (;;) {
        const bool nb = it + NGW < end;
        if (nb) { pb = prep_decode(in, ws, it + NGW); prep_load(pb, wb, lane); }
        prep_finish(pa, wa, scr, lane);
        if (!nb) break;
        it += NGW;
        const bool na = it + NGW < end;
        if (na) { pa = prep_decode(in, ws, it + NGW); prep_load(pa, wa, lane); }
        prep_finish(pb, wb, scr, lane);
        if (!na) break;
        it += NGW;
    }
}
__device__ __forceinline__ void convert_p(const float* pl, unsigned char* ws, int gw, int NGW, int row0 = 0, int nrows = NTOK) {
    const int lane = fresh_lane(); bf16* pb = (bf16*)(ws + WS_PB);
    int m = row0 + gw; const int mend = row0 + nrows;
    for (; m + 7 * NGW < mend; m += 8 * NGW) { f32x4 v[8];
#pragma unroll
        for (int u = 0; u < 8; ++u) v[u] = __builtin_nontemporal_load((const f32x4*)(pl + (size_t)(m + u * NGW) * 256) + lane);
#pragma unroll
        for (int u = 0; u < 8; ++u) ((unsigned long long*)(pb + (size_t)(m + u * NGW) * 256))[lane] = (unsigned long long)pk2(v[u][0], v[u][1]) | ((unsigned long long)pk2(v[u][2], v[u][3]) << 32); }
    for (; m < mend; m += NGW) { const f32x4 v = __builtin_nontemporal_load((const f32x4*)(pl + (size_t)m * 256) + lane);
        ((unsigned long long*)(pb + (size_t)m * 256))[lane] = (unsigned long long)pk2(v[0], v[1]) | ((unsigned long long)pk2(v[2], v[3]) << 32); }
}
struct Args { const float* in[30]; float* out; unsigned char* ws; int s_lo, s_hi; };

__device__ __forceinline__ void prologue_phase(const Args& a, unsigned char* ws, float* outp, LAS unsigned char* lds, int gw, int NGW, int wave, int lane) {
    LAS float* scr = (LAS float*)(lds + wave * 16640);
    if (gw >= 64) convert_weights(a.in, ws, scr, gw - 64, NGW - 64, lane);
    {
        const float* x = a.in[0]; float* ssq = (float*)(ws + TAB_SSQ0);
        for (int m = gw; m < NTOK; m += 4 * NGW) {
            f32x4 v[4][4];
#pragma unroll
            for (int u = 0; u < 4; ++u)
#pragma unroll
                for (int j = 0; j < 4; ++j) v[u][j] = __builtin_nontemporal_load((const f32x4*)(x + (size_t)(m + u * NGW) * DM) + lane + 64 * j);
#pragma unroll
            for (int u = 0; u < 4; ++u) { const int mm = m + u * NGW; bf16* hb = (bf16*)((unsigned char*)outp + out_hbb(mm >> 13)); unsigned long long* o8 = (unsigned long long*)(hb + (size_t)mm * DM) + lane; float s = 0.f;
#pragma unroll
                for (int j = 0; j < 4; ++j) { const f32x4 t = v[u][j]; s += (t[0] * t[0] + t[1] * t[1]) + (t[2] * t[2] + t[3] * t[3]);
                    o8[64 * j] = (unsigned long long)pk2(t[0], t[1]) | ((unsigned long long)pk2(t[2], t[3]) << 32); }
                s = wave_sum(s);
                if (lane < 4) ssq[lane * NTOK + mm] = (lane == 0) ? s : 0.f; }
        }
    }
    {
        const int* pos = (const int*)a.in[2]; float* cosT = (float*)(ws + TAB_COS); float* sinT = (float*)(ws + TAB_SIN);
        for (int i0 = gw * 64 + lane; i0 < NTOK * 32; i0 += 4 * NGW * 64) { int ps[4];
#pragma unroll
            for (int u = 0; u < 4; ++u) ps[u] = pos[(i0 + u * NGW * 64) >> 5];
#pragma unroll
            for (int u = 0; u < 4; ++u) { const int i = i0 + u * NGW * 64, k = i & 31;
                const double rev = (double)ps[u] * ROPE_INV_REV[k]; const float r = (float)(rev - __builtin_rint(rev));
                cosT[i] = __builtin_amdgcn_cosf(r); sinT[i] = __builtin_amdgcn_sinf(r); } }
    }
    {
        bf16* gwt = (bf16*)(ws + TAB_GW);
        for (int i = gw * 64 + lane; i < NLAYER * 4 * 128 * 128; i += NGW * 64) { const int s_ = i & 127, t_ = (i >> 7) & 127; gwt[i] = (bf16)(pk2(s_ <= t_ ? a.in[7][i] : 0.f, 0.f) & 0xffffu); }
    }
    ssm_tables(a.in, ws, gw * 64 + lane, NGW * 64);
    convert_p(a.in[1], ws, gw, NGW);
    {
        float* sm = (float*)(ws + TAB_SMALL);
        for (int i = gw * 64 + lane; i < NLAYER * SM_STRIDE; i += NGW * 64) { const int L = i / SM_STRIDE, o = i % SM_STRIDE; float v = 0.f;
            if (o < SM_LNB) v = a.in[5][L * 256 + o]; else if (o < SM_QG) v = a.in[6][L * 256 + o - SM_LNB]; else if (o < SM_KG) v = a.in[9][L * 64 + o - SM_QG];
            else if (o < SM_SINK) v = a.in[10][L * 64 + o - SM_KG]; else if (o < SM_SINK + 8) v = a.in[11][L * 8 + o - SM_SINK];
            else if (o >= SM_GBS && o < SM_GBS + 512) v = a.in[8][L * 512 + o - SM_GBS];
            sm[i] = v; }
    }
}

template <int MODE> struct SOrder {
    int c, s; unsigned* pc = nullptr;
    __device__ __forceinline__ bool next(int i, pg8::Unit& u) const { const int r = c >> 3, pmb = 32 * s + 4 * (c & 7) + (r & 3);
        if (MODE == 0) { if (i > 0) return false; u.pm = pmb; u.pn = r >> 2; return true; }
        if (MODE == 1) { if (i == 0) { u.pm = pmb; u.pn = r >> 2; return true; } if (i == 1 && c < 64) { u.pm = pmb; u.pn = 4 + (r >> 2); return true; } return false; }
        if (MODE == 2) { if (i >= 4) return false; u.pm = pmb; u.pn = 4 * i + (r >> 2); return true; }
        if (c < 64 || i >= 2) return false; const int Lq = 2 * (r - 8) + i; u.pm = 32 * s + 4 * (c & 7) + (Lq >> 2); u.pn = Lq & 3; return true; }
    __device__ __forceinline__ void a_ready(const pg8::Unit&) const {}
    __device__ __forceinline__ void done(const pg8::Unit& u) const { if (MODE == 1 && pc) { if (c < 64 && u.pn < 4) return;
        asm volatile("s_waitcnt vmcnt(0)" ::: "memory");
        if (fresh_lane() == 0) __hip_atomic_fetch_add(pc + 16 * u.pm, (c < 64) ? 2u : 1u, __ATOMIC_RELAXED, __HIP_MEMORY_SCOPE_AGENT); } }
};
#ifndef PROBE_BLK
#define PROBE_BLK 0
#endif
#ifdef PROBE_VIRT
#define PROBE_ME ((sid0 * 128 + lb0) == PROBE_BLK)
#else
#define PROBE_ME (blockIdx.x == PROBE_BLK)
#endif
#if defined(PROBE_T0) && defined(PROBE_SLOT)
#define M_STAMP(id) do { if (PROBE_ME && wave0 == 0 && s == PROBE_SLOT) { \
    if ((id) == PROBE_T0) { const unsigned long long t_ = __builtin_amdgcn_s_memrealtime(); MISC[8] = (unsigned)t_; MISC[9] = (unsigned)(t_ >> 32); } \
    if ((id) == PROBE_T1) { const unsigned long long t_ = __builtin_amdgcn_s_memrealtime(), t0_ = ((unsigned long long)MISC[9] << 32) | MISC[8]; MISC[10] = (unsigned)(t_ - t0_); } } } while (0)
#else
#define M_STAMP(id) do {} while (0)
#endif
enum { ST_IN = 0, ST_MIX, ST_OUT, ST_FF1, ST_FF2, ST_PLE, NSTEP };
#ifndef PG8_SP2
#define PG8_SP2 true
#endif
#ifndef PG8_ALIGN
#define PG8_ALIGN true
#endif
__global__ void __launch_bounds__(NWAVES * 64, 2) mk_fwd(Args args) {
    extern __shared__ __attribute__((aligned(16))) unsigned char lds_raw[];
    LAS unsigned char* lds = (LAS unsigned char*)lds_raw;
    const int wave0 = __builtin_amdgcn_readfirstlane(threadIdx.x >> 6);
    volatile LAS unsigned* MISC = (volatile LAS unsigned*)(lds + 143360);
    { const int l0 = fresh_lane(); if (wave0 == 0) MISC[l0] = 0u; }
    __syncthreads();
#if defined(PROBE_T0)
    if (PROBE_T0 == 0 && blockIdx.x == PROBE_BLK && wave0 == 0) { const unsigned long long t = __builtin_amdgcn_s_memrealtime(); MISC[8] = (unsigned)t; MISC[9] = (unsigned)(t >> 32); }
#endif
    unsigned* ctl0 = (unsigned*)(args.ws + WS_CTL);
    XcdBarrier gbar = xcd_barrier_post(ctl0, MISC, wave0 == 0 && fresh_lane() == 0, gridDim.x);
    if (wave0 == 0 && fresh_lane() == 0) { const unsigned r = (gbar.x < 8u) ? xb_add(&ctl0[XL_RANK(gbar.x)], 1u) : 99u;
#if defined(FORCE_FALLBACK)
        __hip_atomic_store(&ctl0[XL_FLAG], 1u, __ATOMIC_RELAXED, __HIP_MEMORY_SCOPE_AGENT);
#endif
        if (r >= 32u || gridDim.x != 256u) __hip_atomic_store(&ctl0[XL_FLAG], 1u, __ATOMIC_RELAXED, __HIP_MEMORY_SCOPE_AGENT);
        MISC[2] = r; MISC[3] = gbar.x; }
    __syncthreads();
#if defined(STREAM_SPLIT_KT)
#define KT_NEED 256u
#else
#define KT_NEED 128u
#endif
#ifndef MK_SPLIT_SEAM
#define MK_SPLIT_SEAM 1
#endif
#ifndef MK_SLAB
#define MK_SLAB 1
#endif
#ifndef MK_PANEL_SEAM
#define MK_PANEL_SEAM 1
#endif
#ifndef MK_LOCAL_SEAMS
#define MK_LOCAL_SEAMS 1
#endif
#define FRESH_TID(name) int name = fresh_lane(); name += wv * 64
    { const int bx0 = blockIdx.x, vcu0 = (bx0 % 8) * 32 + bx0 / 8; const int wv = wave0; FRESH_TID(t0);
      prologue_phase(args, args.ws, args.out, lds, vcu0 * NWAVES + wv, 256 * NWAVES, wv, t0 & 63); asm volatile("s_waitcnt vmcnt(0) lgkmcnt(0)" ::: "memory"); __syncthreads(); }
    xcd_barrier(gbar, wave0 == 0 && fresh_lane() == 0);
    const bool xl_ok = (__builtin_amdgcn_readfirstlane((int)__hip_atomic_load(&ctl0[XL_FLAG], __ATOMIC_RELAXED, __HIP_MEMORY_SCOPE_AGENT)) == 0);
    const int vb = xl_ok ? (int)__builtin_amdgcn_readfirstlane((int)(MISC[2] * 8u + MISC[3])) : (int)blockIdx.x;
    const int sid0 = vb >> 7, lb0 = vb & 127;
    unsigned* sctl = ctl0 + 8192 + 8192 * sid0;
    XcdBarrier sbar = xcd_barrier_post(sctl, MISC + 4, wave0 == 0 && fresh_lane() == 0, 128u);
    int prev_st = -1;
    for (int s = 1; s < 1 + NLAYER * NSTEP; ++s) {
        if (s > 1) { const bool ldr = wave0 == 0 && fresh_lane() == 0;
            const bool last_ple = (s == 1 + (NLAYER - 1) * NSTEP + ST_PLE);
            if (MK_SPLIT_SEAM && MK_LOCAL_SEAMS && xl_ok && prev_st == ST_MIX) {   }
            else if (MK_LOCAL_SEAMS && xl_ok && !last_ple && (prev_st == ST_MIX || prev_st == ST_FF1 || prev_st == ST_FF2 || (MK_SLAB && (prev_st == ST_OUT || prev_st == ST_PLE)))) xcd_local_barrier(sctl, sbar.x, 16u, ldr);
            else if (MK_PANEL_SEAM && xl_ok && prev_st == ST_IN) {   }
            else xcd_barrier(sbar, ldr); }
#if defined(PROBE_T0)
#ifndef PROBE_Q
#define PROBE_Q 1.0f
#endif
        if (PROBE_ME && wave0 == 0) { if (s == PROBE_T0) { const unsigned long long t = __builtin_amdgcn_s_memrealtime(); MISC[8] = (unsigned)t; MISC[9] = (unsigned)(t >> 32); }
            if (s == PROBE_T1) { const unsigned long long t = __builtin_amdgcn_s_memrealtime(), t0 = ((unsigned long long)MISC[9] << 32) | MISC[8]; MISC[10] = (unsigned)(t - t0); } }
#endif
#if defined(PROBE_SLOT)
        if (wave0 == 0) MISC[12] = (unsigned)s;
#endif
        unsigned long long z0 = 0ull; int lb = lb0, sid = sid0; int wv = wave0;
        asm volatile("" : "+s"(z0), "+s"(lb), "+s"(sid), "+s"(wv));
        unsigned char* ws = args.ws + z0; float* outp = args.out + z0;
        const int item = sid * 128 + (lb & 7) * 16 + (lb >> 3);
        const int L = (s - 1) / NSTEP, st = (s - 1) % NSTEP, par = L & 1; prev_st = st;
        unsigned char* wl = ws + WS_W + (size_t)L * LW_STRIDE;
        const bf16* hbb = (const bf16*)((unsigned char*)outp + out_hbb(sid));
        if (st == ST_IN) {
#if defined(STREAM_SPLIT_KT)
            if (L == 0) { ssm_ktable(args.in, ws, (lb * 2 + sid) * NWAVES + wv, 256 * NWAVES);
#else
            if (L == 0 && sid == 1) { ssm_ktable(args.in, ws, lb * NWAVES + wv, 128 * NWAVES);
#endif asm volatile("s_waitcnt vmcnt(0)" ::: "memory");
#if defined(STREAM_LAG_US)
                { const unsigned long long t0s = __builtin_amdgcn_s_memrealtime(); while (__builtin_amdgcn_s_memrealtime() - t0s < (unsigned long long)(STREAM_LAG_US * 100)) __builtin_amdgcn_s_sleep(8); }
#endif
            }
            unsigned* pcnt = ctl0 + 24576 + 1024 * L;
            pg8::Gemm g{hbb, (const bf16*)(wl + LW_IN), NTOK, NIN, DM}; SOrder<1> S{lb, sid, pcnt};
            pg8::EpiIn E{ws, par, L, lds};
            { pg8::Unit u0; FRESH_TID(tr); S.next(0, u0); pg8::rstd_panel_to_lds(lds, (const float*)(ws + (par ? TAB_SSQ1 : TAB_SSQ0)), u0.pm, tr); }
            { FRESH_TID(tl); pg8::gemm_phase<pg8::EpiIn, SOrder<1>, PG8_ALIGN, PG8_SP2>(lds, g, S, E, tl); }
            {
                pg8::Gemm g2{(const bf16*)(ws + WS_PB), (const bf16*)(wl + LW_PROJ), NTOK, DM, 256}; SOrder<3> S2{lb, sid};
                pg8::EpiProj E2{ws};
                { FRESH_TID(tl); pg8::gemm_phase<pg8::EpiProj, SOrder<3>, PG8_ALIGN, PG8_SP2>(lds, g2, S2, E2, tl); }
            }
        } else if (st == ST_MIX) {
            if (L == 0 && sid == 1) {
                asm volatile("s_waitcnt vmcnt(0)" ::: "memory"); __builtin_amdgcn_s_barrier();
                if (wv == 0 && fresh_lane() == 0) { __builtin_amdgcn_fence(__ATOMIC_RELEASE, "agent"); asm volatile("s_waitcnt vmcnt(0)" ::: "memory");
                    __hip_atomic_fetch_add(&ctl0[XL_KTDONE], 1u, __ATOMIC_RELAXED, __HIP_MEMORY_SCOPE_AGENT); } }
            if (MK_PANEL_SEAM && xl_ok) {
                if (wv == 0) { const unsigned* pcnt = ctl0 + 24576 + 1024 * L; const int pmI = item >> 2; unsigned spins = 0;
                    while ((unsigned)__builtin_amdgcn_readfirstlane(__hip_atomic_load(pcnt + 16 * pmI, __ATOMIC_RELAXED, __HIP_MEMORY_SCOPE_AGENT)) < 48u) { __builtin_amdgcn_s_sleep(2); if (++spins > (1u << 22)) break; }
                    if ((item & 3) < 2 && (item & 127) >= 2) { spins = 0;
                        while ((unsigned)__builtin_amdgcn_readfirstlane(__hip_atomic_load(pcnt + 16 * (pmI - 1), __ATOMIC_RELAXED, __HIP_MEMORY_SCOPE_AGENT)) < 48u) { __builtin_amdgcn_s_sleep(2); if (++spins > (1u << 22)) break; } }
                    __builtin_amdgcn_fence(__ATOMIC_ACQUIRE, "agent"); asm volatile("s_waitcnt vmcnt(0)" ::: "memory"); }
                asm volatile("" ::: "memory"); __builtin_amdgcn_s_barrier(); asm volatile("" ::: "memory"); }
            M_STAMP(300);
            ssm1_item(ws, L, item, wv, 0);
            M_STAMP(301);
            unsigned* cnt = ctl0 + 3584 + 64 * (sid * NLAYER + L); unsigned* cnt2 = ctl0 + 7168 + 64 * (sid * NLAYER + L);
            attn_item(ws, L, lds, item, wv, 0, cnt);
            M_STAMP(302);
            if (lb < 16) {
                if (wv == 0) { unsigned spins = 0;
                    while ((unsigned)__builtin_amdgcn_readfirstlane(__hip_atomic_load(cnt, __ATOMIC_RELAXED, __HIP_MEMORY_SCOPE_AGENT)) < 128u) { __builtin_amdgcn_s_sleep(2); if (++spins > (1u << 20)) break; }
                    __builtin_amdgcn_fence(__ATOMIC_ACQUIRE, "agent"); asm volatile("s_waitcnt vmcnt(0)" ::: "memory"); }
                asm volatile("" ::: "memory"); __builtin_amdgcn_s_barrier(); asm volatile("" ::: "memory");
                ssm_scan(ws, L, lds, sid * 16 + lb, wv);
                if (wv == 0 && fresh_lane() == 0) __hip_atomic_fetch_add(cnt2, 1u, __ATOMIC_RELAXED, __HIP_MEMORY_SCOPE_AGENT);
            }
            M_STAMP(303);
            gmlp_item(ws, L, lds, item, wv, 0);
            M_STAMP(304);
            if (wv == 0) { unsigned spins = 0;
                while ((unsigned)__builtin_amdgcn_readfirstlane(__hip_atomic_load(cnt2, __ATOMIC_RELAXED, __HIP_MEMORY_SCOPE_AGENT)) < 16u) { __builtin_amdgcn_s_sleep(2); if (++spins > (1u << 20)) break; }
                if (L == 0) { spins = 0;
                    while ((unsigned)__builtin_amdgcn_readfirstlane(__hip_atomic_load(&ctl0[XL_KTDONE], __ATOMIC_RELAXED, __HIP_MEMORY_SCOPE_AGENT)) < KT_NEED) { __builtin_amdgcn_s_sleep(2); if (++spins > (1u << 22)) break; } }
                __builtin_amdgcn_fence(__ATOMIC_ACQUIRE, "agent"); asm volatile("s_waitcnt vmcnt(0)" ::: "memory"); }
            asm volatile("" ::: "memory"); __builtin_amdgcn_s_barrier(); asm volatile("" ::: "memory");
            M_STAMP(305);
#if defined(PROBE_T0) && defined(PROBE_SLOT)
            ssm2_item(ws, L, lds, item, wv, 0, MISC, PROBE_ME && s == PROBE_SLOT);
#else
            ssm2_item(ws, L, lds, item, wv, 0);
#endif
            M_STAMP(306);
            if (MK_SPLIT_SEAM && MK_LOCAL_SEAMS && xl_ok) {
                unsigned gen_ = 0u; bool last_ = false; const bool ldr = wv == 0 && fresh_lane() == 0;
                if (ldr) { __builtin_amdgcn_s_waitcnt(0); const unsigned old = xb_add(&sctl[XL_SUB(sbar.x)], 1u); gen_ = old / 16u; last_ = (old + 1u == (gen_ + 1u) * 16u);
                    if (last_) xb_add(&sctl[XL_GEN(sbar.x)], 1u); }
                if (L + 1 < NLAYER) convert_p(args.in[1] + (size_t)(L + 1) * NTOK * 256, ws, (lb >> 3) * NWAVES + wv, 16 * NWAVES, 8192 * sid + 1024 * (lb & 7), 1024);
                if (ldr) { if (!last_) XB_SPIN(xb_ld(&sctl[XL_GEN(sbar.x)]) == gen_, sctl);
                    __builtin_amdgcn_fence(__ATOMIC_ACQUIRE, "agent"); asm volatile("s_waitcnt vmcnt(0)" ::: "memory"); }
                __syncthreads();
            } else
            if (L + 1 < NLAYER) convert_p(args.in[1] + (size_t)(L + 1) * NTOK * 256, ws, (lb >> 3) * NWAVES + wv, 16 * NWAVES, 8192 * sid + 1024 * (lb & 7), 1024);
        } else if (st == ST_OUT || st == ST_FF2) {
            const bool o = (st == ST_OUT);
            const int pm_ = 32 * sid + 4 * (lb & 7) + ((lb >> 3) & 3);
            pg8::Gemm g{(const bf16*)(ws + WS_HID + (o ? ZS_YCAT + (size_t)pm_ * (2 * MiB - 512 * 1024) : 0)), (const bf16*)(wl + (o ? LW_OUT : LW_FF2)), NTOK, DM, o ? DM : DFF}; SOrder<0> S{lb, sid};
            pg8::EpiRes<false> E{o ? hbb : (const bf16*)(ws + WS_HB), (bf16*)(ws + WS_HB), nullptr, ws, o ? (par ^ 1) : par};
            { FRESH_TID(tl); pg8::gemm_phase<pg8::EpiRes<false>, SOrder<0>, false, PG8_SP2>(lds, g, S, E, tl); }
        } else if (st == ST_FF1) {
            pg8::Gemm g{(const bf16*)(ws + WS_HB), (const bf16*)(wl + LW_FF1), NTOK, DFF, DM}; SOrder<2> S{lb, sid};
            pg8::EpiFF1 E{ws, par ^ 1, lds};
            { pg8::Unit u0; FRESH_TID(tr); S.next(0, u0); pg8::rstd_panel_to_lds(lds, (const float*)(ws + ((par ^ 1) ? TAB_SSQ1 : TAB_SSQ0)), u0.pm, tr); }
            { FRESH_TID(tl); pg8::gemm_phase<pg8::EpiFF1, SOrder<2>, PG8_ALIGN, PG8_SP2>(lds, g, S, E, tl); }
        } else if (st == ST_PLE) {
            pg8::Gemm g{(const bf16*)(ws + WS_HB), (const bf16*)(wl + LW_GATE), NTOK, DM, DM}; SOrder<0> S{lb, sid};
            pg8::EpiRes<true> E{(const bf16*)(ws + WS_HB), (bf16*)hbb, (L == NLAYER - 1) ? outp : nullptr, ws, par ^ 1};
            { FRESH_TID(tl); pg8::gemm_phase<pg8::EpiRes<true>, SOrder<0>, false, PG8_SP2>(lds, g, S, E, tl); }
        }
    }
#if defined(PROBE_T0)
    if (PROBE_ME && wave0 == 0) { const unsigned long long t = __builtin_amdgcn_s_memrealtime(), t0 = ((unsigned long long)MISC[9] << 32) | MISC[8];
        const unsigned dt = (PROBE_T1 >= 1 + NLAYER * NSTEP && PROBE_T1 < 100) ? (unsigned)(t - t0) : MISC[10];
        if (fresh_lane() == 0) { asm volatile("s_waitcnt vmcnt(0)" ::: "memory"); args.out[0] += (float)(int)((float)dt * 0.01f / PROBE_Q + 0.5f) * PROBE_Q; } }
#endif
}
extern "C" void kernel_launch(void* const* d_in, const int* in_sizes, int n_in, void* d_out, int out_size, void* d_ws, size_t ws_size, hipStream_t stream) {
    static int grid = 0;
    if (grid == 0) {
        if (n_in != 30 || out_size != NTOK * DM || ws_size < WS_END) { fprintf(stderr, "kernel_launch: unexpected shapes / workspace (n_in %d out %d ws %zu)\n", n_in, out_size, ws_size); grid = -1; return; }
        int dev = 0, cus = 0, per_cu = 0;
        (void)hipGetDevice(&dev); (void)hipDeviceGetAttribute(&cus, hipDeviceAttributeMultiprocessorCount, dev);
        (void)hipFuncSetAttribute((const void*)mk_fwd, hipFuncAttributeMaxDynamicSharedMemorySize, LDS_BYTES);
        (void)hipOccupancyMaxActiveBlocksPerMultiprocessor(&per_cu, (const void*)mk_fwd, NWAVES * 64, LDS_BYTES);
        (void)hipGetLastError();
        grid = (per_cu >= 1 && cus == 256) ? 256 : -1;
        if (grid < 0) { fprintf(stderr, "kernel_launch: needs 256 CUs with one resident workgroup each (cus %d per_cu %d)\n", cus, per_cu); return; }
    }
    if (grid < 0) return;
    (void)hipMemsetAsync((char*)d_ws + WS_CTL, 0, CTL_ZERO_BYTES, stream);
    Args a{};
    for (int i = 0; i < 30; ++i) a.in[i] = (const float*)d_in[i];
    a.out = (float*)d_out; a.ws = (unsigned char*)d_ws;
    unsigned char* ws = (unsigned char*)d_ws;
    const float* const* F = a.in;
#define LAUNCH_STEPS(lo, hi) do { a.s_lo = (lo); a.s_hi = (hi); hipLaunchKernelGGL(mk_fwd, dim3(grid), dim3(NWAVES * 64), LDS_BYTES, stream, a); } while (0)
    LAUNCH_STEPS(0, 1 + NLAYER * NSTEP);
}
```
